# Optimizing an MI355X kernel written in HIP

```python
import math
import jax, jax.numpy as jnp
from jax import lax
import numpy as np

D_MODEL = 1024
BATCH = 4
SEQ = 4096
DEPTH = 2

GRID_W = 64
CTX_LEN = 256
N_MIXERS = 2
N_ATTN_LAYERS = (DEPTH + 1) // 2
N_SSM_LAYERS = DEPTH // 2
HEAD_DIM = 64
N_HEADS = D_MODEL // HEAD_DIM
N_KV_HEADS = 4
GQA_GROUP = N_HEADS // N_KV_HEADS
ATTN_WIDTH = N_HEADS * HEAD_DIM
KV_WIDTH = N_KV_HEADS * HEAD_DIM
ATTN_IN = 2 * ATTN_WIDTH + 2 * KV_WIDTH
WINDOW = 128
BLOCK = 128
ROPE_BASE = 10000.0
ROPE_FREQS = HEAD_DIM // 4
SSM_WIDTH = D_MODEL
SSM_GROUP = 16
SSM_GROUPS = SSM_WIDTH // SSM_GROUP
SSM_STATE = 64
DT_MIN = 0.001
DT_MAX = 0.1
NORM_EPS = 1e-6
NEG_INF = -1e30

kernel_name = "hybrid_swa_sink_s5_ctx_prefix"


def rmsnorm(x, w):
    xf = x.astype(jnp.float32)
    y = xf * lax.rsqrt(jnp.mean(xf * xf, axis=-1, keepdims=True) + NORM_EPS)
    return (y * w.astype(jnp.float32)).astype(x.dtype)


def rope_angles(rows):
    inv = ROPE_BASE ** (-jnp.arange(ROPE_FREQS, dtype=jnp.float32) / ROPE_FREQS)
    row = jnp.repeat(jnp.arange(rows, dtype=jnp.float32), GRID_W)
    col = jnp.tile(jnp.arange(GRID_W, dtype=jnp.float32), rows)
    return jnp.stack([row[:, None] * inv, col[:, None] * inv], axis=1)


def rope_2d(t, ang):
    ts = t.reshape(t.shape[:-1] + (2, 2, ROPE_FREQS))
    t1, t2 = ts[..., 0, :], ts[..., 1, :]
    cos = jnp.cos(ang)[None, :, None].astype(t.dtype)
    sin = jnp.sin(ang)[None, :, None].astype(t.dtype)
    out = jnp.stack([t1 * cos - t2 * sin, t2 * cos + t1 * sin], axis=-2)
    return out.reshape(t.shape)


def band_mask(n_blocks):
    qi = jnp.arange(BLOCK)[:, None]
    kj = jnp.arange(3 * BLOCK)[None, :]
    in_win = jnp.abs(kj - BLOCK - qi) <= WINDOW
    key_pos = jnp.arange(n_blocks)[:, None] * BLOCK + jnp.arange(3 * BLOCK)[None, :] - BLOCK
    valid = (key_pos >= 0) & (key_pos < n_blocks * BLOCK)
    return in_win[None] & valid[:, None, :]


def band(t):
    b, l = t.shape[0], t.shape[1]
    tp = jnp.pad(t, ((0, 0), (BLOCK, BLOCK), (0, 0), (0, 0)))
    tb = tp.reshape(b, l // BLOCK + 2, BLOCK, t.shape[2], t.shape[3])
    return jnp.concatenate([tb[:, :-2], tb[:, 1:-1], tb[:, 2:]], axis=2)


def attn_mixer(h, hc, w_in, sink, w_out, ang, mask, need_ctx_out):
    b, l, _ = h.shape
    nb = l // BLOCK
    f32 = jnp.float32
    scale = HEAD_DIM ** -0.5
    q, k, v, z = jnp.split(h @ w_in, [ATTN_WIDTH, ATTN_WIDTH + KV_WIDTH, ATTN_WIDTH + 2 * KV_WIDTH], axis=-1)
    q = rope_2d(q.reshape(b, l, N_HEADS, HEAD_DIM), ang)
    k = rope_2d(k.reshape(b, l, N_KV_HEADS, HEAD_DIM), ang)
    v = v.reshape(b, l, N_KV_HEADS, HEAD_DIM)
    kvc = hc @ w_in[:, ATTN_WIDTH:ATTN_WIDTH + 2 * KV_WIDTH]
    kc, vc = jnp.split(kvc, 2, axis=-1)
    n_ctx = hc.shape[1]
    kc = kc.reshape(b, n_ctx, N_KV_HEADS, HEAD_DIM).astype(f32)
    vc = vc.reshape(b, n_ctx, N_KV_HEADS, HEAD_DIM).astype(f32)
    sink_kg = sink.astype(f32).reshape(N_KV_HEADS, GQA_GROUP)

    qb = q.reshape(b, nb, BLOCK, N_KV_HEADS, GQA_GROUP, HEAD_DIM).astype(f32) * scale
    kw = band(k).astype(f32)
    vw = band(v).astype(f32)
    s_win = jnp.einsum('bnqkgd,bnjkd->bnkgqj', qb, kw)
    s_win = jnp.where(mask[None, :, None, None], s_win, NEG_INF)
    s_ctx = jnp.einsum('bnqkgd,bckd->bnkgqc', qb, kc)
    s_sink = jnp.broadcast_to(sink_kg[None, None, :, :, None, None], s_win.shape[:-1] + (1,))
    p = jax.nn.softmax(jnp.concatenate([s_win, s_ctx, s_sink], axis=-1), axis=-1)
    nw = 3 * BLOCK
    o = (jnp.einsum('bnkgqj,bnjkd->bnqkgd', p[..., :nw], vw)
         + jnp.einsum('bnkgqc,bckd->bnqkgd', p[..., nw:nw + n_ctx], vc))
    o = o.reshape(b, l, ATTN_WIDTH).astype(h.dtype)
    y = (o * jax.nn.silu(z)) @ w_out

    yc = None
    if need_ctx_out:
        qc = (hc @ w_in[:, :ATTN_WIDTH]).reshape(b, n_ctx, N_KV_HEADS, GQA_GROUP, HEAD_DIM).astype(f32) * scale
        zc = hc @ w_in[:, ATTN_WIDTH + 2 * KV_WIDTH:]
        sc = jnp.einsum('bqkgd,bckd->bkgqc', qc, kc)
        sc_sink = jnp.broadcast_to(sink_kg[None, :, :, None, None], sc.shape[:-1] + (1,))
        pc = jax.nn.softmax(jnp.concatenate([sc, sc_sink], axis=-1), axis=-1)
        oc = jnp.einsum('bkgqc,bckd->bqkgd', pc[..., :n_ctx], vc)
        oc = oc.reshape(b, n_ctx, ATTN_WIDTH).astype(hc.dtype)
        yc = (oc * jax.nn.silu(zc)) @ w_out
    return y, yc


def _scan_op(e1, e2):
    a1, b1 = e1
    a2, b2 = e2
    return a1 * a2, a2 * b1 + b2


def diag_scan(a_bar, bu):
    a = jnp.broadcast_to(a_bar, bu.shape)
    _, xs = lax.associative_scan(_scan_op, (a, bu), axis=1)
    return xs


def s5_output(y, z, w_glu, w_out, dtype):
    b, l = y.shape[0], y.shape[1]
    y = jax.nn.gelu(y.reshape(b, l, SSM_WIDTH), approximate=False).astype(dtype)
    ya, yg = jnp.split(y @ w_glu, 2, axis=-1)
    y = ya * jax.nn.sigmoid(yg)
    return (y * jax.nn.silu(z)) @ w_out


def s5_mixer(h, hc, w_in, lam_re, lam_im, log_dt, b_re, b_im, c_re, c_im, d_skip, w_glu, w_out, need_ctx_out):
    b, l, _ = h.shape
    n_ctx = hc.shape[1]
    f32 = jnp.float32
    u, z = jnp.split(h @ w_in, 2, axis=-1)
    uc = hc @ w_in[:, :SSM_WIDTH]
    ug = u.reshape(b, l, SSM_GROUPS, SSM_GROUP).astype(f32)
    ucg = uc.reshape(b, n_ctx, SSM_GROUPS, SSM_GROUP).astype(f32)
    d_g = d_skip.astype(f32).reshape(SSM_GROUPS, SSM_GROUP)
    y = d_g * ug
    yc = d_g * ucg if need_ctx_out else None
    for dirn in range(2):
        lam = lax.complex(lam_re[dirn].astype(f32), lam_im[dirn].astype(f32))
        dt = jnp.exp(log_dt[dirn].astype(f32))[:, None]
        a_bar = jnp.exp(lam * dt)
        b_mat = lax.complex(b_re[dirn].astype(f32), b_im[dirn].astype(f32))
        b_bar = ((a_bar - 1.0) / lam)[..., None] * b_mat
        c_mat = lax.complex(c_re[dirn].astype(f32), c_im[dirn].astype(f32))
        bu_c = jnp.einsum('gph,blgh->blgp', b_bar, ucg.astype(jnp.complex64))
        bu = jnp.einsum('gph,blgh->blgp', b_bar, ug.astype(jnp.complex64))
        if dirn == 1:
            bu_c = jnp.flip(bu_c, axis=1)
            bu = jnp.flip(bu, axis=1)
        xs_c = diag_scan(a_bar, bu_c)
        s0 = xs_c[:, -1]
        xs = diag_scan(a_bar, bu.at[:, 0].add(a_bar * s0))
        if dirn == 1:
            xs = jnp.flip(xs, axis=1)
            xs_c = jnp.flip(xs_c, axis=1)
        y = y + jnp.einsum('ghp,blgp->blgh', c_mat, xs).real
        if need_ctx_out:
            yc = yc + jnp.einsum('ghp,blgp->blgh', c_mat, xs_c).real
    out = s5_output(y, z, w_glu, w_out, h.dtype)
    out_c = None
    if need_ctx_out:
        zc = hc @ w_in[:, SSM_WIDTH:]
        out_c = s5_output(yc, zc, w_glu, w_out, hc.dtype)
    return out, out_c


def setup_inputs(seed: int = 0) -> dict:
    key = jax.random.key(seed)
    ks = jax.random.split(key, 24)
    f32 = jnp.float32

    def nrm(k, shape, scale):
        return jax.random.normal(k, shape, f32) * scale

    lam_shape = (N_SSM_LAYERS, 2, SSM_GROUPS, SSM_STATE)
    n_idx = jnp.arange(SSM_STATE, dtype=f32)
    return {
        "x": nrm(ks[0], (BATCH, SEQ, D_MODEL), 1.0),
        "c": nrm(ks[1], (BATCH, D_MODEL), 1.0),
        "ctx": nrm(ks[2], (BATCH, CTX_LEN, D_MODEL), 1.0),
        "c_ctx": nrm(ks[3], (D_MODEL,), 1.0),
        "norm_w": 1.0 + nrm(ks[4], (DEPTH, D_MODEL), 0.02),
        "w_ada": nrm(ks[5], (DEPTH, D_MODEL, 3 * D_MODEL), D_MODEL ** -0.5),
        "b_ada": nrm(ks[6], (DEPTH, 3 * D_MODEL), 0.02),
        "attn_w_in": nrm(ks[7], (N_ATTN_LAYERS, D_MODEL, ATTN_IN), D_MODEL ** -0.5),
        "attn_sink": nrm(ks[8], (N_ATTN_LAYERS, N_HEADS), 0.5),
        "attn_w_out": nrm(ks[9], (N_ATTN_LAYERS, ATTN_WIDTH, D_MODEL), ATTN_WIDTH ** -0.5),
        "ssm_w_in": nrm(ks[10], (N_SSM_LAYERS, D_MODEL, 2 * SSM_WIDTH), D_MODEL ** -0.5),
        "ssm_lam_re": -0.5 + nrm(ks[11], lam_shape, 0.01),
        "ssm_lam_im": math.pi * n_idx + nrm(ks[12], lam_shape, 0.01),
        "ssm_log_dt": jax.random.uniform(ks[13], (N_SSM_LAYERS, 2, SSM_GROUPS), f32,
                                         math.log(DT_MIN), math.log(DT_MAX)),
        "ssm_b_re": nrm(ks[14], (N_SSM_LAYERS, 2, SSM_GROUPS, SSM_STATE, SSM_GROUP), (2 * SSM_GROUP) ** -0.5),
        "ssm_b_im": nrm(ks[15], (N_SSM_LAYERS, 2, SSM_GROUPS, SSM_STATE, SSM_GROUP), (2 * SSM_GROUP) ** -0.5),
        "ssm_c_re": nrm(ks[16], (N_SSM_LAYERS, 2, SSM_GROUPS, SSM_GROUP, SSM_STATE), SSM_STATE ** -0.5),
        "ssm_c_im": nrm(ks[17], (N_SSM_LAYERS, 2, SSM_GROUPS, SSM_GROUP, SSM_STATE), SSM_STATE ** -0.5),
        "ssm_d": nrm(ks[18], (N_SSM_LAYERS, SSM_WIDTH), 1.0),
        "ssm_w_glu": nrm(ks[19], (N_SSM_LAYERS, SSM_WIDTH, 2 * SSM_WIDTH), SSM_WIDTH ** -0.5),
        "ssm_w_out": nrm(ks[20], (N_SSM_LAYERS, SSM_WIDTH, D_MODEL), SSM_WIDTH ** -0.5),
        "final_norm_w": 1.0 + nrm(ks[21], (D_MODEL,), 0.02),
    }


def reference(x, c, ctx, c_ctx, norm_w, w_ada, b_ada, attn_w_in, attn_sink, attn_w_out,
              ssm_w_in, ssm_lam_re, ssm_lam_im, ssm_log_dt, ssm_b_re, ssm_b_im, ssm_c_re, ssm_c_im,
              ssm_d, ssm_w_glu, ssm_w_out, final_norm_w):
    n_lat = x.shape[1]
    rows = n_lat // GRID_W
    ang = rope_angles(rows)
    mask = band_mask(n_lat // BLOCK)
    for i in range(DEPTH):
        need_ctx_out = i < DEPTH - 1
        mod = jax.nn.silu(c) @ w_ada[i] + b_ada[i]
        mod_c = jax.nn.silu(c_ctx) @ w_ada[i] + b_ada[i]
        shift, scale, gate = jnp.split(mod, 3, axis=-1)
        shift_c, scale_c, gate_c = jnp.split(mod_c, 3, axis=-1)
        h = rmsnorm(x, norm_w[i]) * (1.0 + scale[:, None]) + shift[:, None]
        hc = rmsnorm(ctx, norm_w[i]) * (1.0 + scale_c) + shift_c
        j = i // N_MIXERS
        if i % N_MIXERS == 0:
            y, yc = attn_mixer(h, hc, attn_w_in[j], attn_sink[j], attn_w_out[j], ang, mask, need_ctx_out)
        else:
            y, yc = s5_mixer(h, hc, ssm_w_in[j], ssm_lam_re[j], ssm_lam_im[j], ssm_log_dt[j],
                             ssm_b_re[j], ssm_b_im[j], ssm_c_re[j], ssm_c_im[j], ssm_d[j],
                             ssm_w_glu[j], ssm_w_out[j], need_ctx_out)
        x = x + gate[:, None] * y
        if need_ctx_out:
            ctx = ctx + gate_c * yc
    return rmsnorm(x, final_norm_w)
```

```cpp
#include <hip/hip_runtime.h>
#include <hip/hip_cooperative_groups.h>
#include <cstdio>
#include <cstdint>
namespace cg = cooperative_groups;

#define LAS __attribute__((address_space(3)))
typedef unsigned short bf16_t;
typedef short bf16x8 __attribute__((ext_vector_type(8)));
typedef short bf16x4 __attribute__((ext_vector_type(4)));
typedef float f32x4 __attribute__((ext_vector_type(4)));
typedef float f32x2 __attribute__((ext_vector_type(2)));
typedef float f32x16 __attribute__((ext_vector_type(16)));
typedef unsigned u32x4 __attribute__((ext_vector_type(4)));
typedef unsigned u32x2 __attribute__((ext_vector_type(2)));
typedef __bf16 nbf2 __attribute__((ext_vector_type(2)));

constexpr int D = 1024, NB = 4, SEQ = 4096, CTXL = 256;
constexpr int NLAT = NB * SEQ;
constexpr int NCTX = NB * CTXL;
constexpr int MTOT = NLAT + NCTX;
constexpr int NQKVZ = 2560;
constexpr int NUZ = 2048;
constexpr int NCHUNK = 68;
constexpr float LOG2E = 1.4426950408889634f;

constexpr size_t MiB = 1u << 20;
constexpr size_t WS_MOD = 0;
constexpr size_t WS_BAR = 128 * 1024;
constexpr size_t WS_ROPE = 256 * 1024;
constexpr size_t WS_APOW = 512 * 1024;
constexpr size_t WS_BB = 1 * MiB;
constexpr size_t WS_CM = 1 * MiB + 512 * 1024;
constexpr size_t WS_WQKVZ = 2 * MiB;
constexpr size_t WS_WAO = 7 * MiB;
constexpr size_t WS_WSIN = 9 * MiB;
constexpr size_t WS_WGLU = 13 * MiB;
constexpr size_t WS_WSOUT = 17 * MiB;
constexpr size_t WS_CTX1 = 19 * MiB;
constexpr size_t WS_E = 23 * MiB;
constexpr size_t WS_H = 40 * MiB;
constexpr size_t WS_AO = 74 * MiB;
constexpr size_t WS_QKVZ = 108 * MiB;
constexpr size_t WS_STAT = 193 * MiB;
constexpr size_t WS_QE = 194 * MiB;
constexpr size_t WS_X1 = 195 * MiB;
constexpr size_t WS_END = 227 * MiB;
constexpr size_t WS_CNT = WS_BAR + 16384;
constexpr size_t WS_STATC = WS_STAT + 768 * 1024;
constexpr size_t WS_CNTC = WS_CNT + 2 * 68 * 256;
constexpr size_t BAR_ZERO_BYTES = 16384 + 2 * 68 * 256 + 16 * 256;

constexpr int S5_WAVE_LDS = 18944;
constexpr int LDS_TOP = 8 * S5_WAVE_LDS;
constexpr int LDS_BYTES = LDS_TOP + 6144;
#ifndef REP_MASK
#define REP_MASK 0
#endif
#ifndef SYNC_REP
#define SYNC_REP 1
#endif

__device__ __forceinline__ unsigned pk2(float lo, float hi) { f32x2 v = {lo, hi}; nbf2 r = __builtin_convertvector(v, nbf2); return __builtin_bit_cast(unsigned, r); }
__device__ __forceinline__ float bf_lo(unsigned w) { return __uint_as_float(w << 16); }
__device__ __forceinline__ float bf_hi(unsigned w) { return __uint_as_float(w & 0xffff0000u); }
__device__ __forceinline__ float fast_rcp(float x) { return __builtin_amdgcn_rcpf(x); }
__device__ __forceinline__ float fast_exp2(float x) { return __builtin_amdgcn_exp2f(x); }
__device__ __forceinline__ float silu_f(float z) { return z * fast_rcp(1.0f + fast_exp2(-z * LOG2E)); }
__device__ __forceinline__ float sigmoid_f(float z) { return fast_rcp(1.0f + fast_exp2(-z * LOG2E)); }
__device__ __forceinline__ float wave_sum(float v) {
#pragma unroll
    for (int o = 1; o < 64; o <<= 1) v += __shfl_xor(v, o);
    return v;
}
__device__ __forceinline__ float gelu_f(float v) {
    const float av = fabsf(v), d = av * 0.2316418882f + 1.0f;
    const float t = fast_rcp(d);
    float q = t * 0.5307027145f + (-0.7265760135f); q = q * t + 0.7107068705f; q = q * t + (-0.142248368f); q = q * t + 0.127414796f; q = q * t;
    const float e = fast_exp2((v * v) * (-0.72134752044f));
    const float m = v * (q * e), r = v - m;
    return v < 0.f ? m : r;
}
#define WAVE_LDS_FENCE() asm volatile("s_waitcnt lgkmcnt(0)" ::: "memory")
__device__ __forceinline__ f32x2 cmac(f32x2 x, f32x2 a_rr, f32x2 a_i, f32x2 c) { const f32x2 t = a_rr * x + c; const f32x2 xs = {x.y, x.x}; return a_i * xs + t; }

namespace pg8 {
constexpr int BM = 256, BK = 64, HALF = 128, HTB = HALF * BK * 2, NXCD = 8, WGM = 8;
__host__ __device__ __forceinline__ int lds_byte(int r, int c) { const int st = (r >> 4) * 2 + (c >> 5), rr = r & 15, cc = c & 31, ob = rr * 64 + cc * 2; return st * 1024 + (ob ^ (((ob >> 9) & 1) << 5)); }
__host__ __device__ __forceinline__ void stage_rc(int b, int& R, int& C) { const int st = b / 1024, sb = b % 1024, swz = sb ^ (((sb >> 9) & 1) << 5); R = (st >> 1) * 16 + swz / 64; C = (st & 1) * 32 + (swz % 64) / 2; }
__host__ __device__ __forceinline__ int perm32(int rho) { const int n = rho >> 4, i = rho & 15; return 8 * (i >> 2) + 4 * n + (i & 3); }
struct Unit { int pm, pn; };
struct Gemm { const bf16_t* A; const bf16_t* Bt; int M, N, K; };
struct StaticOrder {
    int nM, nN, nwg, G, c;
    __device__ void init(int M, int N, int G_, int c_) { nM = M / BM; nN = N / BM; nwg = nM * nN; G = G_; c = c_; }
    __device__ bool next(int i, Unit& u) const {
        const long L = (long)i * G + c; if (L >= nwg) return false;
        int wgid = (int)L; { const int q = nwg / NXCD, r = nwg % NXCD, xcd = wgid % NXCD, off = wgid / NXCD; wgid = (xcd < r ? xcd * (q + 1) : r * (q + 1) + (xcd - r) * q) + off; }
        const int nig = WGM * nN, gid = wgid / nig, fm = gid * WGM, gsz = (nM - fm) < WGM ? (nM - fm) : WGM;
        u.pm = fm + ((wgid % nig) % gsz); u.pn = (wgid % nig) / gsz; return true;
    }
};
template <class Epi, class Sched>
__device__ __forceinline__ void gemm_phase(LAS unsigned char* lds, const Gemm g, const Sched& S, const Epi& E) {
    const int tid = threadIdx.x, wid = __builtin_amdgcn_readfirstlane(tid >> 6), lane = tid & 63, wr = wid >> 2, wc = wid & 3, fr = lane & 15, fq = lane >> 4;
    const int K = g.K, nt = K / BK;
    unsigned voffA[2], voffB[2];
#pragma unroll
    for (int i = 0; i < 2; ++i) { int R, C; stage_rc(tid * 16 + i * 8192, R, C); const int Rb = Epi::PERM ? ((R & ~31) + perm32(R & 31)) : R;
        voffA[i] = (unsigned)(R * K + C) * 2u; voffB[i] = (unsigned)(Rb * K + C) * 2u; }
    const size_t kstep = (size_t)(BK * 2);
    const size_t hstep = (size_t)HALF * K * 2;
    const size_t tstep = 2 * hstep;
    const unsigned ldsw = (unsigned)wid * 1024u;
    const int aoff = lds_byte(wr * 64 + fr, fq * 8), boff = lds_byte(wc * 32 + fr, fq * 8);
#define PG8_SA(b, h) (((b) * 2 + (h)) * HTB)
#define PG8_SB(b, h) ((4 + (b) * 2 + (h)) * HTB)
#define PG8_STAGE(bufoff, gbase, voff) do { _Pragma("unroll") for (int _i = 0; _i < 2; ++_i) \
        __builtin_amdgcn_global_load_lds((const unsigned*)((const char*)(gbase) + (voff)[_i]), (LAS unsigned*)(lds + (bufoff) + ldsw + _i * 8192), 16, 0, 0); } while (0)
#define PG8_LDA(dst, b, h) do { _Pragma("unroll") for (int m = 0; m < 4; ++m) _Pragma("unroll") for (int k = 0; k < 2; ++k) dst[m][k] = *(const LAS bf16x8*)(lds + PG8_SA(b, h) + aoff + m * 2048 + k * 1024); } while (0)
#define PG8_LDB(dst, b, h) do { _Pragma("unroll") for (int n = 0; n < 2; ++n) _Pragma("unroll") for (int k = 0; k < 2; ++k) dst[n][k] = *(const LAS bf16x8*)(lds + PG8_SB(b, h) + boff + n * 2048 + k * 1024); } while (0)
#define PG8_MMA(ai, bj, At, Bt) do { __builtin_amdgcn_s_setprio(1); _Pragma("unroll") for (int m = 0; m < 4; ++m) _Pragma("unroll") for (int n = 0; n < 2; ++n) _Pragma("unroll") for (int k = 0; k < 2; ++k) \
        acc[ai][bj][m][n] = __builtin_amdgcn_mfma_f32_16x16x32_bf16(Bt[n][k], At[m][k], acc[ai][bj][m][n], 0, 0, 0); __builtin_amdgcn_s_setprio(0); } while (0)
#define PG8_WAIT_V(n) asm volatile("s_waitcnt vmcnt(" #n ")" ::: "memory")
#define PG8_WAIT_L(n) asm volatile("s_waitcnt lgkmcnt(" #n ")" ::: "memory")
#define PG8_BAR __builtin_amdgcn_s_barrier()
#define PG8_SCHED __builtin_amdgcn_sched_barrier(0)
    Unit cur, nxt; int ui = 0;
    if (!S.next(0, cur)) return;
    f32x4 acc[2][2][4][2];
#pragma unroll
    for (int a = 0; a < 2; ++a)
#pragma unroll
        for (int b = 0; b < 2; ++b)
#pragma unroll
            for (int m = 0; m < 4; ++m)
#pragma unroll
                for (int n = 0; n < 2; ++n) acc[a][b][m][n] = (f32x4){0.f, 0.f, 0.f, 0.f};
    bf16x8 At[4][2], B0[2][2], B1[2][2];
    const char* cA = (const char*)g.A + (size_t)cur.pm * tstep; const char* cB = (const char*)g.Bt + (size_t)cur.pn * tstep;
    PG8_STAGE(PG8_SB(0, 0), cB, voffB); PG8_STAGE(PG8_SB(0, 1), cB + hstep, voffB); PG8_STAGE(PG8_SA(0, 0), cA, voffA); PG8_STAGE(PG8_SA(0, 1), cA + hstep, voffA);
    if (wr == 1) PG8_BAR;
    PG8_WAIT_V(2); PG8_BAR;
    PG8_STAGE(PG8_SB(1, 0), cB + kstep, voffB); PG8_STAGE(PG8_SA(1, 0), cA + kstep, voffA); PG8_STAGE(PG8_SB(1, 1), cB + hstep + kstep, voffB);
    PG8_WAIT_V(6); PG8_BAR;
    for (;;) {
        const bool has_next = S.next(ui + 1, nxt);
        const char* nA = has_next ? (const char*)g.A + (size_t)nxt.pm * tstep : cA; const char* nB = has_next ? (const char*)g.Bt + (size_t)nxt.pn * tstep : cB;
        for (int t = 0; t < nt; t += 2) {
            const bool last = (t == nt - 2);
            const char* a1 = cA + (size_t)(t + 1) * kstep;
            const char* a2 = last ? nA : cA + (size_t)(t + 2) * kstep; const char* b2 = last ? nB : cB + (size_t)(t + 2) * kstep;
            const char* a3 = a2 + kstep; const char* b3 = b2 + kstep;
            PG8_LDB(B0, 0, 0); PG8_LDB(B1, 0, 1); PG8_SCHED; PG8_LDA(At, 0, 0); PG8_STAGE(PG8_SA(1, 1), a1 + hstep, voffA);
            PG8_WAIT_V(8); PG8_WAIT_L(0); PG8_BAR; PG8_MMA(0, 0, At, B0); PG8_MMA(0, 1, At, B1); PG8_BAR; PG8_SCHED;
            PG8_LDA(At, 0, 1); PG8_STAGE(PG8_SB(0, 0), b2, voffB); PG8_STAGE(PG8_SB(0, 1), b2 + hstep, voffB); PG8_STAGE(PG8_SA(0, 0), a2, voffA);
            PG8_WAIT_V(8); PG8_WAIT_L(0); PG8_BAR; PG8_MMA(1, 0, At, B0); PG8_MMA(1, 1, At, B1); PG8_BAR; PG8_SCHED;
            PG8_LDB(B0, 1, 0); PG8_LDB(B1, 1, 1); PG8_SCHED; PG8_LDA(At, 1, 0); PG8_STAGE(PG8_SA(0, 1), a2 + hstep, voffA);
            PG8_WAIT_V(8); PG8_WAIT_L(0); PG8_BAR; PG8_MMA(0, 0, At, B0); PG8_MMA(0, 1, At, B1); PG8_BAR; PG8_SCHED;
            PG8_LDA(At, 1, 1); PG8_STAGE(PG8_SB(1, 0), b3, voffB); PG8_STAGE(PG8_SB(1, 1), b3 + hstep, voffB); PG8_STAGE(PG8_SA(1, 0), a3, voffA);
            PG8_WAIT_V(8); PG8_WAIT_L(0); PG8_BAR; PG8_MMA(1, 0, At, B0); PG8_MMA(1, 1, At, B1); PG8_BAR; PG8_SCHED;
        }
        if (wr == 0) PG8_BAR;
        E(acc, cur, wr, wc, fr, fq, lds);
        if (!has_next) break;
#pragma unroll
        for (int a = 0; a < 2; ++a)
#pragma unroll
            for (int b = 0; b < 2; ++b)
#pragma unroll
                for (int m = 0; m < 4; ++m)
#pragma unroll
                    for (int n = 0; n < 2; ++n) acc[a][b][m][n] = (f32x4){0.f, 0.f, 0.f, 0.f};
        cur = nxt; cA = nA; cB = nB; ++ui;
        if (wr == 1) PG8_BAR;
    }
    PG8_WAIT_V(0);
    PG8_BAR;
#undef PG8_SA
#undef PG8_SB
#undef PG8_STAGE
#undef PG8_LDA
#undef PG8_LDB
#undef PG8_MMA
#undef PG8_WAIT_V
#undef PG8_WAIT_L
#undef PG8_BAR
#undef PG8_SCHED
}
}

struct EpiQKVZ {
    static constexpr bool PERM = true;
    bf16_t* O; const float* rope;
    __device__ __forceinline__ void operator()(f32x4 (&acc)[2][2][4][2], const pg8::Unit& u, int wr, int wc, int fr, int fq, LAS unsigned char* lds) const {
        const float qs = 0.125f * LOG2E;
#pragma unroll
        for (int ai = 0; ai < 2; ++ai)
#pragma unroll
            for (int m = 0; m < 4; ++m) {
                const int r = u.pm * 256 + ai * 128 + wr * 64 + m * 16 + fr;
                const bool lat = r < NLAT;
                const int t = r & (SEQ - 1);
                const int val = (wc & 1) ? (t & 63) : (t >> 6);
                const f32x4 cs = *(const f32x4*)(rope + val * 32 + 4 * fq), sn = *(const f32x4*)(rope + val * 32 + 16 + 4 * fq);
                bf16_t* rowp = O + (size_t)r * NQKVZ;
#pragma unroll
                for (int bj = 0; bj < 2; ++bj) {
                    const int cb = u.pn * 256 + bj * 128 + wc * 32;
                    f32x4 t1 = acc[ai][bj][m][0], t2 = acc[ai][bj][m][1];
                    if (cb < 1280 && lat) { const f32x4 o1 = t1 * cs - t2 * sn, o2 = t2 * cs + t1 * sn; t1 = o1; t2 = o2; }
                    if (cb < 1024) { t1 = t1 * qs; t2 = t2 * qs; }
                    u32x4 w; w.x = pk2(t1[0], t1[1]); w.y = pk2(t1[2], t1[3]); w.z = pk2(t2[0], t2[1]); w.w = pk2(t2[2], t2[3]);
                    *(u32x4*)(rowp + cb + 8 * fq) = w;
                }
            }
    }
};
struct EpiResid {
    static constexpr bool PERM = true;
    const float* base_lat; float* out_lat; const float* base_ctx; float* out_ctx; const float* mod;
    __device__ __forceinline__ void operator()(f32x4 (&acc)[2][2][4][2], const pg8::Unit& u, int wr, int wc, int fr, int fq, LAS unsigned char* lds) const {
#pragma unroll
        for (int ai = 0; ai < 2; ++ai) {
            const int r0 = u.pm * 256 + ai * 128;
            const bool lat = r0 < NLAT;
            const int v = lat ? (r0 >> 12) : 4;
            const float* gp = mod + v * 3072 + 2048;
            const float* bp = lat ? base_lat : base_ctx - (size_t)NLAT * D;
            float* op = lat ? out_lat : out_ctx - (size_t)NLAT * D;
#pragma unroll
            for (int bj = 0; bj < 2; ++bj) {
                const int c0 = u.pn * 256 + bj * 128 + wc * 32 + 8 * fq;
                const f32x4 g0 = *(const f32x4*)(gp + c0), g1 = *(const f32x4*)(gp + c0 + 4);
#pragma unroll
                for (int m = 0; m < 4; ++m) {
                    const size_t off = (size_t)(r0 + wr * 64 + m * 16 + fr) * D + c0;
                    const f32x4 x0 = *(const f32x4*)(bp + off), x1 = *(const f32x4*)(bp + off + 4);
                    *(f32x4*)(op + off) = x0 + g0 * acc[ai][bj][m][0];
                    *(f32x4*)(op + off + 4) = x1 + g1 * acc[ai][bj][m][1];
                }
            }
        }
    }
};
struct EpiBf16 {
    static constexpr bool PERM = true;
    bf16_t* O; int ldc;
    __device__ __forceinline__ void operator()(f32x4 (&acc)[2][2][4][2], const pg8::Unit& u, int wr, int wc, int fr, int fq, LAS unsigned char* lds) const {
#pragma unroll
        for (int ai = 0; ai < 2; ++ai)
#pragma unroll
            for (int m = 0; m < 4; ++m) {
                bf16_t* rowp = O + (size_t)(u.pm * 256 + ai * 128 + wr * 64 + m * 16 + fr) * ldc + u.pn * 256 + wc * 32 + 8 * fq;
#pragma unroll
                for (int bj = 0; bj < 2; ++bj) {
                    const f32x4 v0 = acc[ai][bj][m][0], v1 = acc[ai][bj][m][1];
                    u32x4 w; w.x = pk2(v0[0], v0[1]); w.y = pk2(v0[2], v0[3]); w.z = pk2(v1[0], v1[1]); w.w = pk2(v1[2], v1[3]);
                    *(u32x4*)(rowp + bj * 128) = w;
                }
            }
    }
};
struct EpiGlu {
    static constexpr bool PERM = true;
    bf16_t* O; const bf16_t* UZ;
    __device__ __forceinline__ void operator()(f32x4 (&acc)[2][2][4][2], const pg8::Unit& u, int wr, int wc, int fr, int fq, LAS unsigned char* lds) const {
#pragma unroll
        for (int ai = 0; ai < 2; ++ai)
#pragma unroll
            for (int m = 0; m < 4; ++m) {
                const int r = u.pm * 256 + ai * 128 + wr * 64 + m * 16 + fr;
                const int oc = u.pn * 128 + wc * 32 + 8 * fq;
                const u32x4 zw = *(const u32x4*)(UZ + (size_t)r * NUZ + 1024 + oc);
                const f32x4 a0 = acc[ai][0][m][0], a1 = acc[ai][0][m][1], g0 = acc[ai][1][m][0], g1 = acc[ai][1][m][1];
                float o[8];
                o[0] = a0[0] * sigmoid_f(g0[0]) * silu_f(bf_lo(zw.x)); o[1] = a0[1] * sigmoid_f(g0[1]) * silu_f(bf_hi(zw.x));
                o[2] = a0[2] * sigmoid_f(g0[2]) * silu_f(bf_lo(zw.y)); o[3] = a0[3] * sigmoid_f(g0[3]) * silu_f(bf_hi(zw.y));
                o[4] = a1[0] * sigmoid_f(g1[0]) * silu_f(bf_lo(zw.z)); o[5] = a1[1] * sigmoid_f(g1[1]) * silu_f(bf_hi(zw.z));
                o[6] = a1[2] * sigmoid_f(g1[2]) * silu_f(bf_lo(zw.w)); o[7] = a1[3] * sigmoid_f(g1[3]) * silu_f(bf_hi(zw.w));
                u32x4 w; w.x = pk2(o[0], o[1]); w.y = pk2(o[2], o[3]); w.z = pk2(o[4], o[5]); w.w = pk2(o[6], o[7]);
                *(u32x4*)(O + (size_t)r * D + oc) = w;
            }
    }
};


#define XB_TMO      128
#define XB_XCNT(j)  (256  + 64 * (j))
#define XB_XSUB(j)  (1280 + 64 * (j))
#define XB_XGEN(j)  (2304 + 64 * (j))
#define XB_TOP      3328
#define XB_TOPGEN   3392
#define XCD_BAR_WORDS 3456
#define XB_SPIN_CAP (1u << 18)
__device__ __forceinline__ unsigned xb_ld(unsigned* p)              { return __hip_atomic_load(p, __ATOMIC_RELAXED, __HIP_MEMORY_SCOPE_AGENT); }
__device__ __forceinline__ unsigned xb_add(unsigned* p, unsigned v) { return __hip_atomic_fetch_add(p, v, __ATOMIC_RELAXED, __HIP_MEMORY_SCOPE_AGENT); }
__device__ __forceinline__ unsigned xb_xcc_id() { return (unsigned)__builtin_amdgcn_s_getreg((3 << 11) | 20) & 0xFu; }
#define XB_SPIN(cond, bar) do { unsigned _sp = 0; while (cond) { __builtin_amdgcn_s_sleep(1); \
    if ((++_sp & 255u) == 0u) { if (xb_ld(&(bar)[XB_TMO])) break; if (_sp > XB_SPIN_CAP) { atomicAdd(&(bar)[XB_TMO], 1u); break; } } } } while (0)
struct XcdBarrier { unsigned* bar; unsigned x; volatile LAS unsigned* st; };
__device__ __forceinline__ XcdBarrier xcd_barrier_post(unsigned* bar, volatile LAS unsigned* st) {
    XcdBarrier b; b.bar = bar; b.x = xb_xcc_id(); b.st = st;
    if (threadIdx.x == 0) (void)xb_add(&bar[XB_XCNT(b.x)], 1u);
    return b;
}
__device__ __forceinline__ void xcd_barrier_complete(unsigned* bar, unsigned x, unsigned& nloc, unsigned& nx) {
    const unsigned G = gridDim.x * gridDim.y * gridDim.z;
    unsigned sum, cnt, mine, sp = 0u;
    for (;;) {
        sum = 0u; cnt = 0u; mine = 0u;
#pragma unroll
        for (unsigned j = 0; j < 16; ++j) { const unsigned c = xb_ld(&bar[XB_XCNT(j)]); sum += c; cnt += (c > 0u) ? 1u : 0u; mine = (j == x) ? c : mine; }
        if (sum == G) break;
        __builtin_amdgcn_s_sleep(1);
        if ((++sp & 255u) == 0u) { if (xb_ld(&bar[XB_TMO])) break; if (sp > XB_SPIN_CAP) { atomicAdd(&bar[XB_TMO], 1u); break; } }
    }
    nloc = mine > 0u ? mine : 1u; nx = cnt > 0u ? cnt : 1u;
}
__device__ __forceinline__ void xcd_barrier(const XcdBarrier& b) {
    asm volatile("s_waitcnt vmcnt(0)" ::: "memory");
    __syncthreads();
    if (threadIdx.x == 0) {
        unsigned* bar = b.bar;
        __builtin_amdgcn_s_waitcnt(0);
        unsigned nloc = b.st[0], nx = b.st[1];
        if (nloc == 0u) { xcd_barrier_complete(bar, b.x, nloc, nx); b.st[0] = nloc; b.st[1] = nx; }
        const unsigned old = xb_add(&bar[XB_XSUB(b.x)], 1u);
        const unsigned gen = old / nloc;
        if (old + 1u == (gen + 1u) * nloc) {
            __builtin_amdgcn_fence(__ATOMIC_RELEASE, "agent");
            asm volatile("s_waitcnt vmcnt(0)" ::: "memory");
            const unsigned og = xb_add(&bar[XB_TOP], 1u);
            const unsigned tg = og / nx;
            if (og + 1u == (tg + 1u) * nx) xb_add(&bar[XB_TOPGEN], 1u);
            else XB_SPIN(xb_ld(&bar[XB_TOPGEN]) == tg, bar);
            __builtin_amdgcn_fence(__ATOMIC_ACQUIRE, "agent");
            xb_add(&bar[XB_XGEN(b.x)], 1u);
            asm volatile("s_waitcnt vmcnt(0)" ::: "memory");
        } else {
            XB_SPIN(xb_ld(&bar[XB_XGEN(b.x)]) == gen, bar);
            __builtin_amdgcn_fence(__ATOMIC_ACQUIRE, "agent");
            asm volatile("s_waitcnt vmcnt(0)" ::: "memory");
        }
    }
    __syncthreads();
}


struct PanelOrder {
    int ntiles, G, c;
    __device__ void init(int M, int G_, int c_) { ntiles = (M / 256) * 4; G = G_; c = c_; }
    __device__ bool next(int i, pg8::Unit& u) const {
        const int L = i * G + c; if (L >= ntiles) return false;
        if (L < 256) { const int xcd = L & 7, j = L >> 3; u.pm = xcd * 8 + (j >> 2); u.pn = j & 3; }
        else { const int Lc = L - 256; u.pm = 64 + (Lc >> 2); u.pn = Lc & 3; }
        return true;
    }
};
template <bool FINAL>
struct EpiResidNorm {
    static constexpr bool PERM = true;
    const float* xin; bf16_t* X1; float* out;
    const float* mod;
    const float* nw;
    const float* mod_next;
    bf16_t* H;
    float* stat; unsigned* cnt;
    __device__ __forceinline__ void operator()(f32x4 (&acc)[2][2][4][2], const pg8::Unit& u, int wr, int wc, int fr, int fq, LAS unsigned char* lds) const {
        LAS float* P = (LAS float*)(lds + LDS_TOP + 64);
        LAS float* S = P + 1024;
        const int tid = threadIdx.x;
        asm volatile("s_waitcnt vmcnt(0)" ::: "memory"); __syncthreads();
        LAS unsigned char* park = lds + tid * 16;
        float q[2][4];
#pragma unroll
        for (int ai = 0; ai < 2; ++ai) {
            const int r0 = u.pm * 256 + ai * 128;
            const float* gp = mod + (r0 >> 12) * 3072 + 2048;
#pragma unroll
            for (int m = 0; m < 4; ++m) q[ai][m] = 0.f;
#pragma unroll
            for (int bj = 0; bj < 2; ++bj) {
                const int c0 = u.pn * 256 + bj * 128 + wc * 32 + 8 * fq;
                const f32x4 g0 = *(const f32x4*)(gp + c0), g1 = *(const f32x4*)(gp + c0 + 4);
#pragma unroll
                for (int m = 0; m < 4; ++m) {
                    const size_t off = (size_t)(r0 + wr * 64 + m * 16 + fr) * D + c0;
                    f32x4 b0, b1;
                    if (FINAL) { const u32x4 w = *(const u32x4*)(X1 + off); b0 = (f32x4){bf_lo(w.x), bf_hi(w.x), bf_lo(w.y), bf_hi(w.y)}; b1 = (f32x4){bf_lo(w.z), bf_hi(w.z), bf_lo(w.w), bf_hi(w.w)}; }
                    else { b0 = *(const f32x4*)(xin + off); b1 = *(const f32x4*)(xin + off + 4); }
                    const f32x4 x0 = b0 + g0 * acc[ai][bj][m][0], x1 = b1 + g1 * acc[ai][bj][m][1];
                    u32x4 w; w.x = pk2(x0[0], x0[1]); w.y = pk2(x0[2], x0[3]); w.z = pk2(x1[0], x1[1]); w.w = pk2(x1[2], x1[3]);
                    *(LAS u32x4*)(park + ((ai * 2 + bj) * 4 + m) * 8192) = w;
                    if (!FINAL) *(u32x4*)(X1 + off) = w;
                    q[ai][m] += ((x0[0] * x0[0] + x0[1] * x0[1]) + (x0[2] * x0[2] + x0[3] * x0[3])) + ((x1[0] * x1[0] + x1[1] * x1[1]) + (x1[2] * x1[2] + x1[3] * x1[3]));
                }
            }
        }
#pragma unroll
        for (int ai = 0; ai < 2; ++ai)
#pragma unroll
            for (int m = 0; m < 4; ++m) {
                float t = q[ai][m]; t += __shfl_xor(t, 16); t += __shfl_xor(t, 32);
                if (fq == 0) P[(ai * 128 + wr * 64 + m * 16 + fr) * 4 + wc] = t;
            }
        __syncthreads();
        float* st = stat + (size_t)u.pm * 1024;
        if (tid < 256) { const f32x4 p = *(const LAS f32x4*)(P + tid * 4);
            __hip_atomic_store(st + u.pn * 256 + tid, (p[0] + p[1]) + (p[2] + p[3]), __ATOMIC_RELAXED, __HIP_MEMORY_SCOPE_AGENT); }
        asm volatile("s_waitcnt vmcnt(0)" ::: "memory");
        __syncthreads();
        if (tid == 0) {
            __hip_atomic_fetch_add(cnt + 64 * u.pm, 1u, __ATOMIC_RELAXED, __HIP_MEMORY_SCOPE_AGENT);
            unsigned sp = 0;
            while (__hip_atomic_load(cnt + 64 * u.pm, __ATOMIC_RELAXED, __HIP_MEMORY_SCOPE_AGENT) < 4u) { __builtin_amdgcn_s_sleep(1); if (++sp > (1u << 20)) break; }
        }
        __syncthreads();
        if (tid < 256) {
            float t = 0.f;
#pragma unroll
            for (int k = 0; k < 4; ++k) t += __hip_atomic_load(st + k * 256 + tid, __ATOMIC_RELAXED, __HIP_MEMORY_SCOPE_AGENT);
            S[tid] = 1.0f / sqrtf(t * (1.0f / D) + 1e-6f);
        }
        __syncthreads();
#pragma unroll
        for (int ai = 0; ai < 2; ++ai) {
            const int r0 = u.pm * 256 + ai * 128;
            const float* mp = FINAL ? nullptr : mod_next + (r0 >> 12) * 3072;
#pragma unroll
            for (int bj = 0; bj < 2; ++bj) {
                const int c0 = u.pn * 256 + bj * 128 + wc * 32 + 8 * fq;
                f32x4 w0 = *(const f32x4*)(nw + c0), w1 = *(const f32x4*)(nw + c0 + 4), s0, s1;
                if (!FINAL) { w0 = w0 * (*(const f32x4*)(mp + 1024 + c0) + 1.0f); w1 = w1 * (*(const f32x4*)(mp + 1024 + c0 + 4) + 1.0f); s0 = *(const f32x4*)(mp + c0); s1 = *(const f32x4*)(mp + c0 + 4); }
#pragma unroll
                for (int m = 0; m < 4; ++m) {
                    const int rl = ai * 128 + wr * 64 + m * 16 + fr;
                    const float rstd = S[rl];
                    const size_t off = (size_t)(u.pm * 256 + rl) * D + c0;
                    const u32x4 xw = *(const LAS u32x4*)(park + ((ai * 2 + bj) * 4 + m) * 8192);
                    const f32x4 x0 = {bf_lo(xw.x), bf_hi(xw.x), bf_lo(xw.y), bf_hi(xw.y)}, x1 = {bf_lo(xw.z), bf_hi(xw.z), bf_lo(xw.w), bf_hi(xw.w)};
                    if (FINAL) { *(f32x4*)(out + off) = x0 * rstd * w0; *(f32x4*)(out + off + 4) = x1 * rstd * w1; }
                    else { const f32x4 y0 = x0 * rstd * w0 + s0, y1 = x1 * rstd * w1 + s1;
                        u32x4 w; w.x = pk2(y0[0], y0[1]); w.y = pk2(y0[2], y0[3]); w.z = pk2(y1[0], y1[1]); w.w = pk2(y1[2], y1[3]);
                        *(u32x4*)(H + off) = w; }
                }
            }
        }
        __syncthreads();
    }
};

template <class Epi>
__device__ __forceinline__ void gemm64_tile(LAS unsigned char* lds, const bf16_t* A, const bf16_t* Bt, const Epi& E) {
    constexpr int K = 1024, BK = 128, PITCH = BK * 2 + 16, NKT = K / BK;
    const int tid = threadIdx.x, lane = tid & 63, wave = __builtin_amdgcn_readfirstlane(tid >> 6), fr = lane & 15, fq = lane >> 4, wr = wave >> 1, wc = wave & 1;
    LAS unsigned char* As = lds; LAS unsigned char* Bs = lds + 64 * PITCH;
    const int srow = tid >> 4, sch = tid & 15;
    const bf16_t* ga = A + (size_t)srow * K + sch * 8; const bf16_t* gb = Bt + (size_t)srow * K + sch * 8;
    u32x4 ra[2], rb[2];
#pragma unroll
    for (int i = 0; i < 2; ++i) { ra[i] = *(const u32x4*)(ga + (size_t)(32 * i) * K); rb[i] = *(const u32x4*)(gb + (size_t)(32 * i) * K); }
    f32x4 acc[2] = {(f32x4){0.f, 0.f, 0.f, 0.f}, (f32x4){0.f, 0.f, 0.f, 0.f}};
    for (int kt = 0; kt < NKT; ++kt) {
        __syncthreads();
#pragma unroll
        for (int i = 0; i < 2; ++i) { *(LAS u32x4*)(As + (srow + 32 * i) * PITCH + sch * 16) = ra[i]; *(LAS u32x4*)(Bs + (srow + 32 * i) * PITCH + sch * 16) = rb[i]; }
        __syncthreads();
        if (kt + 1 < NKT) {
#pragma unroll
            for (int i = 0; i < 2; ++i) { ra[i] = *(const u32x4*)(ga + (size_t)(32 * i) * K + (kt + 1) * BK); rb[i] = *(const u32x4*)(gb + (size_t)(32 * i) * K + (kt + 1) * BK); }
        }
#pragma unroll
        for (int ks = 0; ks < 4; ++ks) {
            const bf16x8 Af = *(const LAS bf16x8*)(As + (16 * wr + fr) * PITCH + (32 * ks + 8 * fq) * 2);
#pragma unroll
            for (int n = 0; n < 2; ++n) {
                const bf16x8 Bf = *(const LAS bf16x8*)(Bs + (32 * wc + 16 * n + fr) * PITCH + (32 * ks + 8 * fq) * 2);
                acc[n] = __builtin_amdgcn_mfma_f32_16x16x32_bf16(Bf, Af, acc[n], 0, 0, 0);
            }
        }
    }
    __syncthreads();
    E(acc, wr, wc, fr, fq, lds);
}
struct Epi64Bf16 {
    bf16_t* O; int ldc;
    __device__ __forceinline__ void operator()(f32x4 (&acc)[2], int wr, int wc, int fr, int fq, LAS unsigned char* lds) const {
#pragma unroll
        for (int n = 0; n < 2; ++n) { u32x2 w; w.x = pk2(acc[n][0], acc[n][1]); w.y = pk2(acc[n][2], acc[n][3]);
            *(u32x2*)(O + (size_t)(16 * wr + fr) * ldc + 32 * wc + 16 * n + 4 * fq) = w; }
    }
};
struct Epi64ResidNorm {
    const float* base; const float* modc; const float* nw; const float* modc_next; bf16_t* H;
    int col0; float* stat; unsigned* cnt;
    int cb;
    __device__ __forceinline__ void operator()(f32x4 (&acc)[2], int wr, int wc, int fr, int fq, LAS unsigned char* lds) const {
        LAS float* P = (LAS float*)(lds + LDS_TOP + 64);
        LAS float* S = P + 128;
        const int tid = threadIdx.x, row = 16 * wr + fr;
        f32x4 x[2]; float q = 0.f;
#pragma unroll
        for (int n = 0; n < 2; ++n) { const int c = col0 + 32 * wc + 16 * n + 4 * fq;
            x[n] = *(const f32x4*)(base + (size_t)row * D + c) + *(const f32x4*)(modc + 2048 + c) * acc[n];
            q += (x[n][0] * x[n][0] + x[n][1] * x[n][1]) + (x[n][2] * x[n][2] + x[n][3] * x[n][3]); }
        q += __shfl_xor(q, 16); q += __shfl_xor(q, 32);
        if (fq == 0) P[row * 2 + wc] = q;
        __syncthreads();
        if (tid < 64) __hip_atomic_store(stat + cb * 64 + tid, P[tid * 2] + P[tid * 2 + 1], __ATOMIC_RELAXED, __HIP_MEMORY_SCOPE_AGENT);
        asm volatile("s_waitcnt vmcnt(0)" ::: "memory");
        __syncthreads();
        if (tid == 0) {
            __hip_atomic_fetch_add(cnt, 1u, __ATOMIC_RELAXED, __HIP_MEMORY_SCOPE_AGENT);
            unsigned sp = 0;
            while (__hip_atomic_load(cnt, __ATOMIC_RELAXED, __HIP_MEMORY_SCOPE_AGENT) < 16u) { __builtin_amdgcn_s_sleep(1); if (++sp > (1u << 20)) break; }
        }
        __syncthreads();
        if (tid < 64) { float t = 0.f;
#pragma unroll
            for (int k = 0; k < 16; ++k) t += __hip_atomic_load(stat + k * 64 + tid, __ATOMIC_RELAXED, __HIP_MEMORY_SCOPE_AGENT);
            S[tid] = 1.0f / sqrtf(t * (1.0f / D) + 1e-6f); }
        __syncthreads();
        const float rstd = S[row];
#pragma unroll
        for (int n = 0; n < 2; ++n) { const int c = col0 + 32 * wc + 16 * n + 4 * fq;
            const f32x4 y = x[n] * rstd * *(const f32x4*)(nw + c) * (*(const f32x4*)(modc_next + 1024 + c) + 1.0f) + *(const f32x4*)(modc_next + c);
            u32x2 w; w.x = pk2(y[0], y[1]); w.y = pk2(y[2], y[3]);
            *(u32x2*)(H + (size_t)row * D + c) = w; }
        __syncthreads();
    }
};

struct Args {
    const float* in[22];
    float* out;
    unsigned char* ws;
    int ph_lo, ph_hi, pad, pad2;
};

__device__ __forceinline__ void transpose_item(const float* W, int K, int N, bf16_t* WT, int k0, int n0, int dst_row0, LAS float* scr, int lane, bool perm = false) {
#pragma unroll 8
    for (int i = 0; i < 32; ++i) { const int kk = 2 * i + (lane >> 5); scr[kk * 33 + (lane & 31)] = W[(size_t)(k0 + kk) * N + n0 + (lane & 31)]; }
    WAVE_LDS_FENCE();
    const int c = lane & 7;
#pragma unroll
    for (int j = 0; j < 4; ++j) { const int n = (lane >> 3) + 8 * j; const LAS float* s = scr + (8 * c) * 33 + n;
        u32x4 o; o.x = pk2(s[0 * 33], s[1 * 33]); o.y = pk2(s[2 * 33], s[3 * 33]); o.z = pk2(s[4 * 33], s[5 * 33]); o.w = pk2(s[6 * 33], s[7 * 33]);
        const int nd = perm ? 8 * ((n & 15) >> 2) + 4 * (n >> 4) + (n & 3) : n;
        *(u32x4*)(WT + (size_t)(dst_row0 + nd) * K + k0 + 8 * c) = o; }
    WAVE_LDS_FENCE();
}

__device__ __forceinline__ void p0_prologue(const Args& a, LAS unsigned char* lds) {
    const int tid = threadIdx.x, lane = tid & 63, wave = tid >> 6, bid = blockIdx.x, G = gridDim.x;
    unsigned char* ws = a.ws;
    if (bid < 192) {
        LAS float* sv = (LAS float*)lds;
        LAS float* red = (LAS float*)(lds + 20480);
        const int layer = bid / 96, n0 = (bid % 96) * 32;
        const int c4 = lane & 7, kk = lane >> 3;
        const float* wp = a.in[5] + (size_t)layer * D * 3072 + (size_t)(wave * 128 + kk) * 3072 + n0 + 4 * c4;
        f32x4 w[16];
#pragma unroll
        for (int i = 0; i < 16; ++i) w[i] = *(const f32x4*)(wp + (size_t)(8 * i) * 3072);
        float cx[10];
#pragma unroll
        for (int j = 0; j < 10; ++j) { const int idx = tid + 512 * j, v = idx >> 10, k = idx & 1023; cx[j] = v < 4 ? a.in[1][v * D + k] : a.in[3][k]; }
#pragma unroll
        for (int j = 0; j < 10; ++j) sv[tid + 512 * j] = cx[j] / (1.0f + expf(-cx[j]));
        __syncthreads();
        f32x4 acc[5];
#pragma unroll
        for (int v = 0; v < 5; ++v) acc[v] = (f32x4){0.f, 0.f, 0.f, 0.f};
#pragma unroll
        for (int i = 0; i < 16; ++i) {
#pragma unroll
            for (int v = 0; v < 5; ++v) acc[v] += w[i] * sv[v * D + wave * 128 + 8 * i + kk];
        }
#pragma unroll
        for (int v = 0; v < 5; ++v)
#pragma unroll
            for (int j = 0; j < 4; ++j) { float t = acc[v][j]; t += __shfl_xor(t, 8); t += __shfl_xor(t, 16); t += __shfl_xor(t, 32); acc[v][j] = t; }
        if (kk == 0) {
#pragma unroll
            for (int v = 0; v < 5; ++v) *(LAS f32x4*)(red + (wave * 5 + v) * 32 + 4 * c4) = acc[v];
        }
        __syncthreads();
        if (tid < 160) { const int v = tid >> 5, c = tid & 31; float t = 0.f;
#pragma unroll
            for (int q = 0; q < 8; ++q) t += red[(q * 5 + v) * 32 + c];
            ((float*)(ws + WS_MOD))[(layer * 5 + v) * 3072 + n0 + c] = t + a.in[6][layer * 3072 + n0 + c]; }
        __syncthreads();
    }
    if (bid >= 192 && bid < 208) {
        const int id = (bid - 192) * 512 + tid;
        const int dg = id >> 6, p = id & 63;
        const float lre = a.in[11][id], lim = a.in[12][id], dt = expf(a.in[13][dg]);
        const float mag = expf(lre * dt), ar = mag * cosf(lim * dt), ai = mag * sinf(lim * dt);
        float pr = ar, pi = ai;
#pragma unroll
        for (int s = 0; s < 6; ++s) { const float nr = pr * pr - pi * pi, ni = 2.f * pr * pi; pr = nr; pi = ni; }
        ((f32x4*)(ws + WS_APOW))[id] = (f32x4){ar, ai, pr, pi};
        const float den = lre * lre + lim * lim, nr_ = ar - 1.0f, ni_ = ai;
        const float cr = (nr_ * lre + ni_ * lim) / den, ci = (ni_ * lre - nr_ * lim) / den;
        bf16_t* Bb = (bf16_t*)(ws + WS_BB) + (size_t)dg * 128 * 16;
        bf16_t* Cm = (bf16_t*)(ws + WS_CM) + (size_t)dg * 16 * 128;
        const float* bre = a.in[14] + (size_t)id * 16; const float* bim = a.in[15] + (size_t)id * 16;
#pragma unroll
        for (int h = 0; h < 16; h += 2) {
            const float r0 = cr * bre[h] - ci * bim[h], i0 = cr * bim[h] + ci * bre[h], r1 = cr * bre[h + 1] - ci * bim[h + 1], i1 = cr * bim[h + 1] + ci * bre[h + 1];
            *(unsigned*)(Bb + (2 * p) * 16 + h) = pk2(r0, r1); *(unsigned*)(Bb + (2 * p + 1) * 16 + h) = pk2(i0, i1);
        }
        const float* cre = a.in[16] + (size_t)dg * 16 * 64; const float* cim = a.in[17] + (size_t)dg * 16 * 64;
#pragma unroll
        for (int h = 0; h < 16; ++h) *(unsigned*)(Cm + h * 128 + 2 * p) = pk2(cre[h * 64 + p], -cim[h * 64 + p]);
    }
    if (bid >= 208 && bid < 210) {
        const int id = (bid - 208) * 512 + tid;
        const int val = id >> 4, f = id & 15;
        const float inv = powf(10000.0f, -(float)f / 16.0f), ang = (float)val * inv;
        float* rp = (float*)(ws + WS_ROPE);
        rp[val * 32 + f] = cosf(ang); rp[val * 32 + 16 + f] = sinf(ang);
    }
    LAS float* scr = (LAS float*)(lds + wave * 16384);
    const int gw = bid * 8 + wave, NGW = G * 8;
    constexpr int I0 = 16 * 80, I1 = 16 * 32;
    for (int it = gw; it < I0 + I1; it += NGW) {
        int r = it;
        if (r < I0) { const int nb = r % 80, kb = r / 80; transpose_item(a.in[7], D, NQKVZ, (bf16_t*)(ws + WS_WQKVZ), kb * 64, nb * 32, nb * 32, scr, lane, nb * 32 < 1280); continue; } r -= I0;
        { const int nb = r % 32, kb = r / 32; transpose_item(a.in[9], D, D, (bf16_t*)(ws + WS_WAO), kb * 64, nb * 32, nb * 32, scr, lane); }
    }
}
__device__ __forceinline__ void p2_late_transposes(const Args& a, LAS unsigned char* lds, int w0) {
    const int tid = threadIdx.x, lane = tid & 63, wave = tid >> 6, bid = blockIdx.x, G = gridDim.x;
    unsigned char* ws = a.ws;
    LAS float* scr = (LAS float*)(lds + wave * 16384);
    const bool all = (w0 <= 0 || w0 >= G);
    if (!all && bid < w0) return;
    const int gw = ((all ? bid : bid - w0) * 8 + wave), NGW = (all ? G : G - w0) * 8;
    constexpr int I2 = 16 * 64, I3 = 16 * 64, I4 = 16 * 32;
    for (int it = gw; it < I2 + I3 + I4; it += NGW) {
        int r = it;
        if (r < I2) { const int nb = r % 64, kb = r / 64; transpose_item(a.in[10], D, NUZ, (bf16_t*)(ws + WS_WSIN), kb * 64, nb * 32, nb * 32, scr, lane); continue; } r -= I2;
        if (r < I3) { const int nb = r % 64, kb = r / 64, n0 = nb * 32; const int dst = 256 * ((n0 & 1023) >> 7) + 128 * (n0 >> 10) + (n0 & 127);
                      transpose_item(a.in[19], D, NUZ, (bf16_t*)(ws + WS_WGLU), kb * 64, n0, dst, scr, lane); continue; } r -= I3;
        { const int nb = r % 32, kb = r / 32; transpose_item(a.in[20], D, D, (bf16_t*)(ws + WS_WSOUT), kb * 64, nb * 32, nb * 32, scr, lane); }
    }
}

__device__ __forceinline__ const float* norm_src(const float* xlat, const float* xctx, int r) { return r < NLAT ? xlat + (size_t)r * D : xctx + (size_t)(r - NLAT) * D; }
__device__ __forceinline__ void norm_mod_phase(const float* xlat, const float* xctx, const float* nw, const float* mod, bf16_t* H) {
    const int lane = threadIdx.x & 63, gw = blockIdx.x * 8 + (threadIdx.x >> 6), NGW = gridDim.x * 8;
    f32x4 w4[4];
#pragma unroll
    for (int j = 0; j < 4; ++j) w4[j] = ((const f32x4*)nw)[lane + 64 * j];
    f32x4 nx[4];
    if (gw < MTOT) { const float* xr = norm_src(xlat, xctx, gw);
#pragma unroll
        for (int j = 0; j < 4; ++j) nx[j] = ((const f32x4*)xr)[lane + 64 * j]; }
    for (int r = gw; r < MTOT; r += NGW) {
        f32x4 v[4];
#pragma unroll
        for (int j = 0; j < 4; ++j) v[j] = nx[j];
        if (r + NGW < MTOT) { const float* xr = norm_src(xlat, xctx, r + NGW);
#pragma unroll
            for (int j = 0; j < 4; ++j) nx[j] = ((const f32x4*)xr)[lane + 64 * j]; }
        const float* mp = mod + (r < NLAT ? (r >> 12) : 4) * 3072;
        float s = 0.f;
#pragma unroll
        for (int j = 0; j < 4; ++j) s += (v[j].x * v[j].x + v[j].y * v[j].y) + (v[j].z * v[j].z + v[j].w * v[j].w);
        const float rstd = 1.0f / sqrtf(wave_sum(s) * (1.0f / D) + 1e-6f);
        unsigned long long* o8 = (unsigned long long*)(H + (size_t)r * D) + lane;
#pragma unroll
        for (int j = 0; j < 4; ++j) {
            const f32x4 sh = ((const f32x4*)mp)[lane + 64 * j], sc = ((const f32x4*)(mp + 1024))[lane + 64 * j];
            const f32x4 y = v[j] * rstd * w4[j] * (sc + 1.0f) + sh;
            o8[64 * j] = (unsigned long long)pk2(y.x, y.y) | ((unsigned long long)pk2(y.z, y.w) << 32);
        }
    }
}
__device__ __forceinline__ void final_norm_phase(float* out, const float* nw) {
    const int lane = threadIdx.x & 63, gw = blockIdx.x * 8 + (threadIdx.x >> 6), NGW = gridDim.x * 8;
    f32x4 w4[4];
#pragma unroll
    for (int j = 0; j < 4; ++j) w4[j] = ((const f32x4*)nw)[lane + 64 * j];
    f32x4 nx[4];
#pragma unroll
    for (int j = 0; j < 4; ++j) nx[j] = ((const f32x4*)(out + (size_t)gw * D))[lane + 64 * j];
    for (int r = gw; r < NLAT; r += NGW) {
        f32x4* xr = (f32x4*)(out + (size_t)r * D);
        f32x4 v[4]; float s = 0.f;
#pragma unroll
        for (int j = 0; j < 4; ++j) v[j] = nx[j];
        if (r + NGW < NLAT) {
#pragma unroll
            for (int j = 0; j < 4; ++j) nx[j] = ((const f32x4*)(out + (size_t)(r + NGW) * D))[lane + 64 * j]; }
#pragma unroll
        for (int j = 0; j < 4; ++j) s += (v[j].x * v[j].x + v[j].y * v[j].y) + (v[j].z * v[j].z + v[j].w * v[j].w);
        const float rstd = 1.0f / sqrtf(wave_sum(s) * (1.0f / D) + 1e-6f);
#pragma unroll
        for (int j = 0; j < 4; ++j) xr[lane + 64 * j] = v[j] * rstd * w4[j];
    }
}

constexpr int KS_PITCH = 144, VT_PITCH = 264, VT_OFF = 128 * KS_PITCH;
constexpr int ATT_BUF = 36864;
constexpr float ATT_THR = 8.0f;
#define MFMA32(a, b, c) __builtin_amdgcn_mfma_f32_32x32x16_bf16((a), (b), (c), 0, 0, 0)
__device__ __forceinline__ void attn_phase(LAS unsigned char* lds, const bf16_t* QKVZ, bf16_t* AO, const float* sink) {
    const int tid = threadIdx.x, lane = tid & 63, wave = __builtin_amdgcn_readfirstlane(tid >> 6);
    const int ql = lane & 31, hh = lane >> 5, hq = wave & 3, qh = wave >> 2;
    int pb = 0;
    const bool bal = gridDim.x == 256;
    const int bi = blockIdx.x;
    int ctx_it = -1;
    { const int m = bi & 127, h = bi >> 7;
      if (m < 4) ctx_it = h * 4 + m; else if (m >= 124) ctx_it = 8 + h * 4 + (m - 124); else if (m >= 116) ctx_it = 16 + h * 8 + (m - 116); }
    const int nit = bal ? (ctx_it >= 0 ? 3 : 2) : (544 - bi + (int)gridDim.x - 1) / (int)gridDim.x;
#define ATT_ITEM(kk) (bal ? ((kk) == 0 ? bi : ((kk) == 1 ? 256 + ((bi + 8) & 255) : 512 + ctx_it)) : bi + (kk) * (int)gridDim.x)
#define ATT_QROW0(it) ((it) < 512 ? ((it) >> 7) * SEQ + (((it) >> 2) & 31) * 128 : NLAT + (((it) - 512) >> 3) * CTXL + ((((it) - 512) >> 2) & 1) * 128)
#define ATT_LOADQ(Q, it) do { const int qr0_ = ATT_QROW0(it), hd_ = ((it) & 3) * 4 + hq; _Pragma("unroll") for (int qt = 0; qt < 2; ++qt) _Pragma("unroll") for (int ks = 0; ks < 4; ++ks) \
        Q[qt][ks] = *(const bf16x8*)(QKVZ + (size_t)(qr0_ + 64 * qh + 32 * qt + ql) * NQKVZ + hd_ * 64 + 16 * ks + 8 * hh); } while (0)
#define ATT_LOADKV0(it) do { const bool ic_ = (it) >= 512; const int b_ = ic_ ? ((it) - 512) >> 3 : (it) >> 7, nb_ = ((it) >> 2) & 31, kh_ = (it) & 3; \
        const int kr0_ = ic_ ? NLAT + b_ * CTXL : b_ * SEQ + (nb_ == 0 ? 0 : nb_ - 1) * 128; \
        _Pragma("unroll") for (int i = 0; i < 2; ++i) { const int c = tid + 512 * i, key = c >> 3, dc = c & 7; kr[i] = *(const u32x4*)(QKVZ + (size_t)(kr0_ + key) * NQKVZ + 1024 + kh_ * 64 + dc * 8); } \
        va = *(const u32x4*)(QKVZ + (size_t)(kr0_ + 2 * kp) * NQKVZ + 1280 + kh_ * 64 + dcv * 8); \
        vb = *(const u32x4*)(QKVZ + (size_t)(kr0_ + 2 * kp + 1) * NQKVZ + 1280 + kh_ * 64 + dcv * 8); } while (0)
    const int kp = tid & 63, dcv = tid >> 6;
    u32x4 kr[2], va, vb;
    bf16x8 Qn[2][4];
    if (nit > 0) { ATT_LOADQ(Qn, ATT_ITEM(0)); ATT_LOADKV0(ATT_ITEM(0)); }
    for (int k = 0; k < nit; ++k) {
        const int item = ATT_ITEM(k);
        int b, kh, qrow0, nblk; bool isctx;
        if (item < 512) { b = item >> 7; nblk = (item >> 2) & 31; kh = item & 3; qrow0 = b * SEQ + nblk * 128; isctx = false; }
        else { const int r = item - 512; b = r >> 3; kh = r & 3; qrow0 = NLAT + b * CTXL + ((r >> 2) & 1) * 128; isctx = true; nblk = 0; }
        const int head = kh * 4 + hq;
        bf16x8 Qf[2][4];
#pragma unroll
        for (int qt = 0; qt < 2; ++qt)
#pragma unroll
            for (int ks = 0; ks < 4; ++ks) Qf[qt][ks] = Qn[qt][ks];
        f32x16 O[2][2];
#pragma unroll
        for (int dt = 0; dt < 2; ++dt)
#pragma unroll
            for (int qt = 0; qt < 2; ++qt)
#pragma unroll
                for (int i = 0; i < 16; ++i) O[dt][qt][i] = 0.f;
        const float sk = sink[head] * LOG2E;
        float m_[2] = {sk, sk}, l_[2]; l_[0] = l_[1] = (hh == 0) ? 1.0f : 0.0f;
        const int ntiles = isctx ? 2 : 5;
        int tcur = (!isctx && nblk == 0) ? 1 : 0;
        while (tcur < ntiles) {
            const int mode = (!isctx && tcur == 0) ? 1 : ((!isctx && tcur == 2) ? 2 : 0);
            LAS unsigned char* Ks = lds + pb * ATT_BUF; LAS unsigned char* Vt = Ks + VT_OFF; pb ^= 1;
            {
#pragma unroll
                for (int i = 0; i < 2; ++i) { const int c = tid + 512 * i, key = c >> 3, dc = c & 7; *(LAS u32x4*)(Ks + key * KS_PITCH + dc * 16) = kr[i]; }
                LAS unsigned char* vp = Vt + (dcv * 8) * VT_PITCH + kp * 4;
#pragma unroll
                for (int e = 0; e < 4; ++e) {
                    const unsigned wa = va[e], wb = vb[e];
                    *(LAS unsigned*)(vp + (2 * e) * VT_PITCH) = (wa & 0xffffu) | (wb << 16);
                    *(LAS unsigned*)(vp + (2 * e + 1) * VT_PITCH) = (wa >> 16) | (wb & 0xffff0000u);
                }
            }
            __syncthreads();
            int tnext = tcur + 1; if (!isctx && tnext == 2 && nblk == 31) tnext = 3;
            if (tnext < ntiles) {
                const int krow0 = isctx ? NLAT + b * CTXL + tnext * 128 : (tnext < 3 ? b * SEQ + (nblk - 1 + tnext) * 128 : NLAT + b * CTXL + (tnext - 3) * 128);
#pragma unroll
                for (int i = 0; i < 2; ++i) { const int c = tid + 512 * i, key = c >> 3, dc = c & 7; kr[i] = *(const u32x4*)(QKVZ + (size_t)(krow0 + key) * NQKVZ + 1024 + kh * 64 + dc * 8); }
                va = *(const u32x4*)(QKVZ + (size_t)(krow0 + 2 * kp) * NQKVZ + 1280 + kh * 64 + dcv * 8);
                vb = *(const u32x4*)(QKVZ + (size_t)(krow0 + 2 * kp + 1) * NQKVZ + 1280 + kh * 64 + dcv * 8);
            }
            tcur = tnext;
#pragma unroll 1
            for (int sub = 0; sub < 2; ++sub) {
                if ((mode == 1 && sub < qh) || (mode == 2 && sub > qh)) continue;
                f32x16 S[2][2];
#pragma unroll
                for (int kt = 0; kt < 2; ++kt)
#pragma unroll
                    for (int qt = 0; qt < 2; ++qt)
#pragma unroll
                        for (int i = 0; i < 16; ++i) S[kt][qt][i] = -m_[qt];
#pragma unroll
                for (int kt = 0; kt < 2; ++kt)
#pragma unroll
                    for (int ks = 0; ks < 4; ++ks) {
                        const bf16x8 Kf = *(const LAS bf16x8*)(Ks + (64 * sub + 32 * kt + ql) * KS_PITCH + (16 * ks + 8 * hh) * 2);
                        S[kt][0] = MFMA32(Kf, Qf[0][ks], S[kt][0]);
                        S[kt][1] = MFMA32(Kf, Qf[1][ks], S[kt][1]);
                    }
                if (mode) {
#pragma unroll
                    for (int kt = 0; kt < 2; ++kt)
#pragma unroll
                        for (int qt = 0; qt < 2; ++qt)
#pragma unroll
                            for (int i = 0; i < 16; ++i) {
                                const int j = 64 * sub + 32 * kt + 8 * (i >> 2) + 4 * hh + (i & 3), iq = 64 * qh + 32 * qt + ql;
                                const bool valid = (mode == 1) ? (j >= iq) : (j <= iq);
                                S[kt][qt][i] = valid ? S[kt][qt][i] : -1e30f;
                            }
                }
#pragma unroll
                for (int qt = 0; qt < 2; ++qt) {
                    float mx = S[0][qt][0];
#pragma unroll
                    for (int kt = 0; kt < 2; ++kt)
#pragma unroll
                        for (int i = 0; i < 16; ++i) mx = fmaxf(mx, S[kt][qt][i]);
                    { const auto rr = __builtin_amdgcn_permlane32_swap(__float_as_uint(mx), __float_as_uint(mx), false, false);
                      mx = fmaxf(__uint_as_float(rr[0]), __uint_as_float(rr[1])); }
                    float alpha = 1.0f;
                    if (!__builtin_expect(__all(mx <= ATT_THR), 1)) {
                        const float dlt = fmaxf(mx, 0.0f);
                        alpha = fast_exp2(-dlt); m_[qt] += dlt;
#pragma unroll
                        for (int i = 0; i < 16; ++i) { O[0][qt][i] *= alpha; O[1][qt][i] *= alpha; }
#pragma unroll
                        for (int kt = 0; kt < 2; ++kt)
#pragma unroll
                            for (int i = 0; i < 16; ++i) S[kt][qt][i] -= dlt;
                    }
                    float rs = 0.f;
#pragma unroll
                    for (int kt = 0; kt < 2; ++kt)
#pragma unroll
                        for (int i = 0; i < 16; ++i) { const float p = fast_exp2(S[kt][qt][i]); S[kt][qt][i] = p; rs += p; }
                    l_[qt] = l_[qt] * alpha + rs;
                }
#pragma unroll
                for (int kt = 0; kt < 2; ++kt)
#pragma unroll
                    for (int s2 = 0; s2 < 2; ++s2) {
                        bf16x8 Pf[2];
#pragma unroll
                        for (int qt = 0; qt < 2; ++qt) {
                            u32x4 w; w.x = pk2(S[kt][qt][8 * s2 + 0], S[kt][qt][8 * s2 + 1]); w.y = pk2(S[kt][qt][8 * s2 + 2], S[kt][qt][8 * s2 + 3]);
                            w.z = pk2(S[kt][qt][8 * s2 + 4], S[kt][qt][8 * s2 + 5]); w.w = pk2(S[kt][qt][8 * s2 + 6], S[kt][qt][8 * s2 + 7]);
                            Pf[qt] = __builtin_bit_cast(bf16x8, w);
                        }
#pragma unroll
                        for (int dt = 0; dt < 2; ++dt) {
                            const LAS unsigned char* ap = Vt + (32 * dt + ql) * VT_PITCH + (64 * sub + 32 * kt + 16 * s2 + 4 * hh) * 2;
                            const u32x2 lo = *(const LAS u32x2*)ap, hi = *(const LAS u32x2*)(ap + 16);
                            u32x4 w; w.x = lo.x; w.y = lo.y; w.z = hi.x; w.w = hi.y;
                            const bf16x8 Vf = __builtin_bit_cast(bf16x8, w);
                            O[dt][0] = MFMA32(Vf, Pf[0], O[dt][0]);
                            O[dt][1] = MFMA32(Vf, Pf[1], O[dt][1]);
                        }
                    }
            }
        }
        u32x2 zr[2][2][4];
#pragma unroll
        for (int qt = 0; qt < 2; ++qt)
#pragma unroll
            for (int dt = 0; dt < 2; ++dt)
#pragma unroll
                for (int a4 = 0; a4 < 4; ++a4)
                    zr[qt][dt][a4] = *(const u32x2*)(QKVZ + (size_t)(qrow0 + 64 * qh + 32 * qt + ql) * NQKVZ + 1536 + head * 64 + 32 * dt + 8 * a4 + 4 * hh);
        if (k + 1 < nit) { ATT_LOADQ(Qn, ATT_ITEM(k + 1)); ATT_LOADKV0(ATT_ITEM(k + 1)); }
#pragma unroll
        for (int qt = 0; qt < 2; ++qt) {
            const auto lr_ = __builtin_amdgcn_permlane32_swap(__float_as_uint(l_[qt]), __float_as_uint(l_[qt]), false, false);
            const float lt = __uint_as_float(lr_[0]) + __uint_as_float(lr_[1]), inv = 1.0f / lt;
            const size_t row = (size_t)(qrow0 + 64 * qh + 32 * qt + ql);
#pragma unroll
            for (int dt = 0; dt < 2; ++dt)
#pragma unroll
                for (int a4 = 0; a4 < 4; ++a4) {
                    const int d0 = 32 * dt + 8 * a4 + 4 * hh;
                    const u32x2 zw = zr[qt][dt][a4];
                    const float o0 = O[dt][qt][4 * a4 + 0] * inv * silu_f(bf_lo(zw.x)), o1 = O[dt][qt][4 * a4 + 1] * inv * silu_f(bf_hi(zw.x));
                    const float o2 = O[dt][qt][4 * a4 + 2] * inv * silu_f(bf_lo(zw.y)), o3 = O[dt][qt][4 * a4 + 3] * inv * silu_f(bf_hi(zw.y));
                    u32x2 w; w.x = pk2(o0, o1); w.y = pk2(o2, o3);
                    *(u32x2*)(AO + row * D + head * 64 + d0) = w;
                }
        }
    }
    __syncthreads();
}

constexpr int BU_PITCH = 132;
constexpr int XB_PITCH = 272;
template <bool OUT>
__device__ __forceinline__ void s5_chunk(LAS unsigned char* wl, const bf16x4 (&Uf)[4], const bf16x4 (&Bf)[8], const bf16x8 (&Cf)[4],
                                         float ar, float ai, float& xr, float& xi, int dir, f32x4 (&accY)[4], int lane) {
    LAS float* bu = (LAS float*)wl;
    LAS unsigned char* xb = wl + 16 * BU_PITCH * 4;
    const int fr = lane & 15, fq = lane >> 4;
#pragma unroll
    for (int mm = 0; mm < 4; ++mm) {
        const int m = dir ? 3 - mm : mm;
#pragma unroll
        for (int nt = 0; nt < 8; ++nt) {
            f32x4 c = {0.f, 0.f, 0.f, 0.f};
            c = __builtin_amdgcn_mfma_f32_16x16x16bf16_1k(m == 0 ? Uf[0] : m == 1 ? Uf[1] : m == 2 ? Uf[2] : Uf[3], Bf[nt], c, 0, 0, 0);
#pragma unroll
            for (int i = 0; i < 4; ++i) bu[(4 * fq + i) * BU_PITCH + 16 * nt + fr] = c[i];
        }
        WAVE_LDS_FENCE();
#pragma unroll
        for (int rr = 0; rr < 16; ++rr) {
            const int r = dir ? 15 - rr : rr;
            const f32x2 bb = *(const LAS f32x2*)(bu + r * BU_PITCH + 2 * lane);
            const float nr = fmaf(ar, xr, fmaf(-ai, xi, bb.x)), ni = fmaf(ar, xi, fmaf(ai, xr, bb.y));
            xr = nr; xi = ni;
            if (OUT) *(LAS unsigned*)(xb + r * XB_PITCH + lane * 4) = pk2(nr, ni);
        }
        if (OUT) {
            WAVE_LDS_FENCE();
            f32x4 y = (m == 0 ? accY[0] : m == 1 ? accY[1] : m == 2 ? accY[2] : accY[3]);
#pragma unroll
            for (int ks = 0; ks < 4; ++ks) {
                const bf16x8 Xf = *(const LAS bf16x8*)(xb + fr * XB_PITCH + (8 * fq + 32 * ks) * 2);
                y = __builtin_amdgcn_mfma_f32_16x16x32_bf16(Cf[ks], Xf, y, 0, 0, 0);
            }
            if (m == 0) accY[0] = y; else if (m == 1) accY[1] = y; else if (m == 2) accY[2] = y; else accY[3] = y;
        }
    }
}
__device__ __forceinline__ int chunk_rowbase(int b, int dir, int c) {
    if (dir == 0) return c < 4 ? NLAT + b * CTXL + 64 * c : b * SEQ + 64 * (c - 4);
    return c < 4 ? NLAT + b * CTXL + 64 * (3 - c) : b * SEQ + 64 * (63 - (c - 4));
}
__device__ __forceinline__ void load_uf(bf16x4 (&Uf)[4], const bf16_t* UZ, int rowbase, int g, int lane) {
#pragma unroll
    for (int m = 0; m < 4; ++m) Uf[m] = *(const bf16x4*)(UZ + (size_t)(rowbase + 16 * m + (lane & 15)) * NUZ + 16 * g + 4 * (lane >> 4));
}
__device__ __forceinline__ void cmul(float& xr, float& xi, float ar, float ai) { const float nr = xr * ar - xi * ai, ni = xr * ai + xi * ar; xr = nr; xi = ni; }
__device__ __forceinline__ bf16x4 cscale_bf(const bf16x4 re, const bf16x4 im, float wr, float wi, bool want_im) {
    bf16x4 o;
#pragma unroll
    for (int k = 0; k < 4; k += 2) {
        const float r0 = __uint_as_float((unsigned)(unsigned short)re[k] << 16), r1 = __uint_as_float((unsigned)(unsigned short)re[k + 1] << 16);
        const float i0 = __uint_as_float((unsigned)(unsigned short)im[k] << 16), i1 = __uint_as_float((unsigned)(unsigned short)im[k + 1] << 16);
        const unsigned w = want_im ? pk2(wr * i0 + wi * r0, wr * i1 + wi * r1) : pk2(wr * r0 - wi * i0, wr * r1 - wi * i1);
        o[k] = (short)(w & 0xffffu); o[k + 1] = (short)(w >> 16);
    }
    return o;
}
template <int DIR>
__device__ __forceinline__ void s5_local_dir(const bf16_t* UZ, unsigned char* ws, int gw, int NGW, int lane) {
    float* E = (float*)(ws + WS_E);
    const int pair = gw & 127, g = pair & 63, fr = lane & 15, fq = lane >> 4;
    const bf16_t* Bb = (const bf16_t*)(ws + WS_BB) + (size_t)pair * 128 * 16;
    bf16x4 Bre[4][4], Bim[4][4]; float a1r[4], a1i[4], a64r[4], a64i[4], wr_[4], wi_[4];
#pragma unroll
    for (int t = 0; t < 4; ++t) {
        const int p = 16 * t + fr;
        const bf16x4 b_re = *(const bf16x4*)(Bb + (2 * p) * 16 + 4 * fq), b_im = *(const bf16x4*)(Bb + (2 * p + 1) * 16 + 4 * fq);
        const f32x4 ap = ((const f32x4*)(ws + WS_APOW))[pair * 64 + p];
        const float ar = ap.x, ai = ap.y;
        float r2 = ar, i2 = ai; cmul(r2, i2, ar, ai);
        float r4 = r2, i4 = i2; cmul(r4, i4, r2, i2);
        float r8 = r4, i8 = i4; cmul(r8, i8, r4, i4);
        float r12 = r8, i12 = i8; cmul(r12, i12, r4, i4);
        float r16 = r8, i16 = i8; cmul(r16, i16, r8, i8);
        float r32 = r16, i32 = i16; cmul(r32, i32, r16, i16);
        float r48 = r32, i48 = i32; cmul(r48, i48, r16, i16);
        a1r[t] = ar; a1i[t] = ai; a64r[t] = ap.z; a64i[t] = ap.w;
        const int e = DIR ? fq : 3 - fq;
        wr_[t] = e == 0 ? 1.f : e == 1 ? r4 : e == 2 ? r8 : r12; wi_[t] = e == 0 ? 0.f : e == 1 ? i4 : e == 2 ? i8 : i12;
#pragma unroll
        for (int m = 0; m < 4; ++m) {
            const int em = DIR ? m : 3 - m;
            const float pr = em == 0 ? 1.f : em == 1 ? r16 : em == 2 ? r32 : r48, pi = em == 0 ? 0.f : em == 1 ? i16 : em == 2 ? i32 : i48;
            Bre[m][t] = cscale_bf(b_re, b_im, pr, pi, false); Bim[m][t] = cscale_bf(b_re, b_im, pr, pi, true);
        }
    }
    const int qd = gw >> 7, b = qd >> 2, q = qd & 3;
    if (qd >= 16) return;
    const int c0 = 17 * q, c1 = q < 3 ? c0 + 17 : 67;
    float Rr[4] = {0.f, 0.f, 0.f, 0.f}, Ri[4] = {0.f, 0.f, 0.f, 0.f};
    float* ebase = E + ((size_t)((b * 2 + DIR) * 64 + g) * NCHUNK) * 128;
    bf16x4 Un[4];
    load_uf(Un, UZ, chunk_rowbase(b, DIR, c0), g, lane);
    for (int c = c0; c < c1; ++c) {
        bf16x4 Uf[4];
#pragma unroll
        for (int m = 0; m < 4; ++m) Uf[m] = Un[m];
        if (c + 1 < c1) load_uf(Un, UZ, chunk_rowbase(b, DIR, c + 1), g, lane);
        float* e = ebase + (size_t)c * 128;
#pragma unroll
        for (int t = 0; t < 4; ++t) {
            f32x4 cr = {0.f, 0.f, 0.f, 0.f}, ci = {0.f, 0.f, 0.f, 0.f};
#pragma unroll
            for (int m = 0; m < 4; ++m) {
                cr = __builtin_amdgcn_mfma_f32_16x16x16bf16_1k(Uf[m], Bre[m][t], cr, 0, 0, 0);
                ci = __builtin_amdgcn_mfma_f32_16x16x16bf16_1k(Uf[m], Bim[m][t], ci, 0, 0, 0);
            }
            f32x2 s2 = {DIR ? cr[3] : cr[0], DIR ? ci[3] : ci[0]};
#pragma unroll
            for (int ii = 1; ii < 4; ++ii) { const int i = DIR ? 3 - ii : ii;
                s2 = cmac(s2, (f32x2){a1r[t], a1r[t]}, (f32x2){-a1i[t], a1i[t]}, (f32x2){cr[i], ci[i]}); }
            s2 = cmac(s2, (f32x2){wr_[t], wr_[t]}, (f32x2){-wi_[t], wi_[t]}, (f32x2){0.f, 0.f});
            float sr = s2.x, si = s2.y;
            sr += __shfl_xor(sr, 16); si += __shfl_xor(si, 16); sr += __shfl_xor(sr, 32); si += __shfl_xor(si, 32);
            if (fq == 0) { e[16 * t + fr] = Rr[t]; e[64 + 16 * t + fr] = Ri[t]; }
            const float nr = fmaf(a64r[t], Rr[t], fmaf(-a64i[t], Ri[t], sr)), ni = fmaf(a64r[t], Ri[t], fmaf(a64i[t], Rr[t], si)); Rr[t] = nr; Ri[t] = ni;
        }
    }
    float* fin = q < 3 ? (float*)(ws + WS_QE) + ((size_t)((b * 2 + DIR) * 64 + g) * 3 + q) * 128 : ebase + (size_t)67 * 128;
    if (fq == 0) {
#pragma unroll
        for (int t = 0; t < 4; ++t) { fin[16 * t + fr] = Rr[t]; fin[64 + 16 * t + fr] = Ri[t]; }
    }
}
__device__ __forceinline__ void s5_local_phase(LAS unsigned char* lds, const bf16_t* UZ, unsigned char* ws) {
    const int lane = threadIdx.x & 63, wave = __builtin_amdgcn_readfirstlane(threadIdx.x >> 6);
    const int gw = blockIdx.x * 8 + wave, NGW = gridDim.x * 8;
    if ((gw & 127) >> 6) s5_local_dir<1>(UZ, ws, gw, NGW, lane); else s5_local_dir<0>(UZ, ws, gw, NGW, lane);
}
__device__ __forceinline__ void s5_carry_phase(unsigned char* ws) {
    const int gt = blockIdx.x * 128 + (threadIdx.x & 127);
    if (threadIdx.x >= 128 || gt >= NB * 2 * 64 * 64) return;
    const int p = gt & 63, g = (gt >> 6) & 63, bd = gt >> 12, dir = bd & 1;
    const f32x4 ap = ((const f32x4*)(ws + WS_APOW))[(dir * 64 + g) * 64 + p];
    float* e = (float*)(ws + WS_E) + ((size_t)(bd * 64 + g) * NCHUNK) * 128 + p;
    float er[NCHUNK - 1], ei[NCHUNK - 1];
#pragma unroll
    for (int c = 0; c < NCHUNK - 1; ++c) { er[c] = e[c * 128]; ei[c] = e[c * 128 + 64]; }
    float xr = 0.f, xi = 0.f;
#pragma unroll
    for (int c = 0; c < NCHUNK - 1; ++c) {
        const float nr = ap.z * xr - ap.w * xi + er[c], ni = ap.z * xi + ap.w * xr + ei[c];
        er[c] = xr; ei[c] = xi; xr = nr; xi = ni;
    }
#pragma unroll
    for (int c = 0; c < NCHUNK - 1; ++c) { e[c * 128] = er[c]; e[c * 128 + 64] = ei[c]; }
    e[(NCHUNK - 1) * 128] = xr; e[(NCHUNK - 1) * 128 + 64] = xi;
}
__device__ __forceinline__ f32x2 s5_carry(const f32x2 pre, const f32x2 (&qe)[3], const f32x4 ap, int c) {
    const int q = c / 17, k = c - 17 * q;
    if (q == 0) return pre;
    float A1r = ap.z, A1i = ap.w;
    float A2r = A1r, A2i = A1i; cmul(A2r, A2i, A1r, A1i);
    float A4r = A2r, A4i = A2i; cmul(A4r, A4i, A2r, A2i);
    float A8r = A4r, A8i = A4i; cmul(A8r, A8i, A4r, A4i);
    float A16r = A8r, A16i = A8i; cmul(A16r, A16i, A8r, A8i);
    float A17r = A16r, A17i = A16i; cmul(A17r, A17i, A1r, A1i);
    float sr = qe[0].x, si = qe[0].y;
    if (q >= 2) { cmul(sr, si, A17r, A17i); sr += qe[1].x; si += qe[1].y; }
    if (q >= 3) { cmul(sr, si, A17r, A17i); sr += qe[2].x; si += qe[2].y; }
    if (k & 1) cmul(sr, si, A1r, A1i);
    if (k & 2) cmul(sr, si, A2r, A2i);
    if (k & 4) cmul(sr, si, A4r, A4i);
    if (k & 8) cmul(sr, si, A8r, A8i);
    if (k & 16) cmul(sr, si, A16r, A16i);
    return (f32x2){pre.x + sr, pre.y + si};
}
constexpr int BUT_BYTES = 64 * 80, XB_BYTES = 16 * XB_PITCH;
__device__ __forceinline__ float bf_at(const u32x4& lo, const u32x4& hi, int r) { const unsigned w = (r < 8 ? lo : hi)[(r & 7) >> 1]; return (r & 1) ? bf_hi(w) : bf_lo(w); }
__device__ __forceinline__ void s5_out_phase(LAS unsigned char* lds, const bf16_t* UZ, const unsigned char* ws, const float* dskip, bf16_t* YG) {
    const int lane = threadIdx.x & 63, wave = __builtin_amdgcn_readfirstlane(threadIdx.x >> 6);
    LAS unsigned char* wl = lds + wave * S5_WAVE_LDS;
    const int gw = blockIdx.x * 8 + wave, NGW = gridDim.x * 8;
    const float* E = (const float*)(ws + WS_E);
    const int g = gw & 63, fr = lane & 15, fq = lane >> 4;
    const f32x4 dsk = *(const f32x4*)(dskip + 16 * g + 4 * fq);
    bf16x4 Bf[2][8]; bf16x8 Cf[2][4]; f32x4 ap[2];
#pragma unroll
    for (int dir = 0; dir < 2; ++dir) {
        const int pair = dir * 64 + g;
        const bf16_t* Bb = (const bf16_t*)(ws + WS_BB) + (size_t)pair * 128 * 16;
        const bf16_t* Cm = (const bf16_t*)(ws + WS_CM) + (size_t)pair * 16 * 128;
#pragma unroll
        for (int nt = 0; nt < 8; ++nt) Bf[dir][nt] = *(const bf16x4*)(Bb + (16 * nt + fr) * 16 + 4 * fq);
#pragma unroll
        for (int ks = 0; ks < 4; ++ks) Cf[dir][ks] = *(const bf16x8*)(Cm + fr * 128 + 8 * fq + 32 * ks);
        ap[dir] = ((const f32x4*)(ws + WS_APOW))[pair * 64 + lane];
    }
    const int wofs = (fr >> 1) * 80 + (fr & 1) * 32 + 8 * fq;
    const int sstep = NGW >> 6;
    const float* QE = (const float*)(ws + WS_QE);
    bf16x4 Un[4]; f32x2 rp[2], rq[2][3];
#define S5_LOADRAW(bb, ttt) do { _Pragma("unroll") for (int dir = 0; dir < 2; ++dir) { const int c_ = dir ? 4 + 63 - (ttt) : 4 + (ttt); \
        const float* e_ = E + ((size_t)(((bb) * 2 + dir) * 64 + g) * NCHUNK + c_) * 128; rp[dir] = (f32x2){e_[lane], e_[64 + lane]}; \
        const float* q_ = QE + ((size_t)(((bb) * 2 + dir) * 64 + g) * 3) * 128; \
        _Pragma("unroll") for (int j = 0; j < 3; ++j) rq[dir][j] = (f32x2){q_[j * 128 + lane], q_[j * 128 + 64 + lane]}; } } while (0)
    { const int slot = gw >> 6, b = slot >> 6, tt = slot & 63;
      load_uf(Un, UZ, b * SEQ + 64 * tt, g, lane);
      S5_LOADRAW(b, tt); }
    for (int slot = gw >> 6; slot < 256; slot += sstep) {
        const int b = slot >> 6, tt = slot & 63, rowbase = b * SEQ + 64 * tt;
        bf16x4 Uf[4];
#pragma unroll
        for (int m = 0; m < 4; ++m) Uf[m] = Un[m];
        const f32x2 cF_ = s5_carry(rp[0], rq[0], ap[0], 4 + tt), cB_ = s5_carry(rp[1], rq[1], ap[1], 4 + 63 - tt);
        float xfr = cF_.x, xfi = cF_.y, xbr = cB_.x, xbi = cB_.y;
        if (slot + sstep < 256) { const int ns = slot + sstep, nb = ns >> 6, ntt = ns & 63;
            load_uf(Un, UZ, nb * SEQ + 64 * ntt, g, lane);
            S5_LOADRAW(nb, ntt); }
        f32x4 accY[4];
#pragma unroll
        for (int m = 0; m < 4; ++m) accY[m] = (f32x4){0.f, 0.f, 0.f, 0.f};
#pragma unroll
        for (int mm = 0; mm < 4; ++mm) {
            const int mf = mm, mb = 3 - mm;
#pragma unroll
            for (int nt = 0; nt < 8; ++nt) {
                const f32x4 z = {0.f, 0.f, 0.f, 0.f};
                const f32x4 cf = __builtin_amdgcn_mfma_f32_16x16x16bf16_1k(Uf[mf], Bf[0][nt], z, 0, 0, 0);
                const f32x4 cb = __builtin_amdgcn_mfma_f32_16x16x16bf16_1k(Uf[mb], Bf[1][nt], z, 0, 0, 0);
                u32x2 wf, wb; wf.x = pk2(cf[0], cf[1]); wf.y = pk2(cf[2], cf[3]); wb.x = pk2(cb[0], cb[1]); wb.y = pk2(cb[2], cb[3]);
                *(LAS u32x2*)(wl + nt * 640 + wofs) = wf;
                *(LAS u32x2*)(wl + BUT_BYTES + nt * 640 + wofs) = wb;
            }
            WAVE_LDS_FENCE();
            const LAS unsigned char* rp = wl + lane * 80;
            const u32x4 fre0 = *(const LAS u32x4*)(rp), fre1 = *(const LAS u32x4*)(rp + 16), fim0 = *(const LAS u32x4*)(rp + 32), fim1 = *(const LAS u32x4*)(rp + 48);
            const u32x4 bre0 = *(const LAS u32x4*)(rp + BUT_BYTES), bre1 = *(const LAS u32x4*)(rp + BUT_BYTES + 16), bim0 = *(const LAS u32x4*)(rp + BUT_BYTES + 32), bim1 = *(const LAS u32x4*)(rp + BUT_BYTES + 48);
            LAS unsigned char* xf = wl + 2 * BUT_BYTES; LAS unsigned char* xbk = xf + XB_BYTES;
#pragma unroll
            for (int rr = 0; rr < 16; ++rr) {
                const int r = rr, rb = 15 - rr;
                { const f32x2 bb = {bf_at(fre0, fre1, r), bf_at(fim0, fim1, r)};
                  const f32x2 n2 = cmac((f32x2){xfr, xfi}, (f32x2){ap[0].x, ap[0].x}, (f32x2){-ap[0].y, ap[0].y}, bb); xfr = n2.x; xfi = n2.y;
                  *(LAS unsigned*)(xf + r * XB_PITCH + lane * 4) = pk2(n2.x, n2.y); }
                { const f32x2 bb = {bf_at(bre0, bre1, rb), bf_at(bim0, bim1, rb)};
                  const f32x2 n2 = cmac((f32x2){xbr, xbi}, (f32x2){ap[1].x, ap[1].x}, (f32x2){-ap[1].y, ap[1].y}, bb); xbr = n2.x; xbi = n2.y;
                  *(LAS unsigned*)(xbk + rb * XB_PITCH + lane * 4) = pk2(n2.x, n2.y); }
            }
            WAVE_LDS_FENCE();
#pragma unroll
            for (int ks = 0; ks < 4; ++ks) {
                const bf16x8 Xf = *(const LAS bf16x8*)(xf + fr * XB_PITCH + (8 * fq + 32 * ks) * 2);
                const bf16x8 Xb = *(const LAS bf16x8*)(xbk + fr * XB_PITCH + (8 * fq + 32 * ks) * 2);
                accY[mf] = __builtin_amdgcn_mfma_f32_16x16x32_bf16(Cf[0][ks], Xf, accY[mf], 0, 0, 0);
                accY[mb] = __builtin_amdgcn_mfma_f32_16x16x32_bf16(Cf[1][ks], Xb, accY[mb], 0, 0, 0);
            }
        }
#pragma unroll
        for (int m = 0; m < 4; ++m) {
            const unsigned u0 = (unsigned)(unsigned short)Uf[m][0] | ((unsigned)(unsigned short)Uf[m][1] << 16), u1 = (unsigned)(unsigned short)Uf[m][2] | ((unsigned)(unsigned short)Uf[m][3] << 16);
            const float y0 = gelu_f(accY[m][0] + dsk[0] * bf_lo(u0)), y1 = gelu_f(accY[m][1] + dsk[1] * bf_hi(u0));
            const float y2 = gelu_f(accY[m][2] + dsk[2] * bf_lo(u1)), y3 = gelu_f(accY[m][3] + dsk[3] * bf_hi(u1));
            u32x2 w; w.x = pk2(y0, y1); w.y = pk2(y2, y3);
            *(u32x2*)(YG + (size_t)(rowbase + 16 * m + fr) * D + 16 * g + 4 * fq) = w;
        }
    }
}

__global__ void __launch_bounds__(512, 2) fwd_megakernel(Args a) {
    extern __shared__ __attribute__((aligned(16))) unsigned char lds_raw[];
    LAS unsigned char* lds = (LAS unsigned char*)lds_raw;
    cg::grid_group grid = cg::this_grid();
    unsigned char* ws = a.ws;
    volatile LAS unsigned* bst = (volatile LAS unsigned*)(lds + LDS_TOP);
    if (threadIdx.x < 2) bst[threadIdx.x] = 0u;
    __syncthreads();
    const XcdBarrier xbar = xcd_barrier_post((unsigned*)(ws + WS_BAR), bst);
    if (a.pad == 0x7ead) grid.sync();
    const int lo = a.ph_lo, hi = a.ph_hi;
    const int G = gridDim.x, bid = blockIdx.x;
    const float* mod0 = (const float*)(ws + WS_MOD);
    const float* mod1 = mod0 + 5 * 3072;
    bf16_t* H = (bf16_t*)(ws + WS_H);
    bf16_t* QKVZ = (bf16_t*)(ws + WS_QKVZ);
    bf16_t* AO = (bf16_t*)(ws + WS_AO);
    float* CTX1 = (float*)(ws + WS_CTX1);
#define IN(k) (lo <= (k) && (k) < hi)
#define SEAM(k) do { if (IN(k) && IN((k) + 1)) { xcd_barrier(xbar); if (SYNC_REP > 1) xcd_barrier(xbar); } } while (0)
#define REPB(k) ((((REP_MASK) >> (k)) & 1) != 0)
    if (IN(0)) p0_prologue(a, lds);
    if (IN(0) && REPB(0)) p0_prologue(a, lds);
    SEAM(0);
    if (IN(1)) norm_mod_phase(a.in[0], a.in[2], a.in[4], mod0, H);
    if (IN(1) && REPB(1)) norm_mod_phase(a.in[0], a.in[2], a.in[4], mod0, H);
    SEAM(1);
    if (IN(2)) { pg8::Gemm g{H, (const bf16_t*)(ws + WS_WQKVZ), MTOT, NQKVZ, D}; pg8::StaticOrder S; S.init(MTOT, NQKVZ, G, bid);
        EpiQKVZ E{QKVZ, (const float*)(ws + WS_ROPE)}; pg8::gemm_phase<EpiQKVZ, pg8::StaticOrder>(lds, g, S, E);
        p2_late_transposes(a, lds, (MTOT / 256) * (NQKVZ / 256) - 2 * G); }
    if (IN(2) && REPB(2)) { pg8::Gemm g{H, (const bf16_t*)(ws + WS_WQKVZ), MTOT, NQKVZ, D}; pg8::StaticOrder S; S.init(MTOT, NQKVZ, G, bid);
        EpiQKVZ E{QKVZ, (const float*)(ws + WS_ROPE)}; pg8::gemm_phase<EpiQKVZ, pg8::StaticOrder>(lds, g, S, E); }
    SEAM(2);
    if (IN(3)) attn_phase(lds, QKVZ, AO, a.in[8]);
    if (IN(3) && REPB(3)) attn_phase(lds, QKVZ, AO, a.in[8]);
    SEAM(3);
    if (IN(4)) { pg8::Gemm g{AO, (const bf16_t*)(ws + WS_WAO), NLAT, D, D}; PanelOrder S; S.init(NLAT, G, bid);
        EpiResidNorm<false> E{a.in[0], (bf16_t*)(ws + WS_X1), nullptr, mod0, a.in[4] + D, mod1, H, (float*)(ws + WS_STAT), (unsigned*)(ws + WS_CNT)};
        pg8::gemm_phase<EpiResidNorm<false>, PanelOrder>(lds, g, S, E);
        if (bid < 256) { const int rb = bid >> 4, cb = bid & 15;
            Epi64ResidNorm E2{a.in[2] + (size_t)rb * 64 * D, mod0 + 4 * 3072, a.in[4] + D, mod1 + 4 * 3072, H + (size_t)(NLAT + rb * 64) * D, cb * 64,
                              (float*)(ws + WS_STATC) + rb * 1024, (unsigned*)(ws + WS_CNTC) + rb * 64, cb};
            gemm64_tile<Epi64ResidNorm>(lds, AO + (size_t)(NLAT + rb * 64) * D, (const bf16_t*)(ws + WS_WAO) + (size_t)cb * 64 * D, E2); } }
    SEAM(5);
    if (IN(6)) { pg8::Gemm g{H, (const bf16_t*)(ws + WS_WSIN), NLAT, NUZ, D}; pg8::StaticOrder S; S.init(NLAT, NUZ, G, bid);
        EpiBf16 E{QKVZ, NUZ}; pg8::gemm_phase<EpiBf16, pg8::StaticOrder>(lds, g, S, E);
        if (bid < 256) { const int rb = bid >> 4, cb = bid & 15;
            Epi64Bf16 E2{QKVZ + (size_t)(NLAT + rb * 64) * NUZ + cb * 64, NUZ};
            gemm64_tile<Epi64Bf16>(lds, H + (size_t)(NLAT + rb * 64) * D, (const bf16_t*)(ws + WS_WSIN) + (size_t)cb * 64 * D, E2); } }
    SEAM(6);
    if (IN(7)) s5_local_phase(lds, QKVZ, ws);
    if (IN(7) && REPB(7)) s5_local_phase(lds, QKVZ, ws);
    SEAM(7);
    if (IN(9)) s5_out_phase(lds, QKVZ, ws, a.in[18], AO);
    if (IN(9) && REPB(9)) s5_out_phase(lds, QKVZ, ws, a.in[18], AO);
    SEAM(9);
    if (IN(10)) { pg8::Gemm g{AO, (const bf16_t*)(ws + WS_WGLU), NLAT, NUZ, D}; pg8::StaticOrder S; S.init(NLAT, NUZ, G, bid);
        EpiGlu E{H, QKVZ}; pg8::gemm_phase<EpiGlu, pg8::StaticOrder>(lds, g, S, E); }
    if (IN(10) && REPB(10)) { pg8::Gemm g{AO, (const bf16_t*)(ws + WS_WGLU), NLAT, NUZ, D}; pg8::StaticOrder S; S.init(NLAT, NUZ, G, bid);
        EpiGlu E{H, QKVZ}; pg8::gemm_phase<EpiGlu, pg8::StaticOrder>(lds, g, S, E); }
    SEAM(10);
    if (IN(11)) { pg8::Gemm g{H, (const bf16_t*)(ws + WS_WSOUT), NLAT, D, D}; PanelOrder S; S.init(NLAT, G, bid);
        EpiResidNorm<true> E{nullptr, (bf16_t*)(ws + WS_X1), a.out, mod1, a.in[21], nullptr, nullptr, (float*)(ws + WS_STAT) + 68 * 1024, (unsigned*)(ws + WS_CNT) + 68 * 64};
        pg8::gemm_phase<EpiResidNorm<true>, PanelOrder>(lds, g, S, E); }
#undef IN
#undef SEAM
}

extern "C" void kernel_launch(void* const* d_in, const int* in_sizes, int n_in, void* d_out, int out_size, void* d_ws, size_t ws_size, hipStream_t stream) {
    static int grid = 0;
    if (grid == 0) {
        int dev = 0, cus = 0, per_cu = 0;
        (void)hipGetDevice(&dev);
        (void)hipDeviceGetAttribute(&cus, hipDeviceAttributeMultiprocessorCount, dev);
        (void)hipFuncSetAttribute((const void*)fwd_megakernel, hipFuncAttributeMaxDynamicSharedMemorySize, LDS_BYTES);
        (void)hipOccupancyMaxActiveBlocksPerMultiprocessor(&per_cu, (const void*)fwd_megakernel, 512, LDS_BYTES);
        if (per_cu < 1) per_cu = 1;
        grid = cus * per_cu;
        if (n_in != 22 || ws_size < WS_END) { fprintf(stderr, "kernel_launch: unexpected n_in %d / ws_size %zu\n", n_in, ws_size); }
    }
    Args a{};
    for (int i = 0; i < 22; ++i) a.in[i] = (const float*)d_in[i];
    a.out = (float*)d_out; a.ws = (unsigned char*)d_ws; a.ph_lo = 0; a.ph_hi = 13;
    (void)hipMemsetAsync((char*)d_ws + WS_BAR, 0, BAR_ZERO_BYTES, stream);
    void* args[] = {&a};
    hipError_t e = hipLaunchCooperativeKernel((void*)fwd_megakernel, dim3(grid), dim3(512), args, LDS_BYTES, stream);
    if (e != hipSuccess) fprintf(stderr, "cooperative launch failed: %s (grid %d)\n", hipGetErrorString(e), grid);
}
```

```cpp
#include <hip/hip_runtime.h>
#include <hip/hip_cooperative_groups.h>
#include <cstdio>
#include <cstdint>
namespace cg = cooperative_groups;

#define LAS __attribute__((address_space(3)))
typedef unsigned short bf16_t;
typedef short bf16x8 __attribute__((ext_vector_type(8)));
typedef short bf16x4 __attribute__((ext_vector_type(4)));
typedef float f32x4 __attribute__((ext_vector_type(4)));
typedef float f32x2 __attribute__((ext_vector_type(2)));
typedef float f32x16 __attribute__((ext_vector_type(16)));
typedef unsigned u32x4 __attribute__((ext_vector_type(4)));
typedef unsigned u32x2 __attribute__((ext_vector_type(2)));
typedef __bf16 nbf2 __attribute__((ext_vector_type(2)));

constexpr int D = 1024, NB = 4, SEQ = 4096, CTXL = 256;
constexpr int NLAT = NB * SEQ;
constexpr int NCTX = NB * CTXL;
constexpr int MTOT = NLAT + NCTX;
constexpr int NQKVZ = 2560;
constexpr int NUZ = 2048;
constexpr int NCHUNK = 68;
constexpr float LOG2E = 1.4426950408889634f;

constexpr size_t MiB = 1u << 20;
constexpr size_t WS_MOD = 0;
constexpr size_t WS_BAR = 128 * 1024;
constexpr size_t WS_ROPE = 256 * 1024;
constexpr size_t WS_APOW = 512 * 1024;
constexpr size_t WS_BB = 1 * MiB;
constexpr size_t WS_CM = 1 * MiB + 512 * 1024;
constexpr size_t WS_WQKVZ = 2 * MiB;
constexpr size_t WS_WAO = 7 * MiB;
constexpr size_t WS_WSIN = 9 * MiB;
constexpr size_t WS_WGLU = 13 * MiB;
constexpr size_t WS_WSOUT = 17 * MiB;
constexpr size_t WS_CTX1 = 19 * MiB;
constexpr size_t WS_E = 23 * MiB;
constexpr size_t WS_H = 40 * MiB;
constexpr size_t WS_AO = 74 * MiB;
constexpr size_t WS_QKVZ = 108 * MiB;
constexpr size_t WS_STAT = 193 * MiB;
constexpr size_t WS_QE = 194 * MiB;
constexpr size_t WS_X1 = 195 * MiB;
constexpr size_t WS_END = 227 * MiB;
constexpr size_t WS_CNT = WS_BAR + 16384;
constexpr size_t WS_STATC = WS_STAT + 768 * 1024;
constexpr size_t WS_CNTC = WS_CNT + 2 * 68 * 256;
constexpr size_t BAR_ZERO_BYTES = 16384 + 2 * 68 * 256 + 16 * 256;

constexpr int S5_WAVE_LDS = 18944;
constexpr int LDS_TOP = 8 * S5_WAVE_LDS;
constexpr int LDS_BYTES = LDS_TOP + 6144;
#ifndef REP_MASK
#define REP_MASK 0
#endif
#ifndef SYNC_REP
#define SYNC_REP 1
#endif

__device__ __forceinline__ unsigned pk2(float lo, float hi) { f32x2 v = {lo, hi}; nbf2 r = __builtin_convertvector(v, nbf2); return __builtin_bit_cast(unsigned, r); }
__device__ __forceinline__ float bf_lo(unsigned w) { return __uint_as_float(w << 16); }
__device__ __forceinline__ float bf_hi(unsigned w) { return __uint_as_float(w & 0xffff0000u); }
__device__ __forceinline__ float fast_rcp(float x) { return __builtin_amdgcn_rcpf(x); }
__device__ __forceinline__ float fast_exp2(float x) { return __builtin_amdgcn_exp2f(x); }
__device__ __forceinline__ float silu_f(float z) { return z * fast_rcp(1.0f + fast_exp2(-z * LOG2E)); }
__device__ __forceinline__ float sigmoid_f(float z) { return fast_rcp(1.0f + fast_exp2(-z * LOG2E)); }
__device__ __forceinline__ float wave_sum(float v) {
#pragma unroll
    for (int o = 1; o < 64; o <<= 1) v += __shfl_xor(v, o);
    return v;
}
__device__ __forceinline__ float gelu_f(float v) {
    const float av = fabsf(v), d = av * 0.2316418882f + 1.0f;
    const float t = fast_rcp(d);
    float q = t * 0.5307027145f + (-0.7265760135f); q = q * t + 0.7107068705f; q = q * t + (-0.142248368f); q = q * t + 0.127414796f; q = q * t;
    const float e = fast_exp2((v * v) * (-0.72134752044f));
    const float m = v * (q * e), r = v - m;
    return v < 0.f ? m : r;
}
#define WAVE_LDS_FENCE() asm volatile("s_waitcnt lgkmcnt(0)" ::: "memory")
__device__ __forceinline__ f32x2 cmac(f32x2 x, f32x2 a_rr, f32x2 a_i, f32x2 c) { const f32x2 t = a_rr * x + c; const f32x2 xs = {x.y, x.x}; return a_i * xs + t; }

namespace pg8 {
constexpr int BM = 256, BK = 64, HALF = 128, HTB = HALF * BK * 2, NXCD = 8, WGM = 8;
__host__ __device__ __forceinline__ int lds_byte(int r, int c) { const int st = (r >> 4) * 2 + (c >> 5), rr = r & 15, cc = c & 31, ob = rr * 64 + cc * 2; return st * 1024 + (ob ^ (((ob >> 9) & 1) << 5)); }
__host__ __device__ __forceinline__ void stage_rc(int b, int& R, int& C) { const int st = b / 1024, sb = b % 1024, swz = sb ^ (((sb >> 9) & 1) << 5); R = (st >> 1) * 16 + swz / 64; C = (st & 1) * 32 + (swz % 64) / 2; }
__host__ __device__ __forceinline__ int perm32(int rho) { const int n = rho >> 4, i = rho & 15; return 8 * (i >> 2) + 4 * n + (i & 3); }
struct Unit { int pm, pn; };
struct Gemm { const bf16_t* A; const bf16_t* Bt; int M, N, K; };
struct StaticOrder {
    int nM, nN, nwg, G, c;
    __device__ void init(int M, int N, int G_, int c_) { nM = M / BM; nN = N / BM; nwg = nM * nN; G = G_; c = c_; }
    __device__ bool next(int i, Unit& u) const {
        const long L = (long)i * G + c; if (L >= nwg) return false;
        int wgid = (int)L; { const int q = nwg / NXCD, r = nwg % NXCD, xcd = wgid % NXCD, off = wgid / NXCD; wgid = (xcd < r ? xcd * (q + 1) : r * (q + 1) + (xcd - r) * q) + off; }
        const int nig = WGM * nN, gid = wgid / nig, fm = gid * WGM, gsz = (nM - fm) < WGM ? (nM - fm) : WGM;
        u.pm = fm + ((wgid % nig) % gsz); u.pn = (wgid % nig) / gsz; return true;
    }
};
template <class Epi, class Sched>
__device__ __forceinline__ void gemm_phase(LAS unsigned char* lds, const Gemm g, const Sched& S, const Epi& E) {
    const int tid = threadIdx.x, wid = __builtin_amdgcn_readfirstlane(tid >> 6), lane = tid & 63, wr = wid >> 2, wc = wid & 3, fr = lane & 15, fq = lane >> 4;
    const int K = g.K, nt = K / BK;
    unsigned voffA[2], voffB[2];
#pragma unroll
    for (int i = 0; i < 2; ++i) { int R, C; stage_rc(tid * 16 + i * 8192, R, C); const int Rb = Epi::PERM ? ((R & ~31) + perm32(R & 31)) : R;
        voffA[i] = (unsigned)(R * K + C) * 2u; voffB[i] = (unsigned)(Rb * K + C) * 2u; }
    const size_t kstep = (size_t)(BK * 2);
    const size_t hstep = (size_t)HALF * K * 2;
    const size_t tstep = 2 * hstep;
    const unsigned ldsw = (unsigned)wid * 1024u;
    const int aoff = lds_byte(wr * 64 + fr, fq * 8), boff = lds_byte(wc * 32 + fr, fq * 8);
#define PG8_SA(b, h) (((b) * 2 + (h)) * HTB)
#define PG8_SB(b, h) ((4 + (b) * 2 + (h)) * HTB)
#define PG8_STAGE(bufoff, gbase, voff) do { _Pragma("unroll") for (int _i = 0; _i < 2; ++_i) \
        __builtin_amdgcn_global_load_lds((const unsigned*)((const char*)(gbase) + (voff)[_i]), (LAS unsigned*)(lds + (bufoff) + ldsw + _i * 8192), 16, 0, 0); } while (0)
#define PG8_LDA(dst, b, h) do { _Pragma("unroll") for (int m = 0; m < 4; ++m) _Pragma("unroll") for (int k = 0; k < 2; ++k) dst[m][k] = *(const LAS bf16x8*)(lds + PG8_SA(b, h) + aoff + m * 2048 + k * 1024); } while (0)
#define PG8_LDB(dst, b, h) do { _Pragma("unroll") for (int n = 0; n < 2; ++n) _Pragma("unroll") for (int k = 0; k < 2; ++k) dst[n][k] = *(const LAS bf16x8*)(lds + PG8_SB(b, h) + boff + n * 2048 + k * 1024); } while (0)
#define PG8_MMA(ai, bj, At, Bt) do { __builtin_amdgcn_s_setprio(1); _Pragma("unroll") for (int m = 0; m < 4; ++m) _Pragma("unroll") for (int n = 0; n < 2; ++n) _Pragma("unroll") for (int k = 0; k < 2; ++k) \
        acc[ai][bj][m][n] = __builtin_amdgcn_mfma_f32_16x16x32_bf16(Bt[n][k], At[m][k], acc[ai][bj][m][n], 0, 0, 0); __builtin_amdgcn_s_setprio(0); } while (0)
#define PG8_WAIT_V(n) asm volatile("s_waitcnt vmcnt(" #n ")" ::: "memory")
#define PG8_WAIT_L(n) asm volatile("s_waitcnt lgkmcnt(" #n ")" ::: "memory")
#define PG8_BAR __builtin_amdgcn_s_barrier()
#define PG8_SCHED __builtin_amdgcn_sched_barrier(0)
    Unit cur, nxt; int ui = 0;
    if (!S.next(0, cur)) return;
    f32x4 acc[2][2][4][2];
#pragma unroll
    for (int a = 0; a < 2; ++a)
#pragma unroll
        for (int b = 0; b < 2; ++b)
#pragma unroll
            for (int m = 0; m < 4; ++m)
#pragma unroll
                for (int n = 0; n < 2; ++n) acc[a][b][m][n] = (f32x4){0.f, 0.f, 0.f, 0.f};
    bf16x8 At[4][2], B0[2][2], B1[2][2];
    const char* cA = (const char*)g.A + (size_t)cur.pm * tstep; const char* cB = (const char*)g.Bt + (size_t)cur.pn * tstep;
    PG8_STAGE(PG8_SB(0, 0), cB, voffB); PG8_STAGE(PG8_SB(0, 1), cB + hstep, voffB); PG8_STAGE(PG8_SA(0, 0), cA, voffA); PG8_STAGE(PG8_SA(0, 1), cA + hstep, voffA);
    if (wr == 1) PG8_BAR;
    PG8_WAIT_V(2); PG8_BAR;
    PG8_STAGE(PG8_SB(1, 0), cB + kstep, voffB); PG8_STAGE(PG8_SA(1, 0), cA + kstep, voffA); PG8_STAGE(PG8_SB(1, 1), cB + hstep + kstep, voffB);
    PG8_WAIT_V(6); PG8_BAR;
    for (;;) {
        const bool has_next = S.next(ui + 1, nxt);
        const char* nA = has_next ? (const char*)g.A + (size_t)nxt.pm * tstep : cA; const char* nB = has_next ? (const char*)g.Bt + (size_t)nxt.pn * tstep : cB;
        for (int t = 0; t < nt; t += 2) {
            const bool last = (t == nt - 2);
            const char* a1 = cA + (size_t)(t + 1) * kstep;
            const char* a2 = last ? nA : cA + (size_t)(t + 2) * kstep; const char* b2 = last ? nB : cB + (size_t)(t + 2) * kstep;
            const char* a3 = a2 + kstep; const char* b3 = b2 + kstep;
            PG8_LDB(B0, 0, 0); PG8_LDB(B1, 0, 1); PG8_SCHED; PG8_LDA(At, 0, 0); PG8_STAGE(PG8_SA(1, 1), a1 + hstep, voffA);
            PG8_WAIT_V(8); PG8_WAIT_L(0); PG8_BAR; PG8_MMA(0, 0, At, B0); PG8_MMA(0, 1, At, B1); PG8_BAR; PG8_SCHED;
            PG8_LDA(At, 0, 1); PG8_STAGE(PG8_SB(0, 0), b2, voffB); PG8_STAGE(PG8_SB(0, 1), b2 + hstep, voffB); PG8_STAGE(PG8_SA(0, 0), a2, voffA);
            PG8_WAIT_V(8); PG8_WAIT_L(0); PG8_BAR; PG8_MMA(1, 0, At, B0); PG8_MMA(1, 1, At, B1); PG8_BAR; PG8_SCHED;
            PG8_LDB(B0, 1, 0); PG8_LDB(B1, 1, 1); PG8_SCHED; PG8_LDA(At, 1, 0); PG8_STAGE(PG8_SA(0, 1), a2 + hstep, voffA);
            PG8_WAIT_V(8); PG8_WAIT_L(0); PG8_BAR; PG8_MMA(0, 0, At, B0); PG8_MMA(0, 1, At, B1); PG8_BAR; PG8_SCHED;
            PG8_LDA(At, 1, 1); PG8_STAGE(PG8_SB(1, 0), b3, voffB); PG8_STAGE(PG8_SB(1, 1), b3 + hstep, voffB); PG8_STAGE(PG8_SA(1, 0), a3, voffA);
            PG8_WAIT_V(8); PG8_WAIT_L(0); PG8_BAR; PG8_MMA(1, 0, At, B0); PG8_MMA(1, 1, At, B1); PG8_BAR; PG8_SCHED;
        }
        if (wr == 0) PG8_BAR;
        E(acc, cur, wr, wc, fr, fq, lds);
        if (!has_next) break;
#pragma unroll
        for (int a = 0; a < 2; ++a)
#pragma unroll
            for (int b = 0; b < 2; ++b)
#pragma unroll
                for (int m = 0; m < 4; ++m)
#pragma unroll
                    for (int n = 0; n < 2; ++n) acc[a][b][m][n] = (f32x4){0.f, 0.f, 0.f, 0.f};
        cur = nxt; cA = nA; cB = nB; ++ui;
        if (wr == 1) PG8_BAR;
    }
    PG8_WAIT_V(0);
    PG8_BAR;
#undef PG8_SA
#undef PG8_SB
#undef PG8_STAGE
#undef PG8_LDA
#undef PG8_LDB
#undef PG8_MMA
#undef PG8_WAIT_V
#undef PG8_WAIT_L
#undef PG8_BAR
#undef PG8_SCHED
}
}

struct EpiQKVZ {
    static constexpr bool PERM = true;
    bf16_t* O; const float* rope;
    __device__ __forceinline__ void operator()(f32x4 (&acc)[2][2][4][2], const pg8::Unit& u, int wr, int wc, int fr, int fq, LAS unsigned char* lds) const {
        const float qs = 0.125f * LOG2E;
#pragma unroll
        for (int ai = 0; ai < 2; ++ai)
#pragma unroll
            for (int m = 0; m < 4; ++m) {
                const int r = u.pm * 256 + ai * 128 + wr * 64 + m * 16 + fr;
                const bool lat = r < NLAT;
                const int t = r & (SEQ - 1);
                const int val = (wc & 1) ? (t & 63) : (t >> 6);
                const f32x4 cs = *(const f32x4*)(rope + val * 32 + 4 * fq), sn = *(const f32x4*)(rope + val * 32 + 16 + 4 * fq);
                bf16_t* rowp = O + (size_t)r * NQKVZ;
#pragma unroll
                for (int bj = 0; bj < 2; ++bj) {
                    const int cb = u.pn * 256 + bj * 128 + wc * 32;
                    f32x4 t1 = acc[ai][bj][m][0], t2 = acc[ai][bj][m][1];
                    if (cb < 1280 && lat) { const f32x4 o1 = t1 * cs - t2 * sn, o2 = t2 * cs + t1 * sn; t1 = o1; t2 = o2; }
                    if (cb < 1024) { t1 = t1 * qs; t2 = t2 * qs; }
                    u32x4 w; w.x = pk2(t1[0], t1[1]); w.y = pk2(t1[2], t1[3]); w.z = pk2(t2[0], t2[1]); w.w = pk2(t2[2], t2[3]);
                    *(u32x4*)(rowp + cb + 8 * fq) = w;
                }
            }
    }
};
struct EpiResid {
    static constexpr bool PERM = true;
    const float* base_lat; float* out_lat; const float* base_ctx; float* out_ctx; const float* mod;
    __device__ __forceinline__ void operator()(f32x4 (&acc)[2][2][4][2], const pg8::Unit& u, int wr, int wc, int fr, int fq, LAS unsigned char* lds) const {
#pragma unroll
        for (int ai = 0; ai < 2; ++ai) {
            const int r0 = u.pm * 256 + ai * 128;
            const bool lat = r0 < NLAT;
            const int v = lat ? (r0 >> 12) : 4;
            const float* gp = mod + v * 3072 + 2048;
            const float* bp = lat ? base_lat : base_ctx - (size_t)NLAT * D;
            float* op = lat ? out_lat : out_ctx - (size_t)NLAT * D;
#pragma unroll
            for (int bj = 0; bj < 2; ++bj) {
                const int c0 = u.pn * 256 + bj * 128 + wc * 32 + 8 * fq;
                const f32x4 g0 = *(const f32x4*)(gp + c0), g1 = *(const f32x4*)(gp + c0 + 4);
#pragma unroll
                for (int m = 0; m < 4; ++m) {
                    const size_t off = (size_t)(r0 + wr * 64 + m * 16 + fr) * D + c0;
                    const f32x4 x0 = *(const f32x4*)(bp + off), x1 = *(const f32x4*)(bp + off + 4);
                    *(f32x4*)(op + off) = x0 + g0 * acc[ai][bj][m][0];
                    *(f32x4*)(op + off + 4) = x1 + g1 * acc[ai][bj][m][1];
                }
            }
        }
    }
};
struct EpiBf16 {
    static constexpr bool PERM = true;
    bf16_t* O; int ldc;
    __device__ __forceinline__ void operator()(f32x4 (&acc)[2][2][4][2], const pg8::Unit& u, int wr, int wc, int fr, int fq, LAS unsigned char* lds) const {
#pragma unroll
        for (int ai = 0; ai < 2; ++ai)
#pragma unroll
            for (int m = 0; m < 4; ++m) {
                bf16_t* rowp = O + (size_t)(u.pm * 256 + ai * 128 + wr * 64 + m * 16 + fr) * ldc + u.pn * 256 + wc * 32 + 8 * fq;
#pragma unroll
                for (int bj = 0; bj < 2; ++bj) {
                    const f32x4 v0 = acc[ai][bj][m][0], v1 = acc[ai][bj][m][1];
                    u32x4 w; w.x = pk2(v0[0], v0[1]); w.y = pk2(v0[2], v0[3]); w.z = pk2(v1[0], v1[1]); w.w = pk2(v1[2], v1[3]);
                    *(u32x4*)(rowp + bj * 128) = w;
                }
            }
    }
};
struct EpiGlu {
    static constexpr bool PERM = true;
    bf16_t* O; const bf16_t* UZ;
    __device__ __forceinline__ void operator()(f32x4 (&acc)[2][2][4][2], const pg8::Unit& u, int wr, int wc, int fr, int fq, LAS unsigned char* lds) const {
#pragma unroll
        for (int ai = 0; ai < 2; ++ai)
#pragma unroll
            for (int m = 0; m < 4; ++m) {
                const int r = u.pm * 256 + ai * 128 + wr * 64 + m * 16 + fr;
                const int oc = u.pn * 128 + wc * 32 + 8 * fq;
                const u32x4 zw = *(const u32x4*)(UZ + (size_t)r * NUZ + 1024 + oc);
                const f32x4 a0 = acc[ai][0][m][0], a1 = acc[ai][0][m][1], g0 = acc[ai][1][m][0], g1 = acc[ai][1][m][1];
                float o[8];
                o[0] = a0[0] * sigmoid_f(g0[0]) * silu_f(bf_lo(zw.x)); o[1] = a0[1] * sigmoid_f(g0[1]) * silu_f(bf_hi(zw.x));
                o[2] = a0[2] * sigmoid_f(g0[2]) * silu_f(bf_lo(zw.y)); o[3] = a0[3] * sigmoid_f(g0[3]) * silu_f(bf_hi(zw.y));
                o[4] = a1[0] * sigmoid_f(g1[0]) * silu_f(bf_lo(zw.z)); o[5] = a1[1] * sigmoid_f(g1[1]) * silu_f(bf_hi(zw.z));
                o[6] = a1[2] * sigmoid_f(g1[2]) * silu_f(bf_lo(zw.w)); o[7] = a1[3] * sigmoid_f(g1[3]) * silu_f(bf_hi(zw.w));
                u32x4 w; w.x = pk2(o[0], o[1]); w.y = pk2(o[2], o[3]); w.z = pk2(o[4], o[5]); w.w = pk2(o[6], o[7]);
                *(u32x4*)(O + (size_t)r * D + oc) = w;
            }
    }
};


#define XB_TMO      128
#define XB_XCNT(j)  (256  + 64 * (j))
#define XB_XSUB(j)  (1280 + 64 * (j))
#define XB_XGEN(j)  (2304 + 64 * (j))
#define XB_TOP      3328
#define XB_TOPGEN   3392
#define XCD_BAR_WORDS 3456
#define XB_SPIN_CAP (1u << 18)
__device__ __forceinline__ unsigned xb_ld(unsigned* p)              { return __hip_atomic_load(p, __ATOMIC_RELAXED, __HIP_MEMORY_SCOPE_AGENT); }
__device__ __forceinline__ unsigned xb_add(unsigned* p, unsigned v) { return __hip_atomic_fetch_add(p, v, __ATOMIC_RELAXED, __HIP_MEMORY_SCOPE_AGENT); }
__device__ __forceinline__ unsigned xb_xcc_id() { return (unsigned)__builtin_amdgcn_s_getreg((3 << 11) | 20) & 0xFu; }
#define XB_SPIN(cond, bar) do { unsigned _sp = 0; while (cond) { __builtin_amdgcn_s_sleep(1); \
    if ((++_sp & 255u) == 0u) { if (xb_ld(&(bar)[XB_TMO])) break; if (_sp > XB_SPIN_CAP) { atomicAdd(&(bar)[XB_TMO], 1u); break; } } } } while (0)
struct XcdBarrier { unsigned* bar; unsigned x; volatile LAS unsigned* st; };
__device__ __forceinline__ XcdBarrier xcd_barrier_post(unsigned* bar, volatile LAS unsigned* st) {
    XcdBarrier b; b.bar = bar; b.x = xb_xcc_id(); b.st = st;
    if (threadIdx.x == 0) (void)xb_add(&bar[XB_XCNT(b.x)], 1u);
    return b;
}
__device__ __forceinline__ void xcd_barrier_complete(unsigned* bar, unsigned x, unsigned& nloc, unsigned& nx) {
    const unsigned G = gridDim.x * gridDim.y * gridDim.z;
    unsigned sum, cnt, mine, sp = 0u;
    for (;;) {
        sum = 0u; cnt = 0u; mine = 0u;
#pragma unroll
        for (unsigned j = 0; j < 16; ++j) { const unsigned c = xb_ld(&bar[XB_XCNT(j)]); sum += c; cnt += (c > 0u) ? 1u : 0u; mine = (j == x) ? c : mine; }
        if (sum == G) break;
        __builtin_amdgcn_s_sleep(1);
        if ((++sp & 255u) == 0u) { if (xb_ld(&bar[XB_TMO])) break; if (sp > XB_SPIN_CAP) { atomicAdd(&bar[XB_TMO], 1u); break; } }
    }
    nloc = mine > 0u ? mine : 1u; nx = cnt > 0u ? cnt : 1u;
}
__device__ __forceinline__ void xcd_barrier(const XcdBarrier& b) {
    asm volatile("s_waitcnt vmcnt(0)" ::: "memory");
    __syncthreads();
    if (threadIdx.x == 0) {
        unsigned* bar = b.bar;
        __builtin_amdgcn_s_waitcnt(0);
        unsigned nloc = b.st[0], nx = b.st[1];
        if (nloc == 0u) { xcd_barrier_complete(bar, b.x, nloc, nx); b.st[0] = nloc; b.st[1] = nx; }
        const unsigned old = xb_add(&bar[XB_XSUB(b.x)], 1u);
        const unsigned gen = old / nloc;
        if (old + 1u == (gen + 1u) * nloc) {
            __builtin_amdgcn_fence(__ATOMIC_RELEASE, "agent");
            asm volatile("s_waitcnt vmcnt(0)" ::: "memory");
            const unsigned og = xb_add(&bar[XB_TOP], 1u);
            const unsigned tg = og / nx;
            if (og + 1u == (tg + 1u) * nx) xb_add(&bar[XB_TOPGEN], 1u);
            else XB_SPIN(xb_ld(&bar[XB_TOPGEN]) == tg, bar);
            __builtin_amdgcn_fence(__ATOMIC_ACQUIRE, "agent");
            xb_add(&bar[XB_XGEN(b.x)], 1u);
            asm volatile("s_waitcnt vmcnt(0)" ::: "memory");
        } else {
            XB_SPIN(xb_ld(&bar[XB_XGEN(b.x)]) == gen, bar);
            __builtin_amdgcn_fence(__ATOMIC_ACQUIRE, "agent");
            asm volatile("s_waitcnt vmcnt(0)" ::: "memory");
        }
    }
    __syncthreads();
}


struct PanelOrder {
    int ntiles, G, c;
    __device__ void init(int M, int G_, int c_) { ntiles = (M / 256) * 4; G = G_; c = c_; }
    __device__ bool next(int i, pg8::Unit& u) const {
        const int L = i * G + c; if (L >= ntiles) return false;
        if (L < 256) { const int xcd = L & 7, j = L >> 3; u.pm = xcd * 8 + (j >> 2); u.pn = j & 3; }
        else { const int Lc = L - 256; u.pm = 64 + (Lc >> 2); u.pn = Lc & 3; }
        return true;
    }
};
template <bool FINAL>
struct EpiResidNorm {
    static constexpr bool PERM = true;
    const float* xin; bf16_t* X1; float* out;
    const float* mod;
    const float* nw;
    const float* mod_next;
    bf16_t* H;
    float* stat; unsigned* cnt;
    __device__ __forceinline__ void operator()(f32x4 (&acc)[2][2][4][2], const pg8::Unit& u, int wr, int wc, int fr, int fq, LAS unsigned char* lds) const {
        LAS float* P = (LAS float*)(lds + LDS_TOP + 64);
        LAS float* S = P + 1024;
        const int tid = threadIdx.x;
        asm volatile("s_waitcnt vmcnt(0)" ::: "memory"); __syncthreads();
        LAS unsigned char* park = lds + tid * 16;
        float q[2][4];
#pragma unroll
        for (int ai = 0; ai < 2; ++ai) {
            const int r0 = u.pm * 256 + ai * 128;
            const float* gp = mod + (r0 >> 12) * 3072 + 2048;
#pragma unroll
            for (int m = 0; m < 4; ++m) q[ai][m] = 0.f;
#pragma unroll
            for (int bj = 0; bj < 2; ++bj) {
                const int c0 = u.pn * 256 + bj * 128 + wc * 32 + 8 * fq;
                const f32x4 g0 = *(const f32x4*)(gp + c0), g1 = *(const f32x4*)(gp + c0 + 4);
#pragma unroll
                for (int m = 0; m < 4; ++m) {
                    const size_t off = (size_t)(r0 + wr * 64 + m * 16 + fr) * D + c0;
                    f32x4 b0, b1;
                    if (FINAL) { const u32x4 w = *(const u32x4*)(X1 + off); b0 = (f32x4){bf_lo(w.x), bf_hi(w.x), bf_lo(w.y), bf_hi(w.y)}; b1 = (f32x4){bf_lo(w.z), bf_hi(w.z), bf_lo(w.w), bf_hi(w.w)}; }
                    else { b0 = *(const f32x4*)(xin + off); b1 = *(const f32x4*)(xin + off + 4); }
                    const f32x4 x0 = b0 + g0 * acc[ai][bj][m][0], x1 = b1 + g1 * acc[ai][bj][m][1];
                    u32x4 w; w.x = pk2(x0[0], x0[1]); w.y = pk2(x0[2], x0[3]); w.z = pk2(x1[0], x1[1]); w.w = pk2(x1[2], x1[3]);
                    *(LAS u32x4*)(park + ((ai * 2 + bj) * 4 + m) * 8192) = w;
                    if (!FINAL) *(u32x4*)(X1 + off) = w;
                    q[ai][m] += ((x0[0] * x0[0] + x0[1] * x0[1]) + (x0[2] * x0[2] + x0[3] * x0[3])) + ((x1[0] * x1[0] + x1[1] * x1[1]) + (x1[2] * x1[2] + x1[3] * x1[3]));
                }
            }
        }
#pragma unroll
        for (int ai = 0; ai < 2; ++ai)
#pragma unroll
            for (int m = 0; m < 4; ++m) {
                float t = q[ai][m]; t += __shfl_xor(t, 16); t += __shfl_xor(t, 32);
                if (fq == 0) P[(ai * 128 + wr * 64 + m * 16 + fr) * 4 + wc] = t;
            }
        __syncthreads();
        float* st = stat + (size_t)u.pm * 1024;
        if (tid < 256) { const f32x4 p = *(const LAS f32x4*)(P + tid * 4);
            __hip_atomic_store(st + u.pn * 256 + tid, (p[0] + p[1]) + (p[2] + p[3]), __ATOMIC_RELAXED, __HIP_MEMORY_SCOPE_AGENT); }
        asm volatile("s_waitcnt vmcnt(0)" ::: "memory");
        __syncthreads();
        if (tid == 0) {
            __hip_atomic_fetch_add(cnt + 64 * u.pm, 1u, __ATOMIC_RELAXED, __HIP_MEMORY_SCOPE_AGENT);
            unsigned sp = 0;
            while (__hip_atomic_load(cnt + 64 * u.pm, __ATOMIC_RELAXED, __HIP_MEMORY_SCOPE_AGENT) < 4u) { __builtin_amdgcn_s_sleep(1); if (++sp > (1u << 20)) break; }
        }
        __syncthreads();
        if (tid < 256) {
            float t = 0.f;
#pragma unroll
            for (int k = 0; k < 4; ++k) t += __hip_atomic_load(st + k * 256 + tid, __ATOMIC_RELAXED, __HIP_MEMORY_SCOPE_AGENT);
            S[tid] = 1.0f / sqrtf(t * (1.0f / D) + 1e-6f);
        }
        __syncthreads();
#pragma unroll
        for (int ai = 0; ai < 2; ++ai) {
            const int r0 = u.pm * 256 + ai * 128;
            const float* mp = FINAL ? nullptr : mod_next + (r0 >> 12) * 3072;
#pragma unroll
            for (int bj = 0; bj < 2; ++bj) {
                const int c0 = u.pn * 256 + bj * 128 + wc * 32 + 8 * fq;
                f32x4 w0 = *(const f32x4*)(nw + c0), w1 = *(const f32x4*)(nw + c0 + 4), s0, s1;
                if (!FINAL) { w0 = w0 * (*(const f32x4*)(mp + 1024 + c0) + 1.0f); w1 = w1 * (*(const f32x4*)(mp + 1024 + c0 + 4) + 1.0f); s0 = *(const f32x4*)(mp + c0); s1 = *(const f32x4*)(mp + c0 + 4); }
#pragma unroll
                for (int m = 0; m < 4; ++m) {
                    const int rl = ai * 128 + wr * 64 + m * 16 + fr;
                    const float rstd = S[rl];
                    const size_t off = (size_t)(u.pm * 256 + rl) * D + c0;
                    const u32x4 xw = *(const LAS u32x4*)(park + ((ai * 2 + bj) * 4 + m) * 8192);
                    const f32x4 x0 = {bf_lo(xw.x), bf_hi(xw.x), bf_lo(xw.y), bf_hi(xw.y)}, x1 = {bf_lo(xw.z), bf_hi(xw.z), bf_lo(xw.w), bf_hi(xw.w)};
                    if (FINAL) { *(f32x4*)(out + off) = x0 * rstd * w0; *(f32x4*)(out + off + 4) = x1 * rstd * w1; }
                    else { const f32x4 y0 = x0 * rstd * w0 + s0, y1 = x1 * rstd * w1 + s1;
                        u32x4 w; w.x = pk2(y0[0], y0[1]); w.y = pk2(y0[2], y0[3]); w.z = pk2(y1[0], y1[1]); w.w = pk2(y1[2], y1[3]);
                        *(u32x4*)(H + off) = w; }
                }
            }
        }
        __syncthreads();
    }
};

template <class Epi>
__device__ __forceinline__ void gemm64_tile(LAS unsigned char* lds, const bf16_t* A, const bf16_t* Bt, const Epi& E) {
    constexpr int K = 1024, BK = 128, PITCH = BK * 2 + 16, NKT = K / BK;
    const int tid = threadIdx.x, lane = tid & 63, wave = __builtin_amdgcn_readfirstlane(tid >> 6), fr = lane & 15, fq = lane >> 4, wr = wave >> 1, wc = wave & 1;
    LAS unsigned char* As = lds; LAS unsigned char* Bs = lds + 64 * PITCH;
    const int srow = tid >> 4, sch = tid & 15;
    const bf16_t* ga = A + (size_t)srow * K + sch * 8; const bf16_t* gb = Bt + (size_t)srow * K + sch * 8;
    u32x4 ra[2], rb[2];
#pragma unroll
    for (int i = 0; i < 2; ++i) { ra[i] = *(const u32x4*)(ga + (size_t)(32 * i) * K); rb[i] = *(const u32x4*)(gb + (size_t)(32 * i) * K); }
    f32x4 acc[2] = {(f32x4){0.f, 0.f, 0.f, 0.f}, (f32x4){0.f, 0.f, 0.f, 0.f}};
    for (int kt = 0; kt < NKT; ++kt) {
        __syncthreads();
#pragma unroll
        for (int i = 0; i < 2; ++i) { *(LAS u32x4*)(As + (srow + 32 * i) * PITCH + sch * 16) = ra[i]; *(LAS u32x4*)(Bs + (srow + 32 * i) * PITCH + sch * 16) = rb[i]; }
        __syncthreads();
        if (kt + 1 < NKT) {
#pragma unroll
            for (int i = 0; i < 2; ++i) { ra[i] = *(const u32x4*)(ga + (size_t)(32 * i) * K + (kt + 1) * BK); rb[i] = *(const u32x4*)(gb + (size_t)(32 * i) * K + (kt + 1) * BK); }
        }
#pragma unroll
        for (int ks = 0; ks < 4; ++ks) {
            const bf16x8 Af = *(const LAS bf16x8*)(As + (16 * wr + fr) * PITCH + (32 * ks + 8 * fq) * 2);
#pragma unroll
            for (int n = 0; n < 2; ++n) {
                const bf16x8 Bf = *(const LAS bf16x8*)(Bs + (32 * wc + 16 * n + fr) * PITCH + (32 * ks + 8 * fq) * 2);
                acc[n] = __builtin_amdgcn_mfma_f32_16x16x32_bf16(Bf, Af, acc[n], 0, 0, 0);
            }
        }
    }
    __syncthreads();
    E(acc, wr, wc, fr, fq, lds);
}
struct Epi64Bf16 {
    bf16_t* O; int ldc;
    __device__ __forceinline__ void operator()(f32x4 (&acc)[2], int wr, int wc, int fr, int fq, LAS unsigned char* lds) const {
#pragma unroll
        for (int n = 0; n < 2; ++n) { u32x2 w; w.x = pk2(acc[n][0], acc[n][1]); w.y = pk2(acc[n][2], acc[n][3]);
            *(u32x2*)(O + (size_t)(16 * wr + fr) * ldc + 32 * wc + 16 * n + 4 * fq) = w; }
    }
};
struct Epi64ResidNorm {
    const float* base; const float* modc; const float* nw; const float* modc_next; bf16_t* H;
    int col0; float* stat; unsigned* cnt;
    int cb;
    __device__ __forceinline__ void operator()(f32x4 (&acc)[2], int wr, int wc, int fr, int fq, LAS unsigned char* lds) const {
        LAS float* P = (LAS float*)(lds + LDS_TOP + 64);
        LAS float* S = P + 128;
        const int tid = threadIdx.x, row = 16 * wr + fr;
        f32x4 x[2]; float q = 0.f;
#pragma unroll
        for (int n = 0; n < 2; ++n) { const int c = col0 + 32 * wc + 16 * n + 4 * fq;
            x[n] = *(const f32x4*)(base + (size_t)row * D + c) + *(const f32x4*)(modc + 2048 + c) * acc[n];
            q += (x[n][0] * x[n][0] + x[n][1] * x[n][1]) + (x[n][2] * x[n][2] + x[n][3] * x[n][3]); }
        q += __shfl_xor(q, 16); q += __shfl_xor(q, 32);
        if (fq == 0) P[row * 2 + wc] = q;
        __syncthreads();
        if (tid < 64) __hip_atomic_store(stat + cb * 64 + tid, P[tid * 2] + P[tid * 2 + 1], __ATOMIC_RELAXED, __HIP_MEMORY_SCOPE_AGENT);
        asm volatile("s_waitcnt vmcnt(0)" ::: "memory");
        __syncthreads();
        if (tid == 0) {
            __hip_atomic_fetch_add(cnt, 1u, __ATOMIC_RELAXED, __HIP_MEMORY_SCOPE_AGENT);
            unsigned sp = 0;
            while (__hip_atomic_load(cnt, __ATOMIC_RELAXED, __HIP_MEMORY_SCOPE_AGENT) < 16u) { __builtin_amdgcn_s_sleep(1); if (++sp > (1u << 20)) break; }
        }
        __syncthreads();
        if (tid < 64) { float t = 0.f;
#pragma unroll
            for (int k = 0; k < 16; ++k) t += __hip_atomic_load(stat + k * 64 + tid, __ATOMIC_RELAXED, __HIP_MEMORY_SCOPE_AGENT);
            S[tid] = 1.0f / sqrtf(t * (1.0f / D) + 1e-6f); }
        __syncthreads();
        const float rstd = S[row];
#pragma unroll
        for (int n = 0; n < 2; ++n) { const int c = col0 + 32 * wc + 16 * n + 4 * fq;
            const f32x4 y = x[n] * rstd * *(const f32x4*)(nw + c) * (*(const f32x4*)(modc_next + 1024 + c) + 1.0f) + *(const f32x4*)(modc_next + c);
            u32x2 w; w.x = pk2(y[0], y[1]); w.y = pk2(y[2], y[3]);
            *(u32x2*)(H + (size_t)row * D + c) = w; }
        __syncthreads();
    }
};

struct Args {
    const float* in[22];
    float* out;
    unsigned char* ws;
    int ph_lo, ph_hi, pad, pad2;
};

__device__ __forceinline__ void transpose_item(const float* W, int K, int N, bf16_t* WT, int k0, int n0, int dst_row0, LAS float* scr, int lane, bool perm = false) {
#pragma unroll 8
    for (int i = 0; i < 32; ++i) { const int kk = 2 * i + (lane >> 5); scr[kk * 33 + (lane & 31)] = W[(size_t)(k0 + kk) * N + n0 + (lane & 31)]; }
    WAVE_LDS_FENCE();
    const int c = lane & 7;
#pragma unroll
    for (int j = 0; j < 4; ++j) { const int n = (lane >> 3) + 8 * j; const LAS float* s = scr + (8 * c) * 33 + n;
        u32x4 o; o.x = pk2(s[0 * 33], s[1 * 33]); o.y = pk2(s[2 * 33], s[3 * 33]); o.z = pk2(s[4 * 33], s[5 * 33]); o.w = pk2(s[6 * 33], s[7 * 33]);
        const int nd = perm ? 8 * ((n & 15) >> 2) + 4 * (n >> 4) + (n & 3) : n;
        *(u32x4*)(WT + (size_t)(dst_row0 + nd) * K + k0 + 8 * c) = o; }
    WAVE_LDS_FENCE();
}

__device__ __forceinline__ void p0_prologue(const Args& a, LAS unsigned char* lds) {
    const int tid = threadIdx.x, lane = tid & 63, wave = tid >> 6, bid = blockIdx.x, G = gridDim.x;
    unsigned char* ws = a.ws;
    if (bid < 192) {
        LAS float* sv = (LAS float*)lds;
        LAS float* red = (LAS float*)(lds + 20480);
        const int layer = bid / 96, n0 = (bid % 96) * 32;
        const int c4 = lane & 7, kk = lane >> 3;
        const float* wp = a.in[5] + (size_t)layer * D * 3072 + (size_t)(wave * 128 + kk) * 3072 + n0 + 4 * c4;
        f32x4 w[16];
#pragma unroll
        for (int i = 0; i < 16; ++i) w[i] = *(const f32x4*)(wp + (size_t)(8 * i) * 3072);
        float cx[10];
#pragma unroll
        for (int j = 0; j < 10; ++j) { const int idx = tid + 512 * j, v = idx >> 10, k = idx & 1023; cx[j] = v < 4 ? a.in[1][v * D + k] : a.in[3][k]; }
#pragma unroll
        for (int j = 0; j < 10; ++j) sv[tid + 512 * j] = cx[j] / (1.0f + expf(-cx[j]));
        __syncthreads();
        f32x4 acc[5];
#pragma unroll
        for (int v = 0; v < 5; ++v) acc[v] = (f32x4){0.f, 0.f, 0.f, 0.f};
#pragma unroll
        for (int i = 0; i < 16; ++i) {
#pragma unroll
            for (int v = 0; v < 5; ++v) acc[v] += w[i] * sv[v * D + wave * 128 + 8 * i + kk];
        }
#pragma unroll
        for (int v = 0; v < 5; ++v)
#pragma unroll
            for (int j = 0; j < 4; ++j) { float t = acc[v][j]; t += __shfl_xor(t, 8); t += __shfl_xor(t, 16); t += __shfl_xor(t, 32); acc[v][j] = t; }
        if (kk == 0) {
#pragma unroll
            for (int v = 0; v < 5; ++v) *(LAS f32x4*)(red + (wave * 5 + v) * 32 + 4 * c4) = acc[v];
        }
        __syncthreads();
        if (tid < 160) { const int v = tid >> 5, c = tid & 31; float t = 0.f;
#pragma unroll
            for (int q = 0; q < 8; ++q) t += red[(q * 5 + v) * 32 + c];
            ((float*)(ws + WS_MOD))[(layer * 5 + v) * 3072 + n0 + c] = t + a.in[6][layer * 3072 + n0 + c]; }
        __syncthreads();
    }
    if (bid >= 192 && bid < 208) {
        const int id = (bid - 192) * 512 + tid;
        const int dg = id >> 6, p = id & 63;
        const float lre = a.in[11][id], lim = a.in[12][id], dt = expf(a.in[13][dg]);
        const float mag = expf(lre * dt), ar = mag * cosf(lim * dt), ai = mag * sinf(lim * dt);
        float pr = ar, pi = ai;
#pragma unroll
        for (int s = 0; s < 6; ++s) { const float nr = pr * pr - pi * pi, ni = 2.f * pr * pi; pr = nr; pi = ni; }
        ((f32x4*)(ws + WS_APOW))[id] = (f32x4){ar, ai, pr, pi};
        const float den = lre * lre + lim * lim, nr_ = ar - 1.0f, ni_ = ai;
        const float cr = (nr_ * lre + ni_ * lim) / den, ci = (ni_ * lre - nr_ * lim) / den;
        bf16_t* Bb = (bf16_t*)(ws + WS_BB) + (size_t)dg * 128 * 16;
        bf16_t* Cm = (bf16_t*)(ws + WS_CM) + (size_t)dg * 16 * 128;
        const float* bre = a.in[14] + (size_t)id * 16; const float* bim = a.in[15] + (size_t)id * 16;
#pragma unroll
        for (int h = 0; h < 16; h += 2) {
            const float r0 = cr * bre[h] - ci * bim[h], i0 = cr * bim[h] + ci * bre[h], r1 = cr * bre[h + 1] - ci * bim[h + 1], i1 = cr * bim[h + 1] + ci * bre[h + 1];
            *(unsigned*)(Bb + (2 * p) * 16 + h) = pk2(r0, r1); *(unsigned*)(Bb + (2 * p + 1) * 16 + h) = pk2(i0, i1);
        }
        const float* cre = a.in[16] + (size_t)dg * 16 * 64; const float* cim = a.in[17] + (size_t)dg * 16 * 64;
#pragma unroll
        for (int h = 0; h < 16; ++h) *(unsigned*)(Cm + h * 128 + 2 * p) = pk2(cre[h * 64 + p], -cim[h * 64 + p]);
    }
    if (bid >= 208 && bid < 210) {
        const int id = (bid - 208) * 512 + tid;
        const int val = id >> 4, f = id & 15;
        const float inv = powf(10000.0f, -(float)f / 16.0f), ang = (float)val * inv;
        float* rp = (float*)(ws + WS_ROPE);
        rp[val * 32 + f] = cosf(ang); rp[val * 32 + 16 + f] = sinf(ang);
    }
    LAS float* scr = (LAS float*)(lds + wave * 16384);
    const int gw = bid * 8 + wave, NGW = G * 8;
    constexpr int I0 = 16 * 80, I1 = 16 * 32;
    for (int it = gw; it < I0 + I1; it += NGW) {
        int r = it;
        if (r < I0) { const int nb = r % 80, kb = r / 80; transpose_item(a.in[7], D, NQKVZ, (bf16_t*)(ws + WS_WQKVZ), kb * 64, nb * 32, nb * 32, scr, lane, nb * 32 < 1280); continue; } r -= I0;
        { const int nb = r % 32, kb = r / 32; transpose_item(a.in[9], D, D, (bf16_t*)(ws + WS_WAO), kb * 64, nb * 32, nb * 32, scr, lane); }
    }
}
__device__ __forceinline__ void p2_late_transposes(const Args& a, LAS unsigned char* lds, int w0) {
    const int tid = threadIdx.x, lane = tid & 63, wave = tid >> 6, bid = blockIdx.x, G = gridDim.x;
    unsigned char* ws = a.ws;
    LAS float* scr = (LAS float*)(lds + wave * 16384);
    const bool all = (w0 <= 0 || w0 >= G);
    if (!all && bid < w0) return;
    const int gw = ((all ? bid : bid - w0) * 8 + wave), NGW = (all ? G : G - w0) * 8;
    constexpr int I2 = 16 * 64, I3 = 16 * 64, I4 = 16 * 32;
    for (int it = gw; it < I2 + I3 + I4; it += NGW) {
        int r = it;
        if (r < I2) { const int nb = r % 64, kb = r / 64; transpose_item(a.in[10], D, NUZ, (bf16_t*)(ws + WS_WSIN), kb * 64, nb * 32, nb * 32, scr, lane); continue; } r -= I2;
        if (r < I3) { const int nb = r % 64, kb = r / 64, n0 = nb * 32; const int dst = 256 * ((n0 & 1023) >> 7) + 128 * (n0 >> 10) + (n0 & 127);
                      transpose_item(a.in[19], D, NUZ, (bf16_t*)(ws + WS_WGLU), kb * 64, n0, dst, scr, lane); continue; } r -= I3;
        { const int nb = r % 32, kb = r / 32; transpose_item(a.in[20], D, D, (bf16_t*)(ws + WS_WSOUT), kb * 64, nb * 32, nb * 32, scr, lane); }
    }
}

__device__ __forceinline__ const float* norm_src(const float* xlat, const float* xctx, int r) { return r < NLAT ? xlat + (size_t)r * D : xctx + (size_t)(r - NLAT) * D; }
__device__ __forceinline__ void norm_mod_phase(const float* xlat, const float* xctx, const float* nw, const float* mod, bf16_t* H) {
    const int lane = threadIdx.x & 63, gw = blockIdx.x * 8 + (threadIdx.x >> 6), NGW = gridDim.x * 8;
    f32x4 w4[4];
#pragma unroll
    for (int j = 0; j < 4; ++j) w4[j] = ((const f32x4*)nw)[lane + 64 * j];
    const int per = NLAT / NGW;
    const int nrows = per + ((gw < NCTX && NGW >= NCTX) ? 1 : 0);
    if (NLAT % NGW != 0 || NGW < NCTX) {
        for (int r = gw; r < MTOT; r += NGW) {
            const float* xr = norm_src(xlat, xctx, r); const float* mp = mod + (r < NLAT ? (r >> 12) : 4) * 3072;
            f32x4 v[4]; float s = 0.f;
#pragma unroll
            for (int j = 0; j < 4; ++j) { v[j] = ((const f32x4*)xr)[lane + 64 * j]; s += (v[j].x * v[j].x + v[j].y * v[j].y) + (v[j].z * v[j].z + v[j].w * v[j].w); }
            const float rstd = 1.0f / sqrtf(wave_sum(s) * (1.0f / D) + 1e-6f);
            unsigned long long* o8 = (unsigned long long*)(H + (size_t)r * D) + lane;
#pragma unroll
            for (int j = 0; j < 4; ++j) { const f32x4 sh = ((const f32x4*)mp)[lane + 64 * j], sc = ((const f32x4*)(mp + 1024))[lane + 64 * j];
                const f32x4 y = v[j] * rstd * w4[j] * (sc + 1.0f) + sh; o8[64 * j] = (unsigned long long)pk2(y.x, y.y) | ((unsigned long long)pk2(y.z, y.w) << 32); }
        }
        return;
    }
    const int r0 = gw * per;
    f32x4 g4[4], sh4[4];
    { const float* mp = mod + (r0 >> 12) * 3072;
#pragma unroll
      for (int j = 0; j < 4; ++j) { g4[j] = w4[j] * (((const f32x4*)(mp + 1024))[lane + 64 * j] + 1.0f); sh4[j] = ((const f32x4*)mp)[lane + 64 * j]; } }
    f32x4 nx[4];
#pragma unroll
    for (int j = 0; j < 4; ++j) nx[j] = ((const f32x4*)(xlat + (size_t)r0 * D))[lane + 64 * j];
    for (int k = 0; k < nrows; ++k) {
        const bool isc = k == per;
        const int r = isc ? NLAT + gw : r0 + k;
        f32x4 v[4];
#pragma unroll
        for (int j = 0; j < 4; ++j) v[j] = nx[j];
        if (k + 1 < nrows) { const float* xr = (k + 1 == per) ? xctx + (size_t)gw * D : xlat + (size_t)(r0 + k + 1) * D;
#pragma unroll
            for (int j = 0; j < 4; ++j) nx[j] = ((const f32x4*)xr)[lane + 64 * j]; }
        if (isc) { const float* mp = mod + 4 * 3072;
#pragma unroll
            for (int j = 0; j < 4; ++j) { g4[j] = w4[j] * (((const f32x4*)(mp + 1024))[lane + 64 * j] + 1.0f); sh4[j] = ((const f32x4*)mp)[lane + 64 * j]; } }
        float s = 0.f;
#pragma unroll
        for (int j = 0; j < 4; ++j) s += (v[j].x * v[j].x + v[j].y * v[j].y) + (v[j].z * v[j].z + v[j].w * v[j].w);
        const float rstd = 1.0f / sqrtf(wave_sum(s) * (1.0f / D) + 1e-6f);
        unsigned long long* o8 = (unsigned long long*)(H + (size_t)r * D) + lane;
#pragma unroll
        for (int j = 0; j < 4; ++j) {
            const f32x4 y = v[j] * rstd * g4[j] + sh4[j];
            o8[64 * j] = (unsigned long long)pk2(y.x, y.y) | ((unsigned long long)pk2(y.z, y.w) << 32);
        }
    }
}
__device__ __forceinline__ void final_norm_phase(float* out, const float* nw) {
    const int lane = threadIdx.x & 63, gw = blockIdx.x * 8 + (threadIdx.x >> 6), NGW = gridDim.x * 8;
    f32x4 w4[4];
#pragma unroll
    for (int j = 0; j < 4; ++j) w4[j] = ((const f32x4*)nw)[lane + 64 * j];
    f32x4 nx[4];
#pragma unroll
    for (int j = 0; j < 4; ++j) nx[j] = ((const f32x4*)(out + (size_t)gw * D))[lane + 64 * j];
    for (int r = gw; r < NLAT; r += NGW) {
        f32x4* xr = (f32x4*)(out + (size_t)r * D);
        f32x4 v[4]; float s = 0.f;
#pragma unroll
        for (int j = 0; j < 4; ++j) v[j] = nx[j];
        if (r + NGW < NLAT) {
#pragma unroll
            for (int j = 0; j < 4; ++j) nx[j] = ((const f32x4*)(out + (size_t)(r + NGW) * D))[lane + 64 * j]; }
#pragma unroll
        for (int j = 0; j < 4; ++j) s += (v[j].x * v[j].x + v[j].y * v[j].y) + (v[j].z * v[j].z + v[j].w * v[j].w);
        const float rstd = 1.0f / sqrtf(wave_sum(s) * (1.0f / D) + 1e-6f);
#pragma unroll
        for (int j = 0; j < 4; ++j) xr[lane + 64 * j] = v[j] * rstd * w4[j];
    }
}

constexpr int KS_PITCH = 144, VT_PITCH = 264, VT_OFF = 128 * KS_PITCH;
constexpr int ATT_BUF = 36864;
constexpr float ATT_THR = 8.0f;
#define MFMA32(a, b, c) __builtin_amdgcn_mfma_f32_32x32x16_bf16((a), (b), (c), 0, 0, 0)
__device__ __forceinline__ void attn_phase(LAS unsigned char* lds, const bf16_t* QKVZ, bf16_t* AO, const float* sink) {
    const int tid = threadIdx.x, lane = tid & 63, wave = __builtin_amdgcn_readfirstlane(tid >> 6);
    const int ql = lane & 31, hh = lane >> 5, hq = wave & 3, qh = wave >> 2;
    int pb = 0;
    const bool bal = gridDim.x == 256;
    const int bi = blockIdx.x;
    int ctx_it = -1;
    { const int m = bi & 127, h = bi >> 7;
      if (m < 4) ctx_it = h * 4 + m; else if (m >= 124) ctx_it = 8 + h * 4 + (m - 124); else if (m >= 116) ctx_it = 16 + h * 8 + (m - 116); }
    const int nit = bal ? (ctx_it >= 0 ? 3 : 2) : (544 - bi + (int)gridDim.x - 1) / (int)gridDim.x;
#define ATT_ITEM(kk) (bal ? ((kk) == 0 ? bi : ((kk) == 1 ? 256 + ((bi + 8) & 255) : 512 + ctx_it)) : bi + (kk) * (int)gridDim.x)
#define ATT_QROW0(it) ((it) < 512 ? ((it) >> 7) * SEQ + (((it) >> 2) & 31) * 128 : NLAT + (((it) - 512) >> 3) * CTXL + ((((it) - 512) >> 2) & 1) * 128)
#define ATT_LOADQ(Q, it) do { const int qr0_ = ATT_QROW0(it), hd_ = ((it) & 3) * 4 + hq; _Pragma("unroll") for (int qt = 0; qt < 2; ++qt) _Pragma("unroll") for (int ks = 0; ks < 4; ++ks) \
        Q[qt][ks] = *(const bf16x8*)(QKVZ + (size_t)(qr0_ + 64 * qh + 32 * qt + ql) * NQKVZ + hd_ * 64 + 16 * ks + 8 * hh); } while (0)
#define ATT_LOADKV0(it) do { const bool ic_ = (it) >= 512; const int b_ = ic_ ? ((it) - 512) >> 3 : (it) >> 7, nb_ = ((it) >> 2) & 31, kh_ = (it) & 3; \
        const int kr0_ = ic_ ? NLAT + b_ * CTXL : b_ * SEQ + (nb_ == 0 ? 0 : nb_ - 1) * 128; \
        _Pragma("unroll") for (int i = 0; i < 2; ++i) { const int c = tid + 512 * i, key = c >> 3, dc = c & 7; kr[i] = *(const u32x4*)(QKVZ + (size_t)(kr0_ + key) * NQKVZ + 1024 + kh_ * 64 + dc * 8); } \
        va = *(const u32x4*)(QKVZ + (size_t)(kr0_ + 2 * kp) * NQKVZ + 1280 + kh_ * 64 + dcv * 8); \
        vb = *(const u32x4*)(QKVZ + (size_t)(kr0_ + 2 * kp + 1) * NQKVZ + 1280 + kh_ * 64 + dcv * 8); } while (0)
    const int kp = tid & 63, dcv = tid >> 6;
    u32x4 kr[2], va, vb;
    bf16x8 Qn[2][4];
    if (nit > 0) { ATT_LOADQ(Qn, ATT_ITEM(0)); ATT_LOADKV0(ATT_ITEM(0)); }
    for (int k = 0; k < nit; ++k) {
        const int item = ATT_ITEM(k);
        int b, kh, qrow0, nblk; bool isctx;
        if (item < 512) { b = item >> 7; nblk = (item >> 2) & 31; kh = item & 3; qrow0 = b * SEQ + nblk * 128; isctx = false; }
        else { const int r = item - 512; b = r >> 3; kh = r & 3; qrow0 = NLAT + b * CTXL + ((r >> 2) & 1) * 128; isctx = true; nblk = 0; }
        const int head = kh * 4 + hq;
        bf16x8 Qf[2][4];
#pragma unroll
        for (int qt = 0; qt < 2; ++qt)
#pragma unroll
            for (int ks = 0; ks < 4; ++ks) Qf[qt][ks] = Qn[qt][ks];
        f32x16 O[2][2];
#pragma unroll
        for (int dt = 0; dt < 2; ++dt)
#pragma unroll
            for (int qt = 0; qt < 2; ++qt)
#pragma unroll
                for (int i = 0; i < 16; ++i) O[dt][qt][i] = 0.f;
        const float sk = sink[head] * LOG2E;
        float m_[2] = {sk, sk}, l_[2]; l_[0] = l_[1] = (hh == 0) ? 1.0f : 0.0f;
        const int ntiles = isctx ? 2 : 5;
        int tcur = (!isctx && nblk == 0) ? 1 : 0;
        while (tcur < ntiles) {
            const int mode = (!isctx && tcur == 0) ? 1 : ((!isctx && tcur == 2) ? 2 : 0);
            LAS unsigned char* Ks = lds + pb * ATT_BUF; LAS unsigned char* Vt = Ks + VT_OFF; pb ^= 1;
            {
#pragma unroll
                for (int i = 0; i < 2; ++i) { const int c = tid + 512 * i, key = c >> 3, dc = c & 7; *(LAS u32x4*)(Ks + key * KS_PITCH + dc * 16) = kr[i]; }
                LAS unsigned char* vp = Vt + (dcv * 8) * VT_PITCH + kp * 4;
#pragma unroll
                for (int e = 0; e < 4; ++e) {
                    const unsigned wa = va[e], wb = vb[e];
                    *(LAS unsigned*)(vp + (2 * e) * VT_PITCH) = (wa & 0xffffu) | (wb << 16);
                    *(LAS unsigned*)(vp + (2 * e + 1) * VT_PITCH) = (wa >> 16) | (wb & 0xffff0000u);
                }
            }
            __syncthreads();
            int tnext = tcur + 1; if (!isctx && tnext == 2 && nblk == 31) tnext = 3;
            if (tnext < ntiles) {
                const int krow0 = isctx ? NLAT + b * CTXL + tnext * 128 : (tnext < 3 ? b * SEQ + (nblk - 1 + tnext) * 128 : NLAT + b * CTXL + (tnext - 3) * 128);
#pragma unroll
                for (int i = 0; i < 2; ++i) { const int c = tid + 512 * i, key = c >> 3, dc = c & 7; kr[i] = *(const u32x4*)(QKVZ + (size_t)(krow0 + key) * NQKVZ + 1024 + kh * 64 + dc * 8); }
                va = *(const u32x4*)(QKVZ + (size_t)(krow0 + 2 * kp) * NQKVZ + 1280 + kh * 64 + dcv * 8);
                vb = *(const u32x4*)(QKVZ + (size_t)(krow0 + 2 * kp + 1) * NQKVZ + 1280 + kh * 64 + dcv * 8);
            }
            tcur = tnext;
#pragma unroll 1
            for (int sub = 0; sub < 2; ++sub) {
                if ((mode == 1 && sub < qh) || (mode == 2 && sub > qh)) continue;
                f32x16 S[2][2];
#pragma unroll
                for (int kt = 0; kt < 2; ++kt)
#pragma unroll
                    for (int qt = 0; qt < 2; ++qt)
#pragma unroll
                        for (int i = 0; i < 16; ++i) S[kt][qt][i] = -m_[qt];
#pragma unroll
                for (int kt = 0; kt < 2; ++kt)
#pragma unroll
                    for (int ks = 0; ks < 4; ++ks) {
                        const bf16x8 Kf = *(const LAS bf16x8*)(Ks + (64 * sub + 32 * kt + ql) * KS_PITCH + (16 * ks + 8 * hh) * 2);
                        S[kt][0] = MFMA32(Kf, Qf[0][ks], S[kt][0]);
                        S[kt][1] = MFMA32(Kf, Qf[1][ks], S[kt][1]);
                    }
                if (mode) {
#pragma unroll
                    for (int kt = 0; kt < 2; ++kt)
#pragma unroll
                        for (int qt = 0; qt < 2; ++qt)
#pragma unroll
                            for (int i = 0; i < 16; ++i) {
                                const int j = 64 * sub + 32 * kt + 8 * (i >> 2) + 4 * hh + (i & 3), iq = 64 * qh + 32 * qt + ql;
                                const bool valid = (mode == 1) ? (j >= iq) : (j <= iq);
                                S[kt][qt][i] = valid ? S[kt][qt][i] : -1e30f;
                            }
                }
#pragma unroll
                for (int qt = 0; qt < 2; ++qt) {
                    float mx = S[0][qt][0];
#pragma unroll
                    for (int kt = 0; kt < 2; ++kt)
#pragma unroll
                        for (int i = 0; i < 16; ++i) mx = fmaxf(mx, S[kt][qt][i]);
                    { const auto rr = __builtin_amdgcn_permlane32_swap(__float_as_uint(mx), __float_as_uint(mx), false, false);
                      mx = fmaxf(__uint_as_float(rr[0]), __uint_as_float(rr[1])); }
                    float alpha = 1.0f;
                    if (!__builtin_expect(__all(mx <= ATT_THR), 1)) {
                        const float dlt = fmaxf(mx, 0.0f);
                        alpha = fast_exp2(-dlt); m_[qt] += dlt;
#pragma unroll
                        for (int i = 0; i < 16; ++i) { O[0][qt][i] *= alpha; O[1][qt][i] *= alpha; }
#pragma unroll
                        for (int kt = 0; kt < 2; ++kt)
#pragma unroll
                            for (int i = 0; i < 16; ++i) S[kt][qt][i] -= dlt;
                    }
                    float rs = 0.f;
#pragma unroll
                    for (int kt = 0; kt < 2; ++kt)
#pragma unroll
                        for (int i = 0; i < 16; ++i) { const float p = fast_exp2(S[kt][qt][i]); S[kt][qt][i] = p; rs += p; }
                    l_[qt] = l_[qt] * alpha + rs;
                }
#pragma unroll
                for (int kt = 0; kt < 2; ++kt)
#pragma unroll
                    for (int s2 = 0; s2 < 2; ++s2) {
                        bf16x8 Pf[2];
#pragma unroll
                        for (int qt = 0; qt < 2; ++qt) {
                            u32x4 w; w.x = pk2(S[kt][qt][8 * s2 + 0], S[kt][qt][8 * s2 + 1]); w.y = pk2(S[kt][qt][8 * s2 + 2], S[kt][qt][8 * s2 + 3]);
                            w.z = pk2(S[kt][qt][8 * s2 + 4], S[kt][qt][8 * s2 + 5]); w.w = pk2(S[kt][qt][8 * s2 + 6], S[kt][qt][8 * s2 + 7]);
                            Pf[qt] = __builtin_bit_cast(bf16x8, w);
                        }
#pragma unroll
                        for (int dt = 0; dt < 2; ++dt) {
                            const LAS unsigned char* ap = Vt + (32 * dt + ql) * VT_PITCH + (64 * sub + 32 * kt + 16 * s2 + 4 * hh) * 2;
                            const u32x2 lo = *(const LAS u32x2*)ap, hi = *(const LAS u32x2*)(ap + 16);
                            u32x4 w; w.x = lo.x; w.y = lo.y; w.z = hi.x; w.w = hi.y;
                            const bf16x8 Vf = __builtin_bit_cast(bf16x8, w);
                            O[dt][0] = MFMA32(Vf, Pf[0], O[dt][0]);
                            O[dt][1] = MFMA32(Vf, Pf[1], O[dt][1]);
                        }
                    }
            }
        }
        u32x2 zr[2][2][4];
#pragma unroll
        for (int qt = 0; qt < 2; ++qt)
#pragma unroll
            for (int dt = 0; dt < 2; ++dt)
#pragma unroll
                for (int a4 = 0; a4 < 4; ++a4)
                    zr[qt][dt][a4] = *(const u32x2*)(QKVZ + (size_t)(qrow0 + 64 * qh + 32 * qt + ql) * NQKVZ + 1536 + head * 64 + 32 * dt + 8 * a4 + 4 * hh);
        if (k + 1 < nit) { ATT_LOADQ(Qn, ATT_ITEM(k + 1)); ATT_LOADKV0(ATT_ITEM(k + 1)); }
#pragma unroll
        for (int qt = 0; qt < 2; ++qt) {
            const auto lr_ = __builtin_amdgcn_permlane32_swap(__float_as_uint(l_[qt]), __float_as_uint(l_[qt]), false, false);
            const float lt = __uint_as_float(lr_[0]) + __uint_as_float(lr_[1]), inv = 1.0f / lt;
            const size_t row = (size_t)(qrow0 + 64 * qh + 32 * qt + ql);
#pragma unroll
            for (int dt = 0; dt < 2; ++dt)
#pragma unroll
                for (int a4 = 0; a4 < 4; ++a4) {
                    const int d0 = 32 * dt + 8 * a4 + 4 * hh;
                    const u32x2 zw = zr[qt][dt][a4];
                    const float o0 = O[dt][qt][4 * a4 + 0] * inv * silu_f(bf_lo(zw.x)), o1 = O[dt][qt][4 * a4 + 1] * inv * silu_f(bf_hi(zw.x));
                    const float o2 = O[dt][qt][4 * a4 + 2] * inv * silu_f(bf_lo(zw.y)), o3 = O[dt][qt][4 * a4 + 3] * inv * silu_f(bf_hi(zw.y));
                    u32x2 w; w.x = pk2(o0, o1); w.y = pk2(o2, o3);
                    *(u32x2*)(AO + row * D + head * 64 + d0) = w;
                }
        }
    }
    __syncthreads();
}

constexpr int BU_PITCH = 132;
constexpr int XB_PITCH = 272;
template <bool OUT>
__device__ __forceinline__ void s5_chunk(LAS unsigned char* wl, const bf16x4 (&Uf)[4], const bf16x4 (&Bf)[8], const bf16x8 (&Cf)[4],
                                         float ar, float ai, float& xr, float& xi, int dir, f32x4 (&accY)[4], int lane) {
    LAS float* bu = (LAS float*)wl;
    LAS unsigned char* xb = wl + 16 * BU_PITCH * 4;
    const int fr = lane & 15, fq = lane >> 4;
#pragma unroll
    for (int mm = 0; mm < 4; ++mm) {
        const int m = dir ? 3 - mm : mm;
#pragma unroll
        for (int nt = 0; nt < 8; ++nt) {
            f32x4 c = {0.f, 0.f, 0.f, 0.f};
            c = __builtin_amdgcn_mfma_f32_16x16x16bf16_1k(m == 0 ? Uf[0] : m == 1 ? Uf[1] : m == 2 ? Uf[2] : Uf[3], Bf[nt], c, 0, 0, 0);
#pragma unroll
            for (int i = 0; i < 4; ++i) bu[(4 * fq + i) * BU_PITCH + 16 * nt + fr] = c[i];
        }
        WAVE_LDS_FENCE();
#pragma unroll
        for (int rr = 0; rr < 16; ++rr) {
            const int r = dir ? 15 - rr : rr;
            const f32x2 bb = *(const LAS f32x2*)(bu + r * BU_PITCH + 2 * lane);
            const float nr = fmaf(ar, xr, fmaf(-ai, xi, bb.x)), ni = fmaf(ar, xi, fmaf(ai, xr, bb.y));
            xr = nr; xi = ni;
            if (OUT) *(LAS unsigned*)(xb + r * XB_PITCH + lane * 4) = pk2(nr, ni);
        }
        if (OUT) {
            WAVE_LDS_FENCE();
            f32x4 y = (m == 0 ? accY[0] : m == 1 ? accY[1] : m == 2 ? accY[2] : accY[3]);
#pragma unroll
            for (int ks = 0; ks < 4; ++ks) {
                const bf16x8 Xf = *(const LAS bf16x8*)(xb + fr * XB_PITCH + (8 * fq + 32 * ks) * 2);
                y = __builtin_amdgcn_mfma_f32_16x16x32_bf16(Cf[ks], Xf, y, 0, 0, 0);
            }
            if (m == 0) accY[0] = y; else if (m == 1) accY[1] = y; else if (m == 2) accY[2] = y; else accY[3] = y;
        }
    }
}
__device__ __forceinline__ int chunk_rowbase(int b, int dir, int c) {
    if (dir == 0) return c < 4 ? NLAT + b * CTXL + 64 * c : b * SEQ + 64 * (c - 4);
    return c < 4 ? NLAT + b * CTXL + 64 * (3 - c) : b * SEQ + 64 * (63 - (c - 4));
}
__device__ __forceinline__ void load_uf(bf16x4 (&Uf)[4], const bf16_t* UZ, int rowbase, int g, int lane) {
#pragma unroll
    for (int m = 0; m < 4; ++m) Uf[m] = *(const bf16x4*)(UZ + (size_t)(rowbase + 16 * m + (lane & 15)) * NUZ + 16 * g + 4 * (lane >> 4));
}
__device__ __forceinline__ void cmul(float& xr, float& xi, float ar, float ai) { const float nr = xr * ar - xi * ai, ni = xr * ai + xi * ar; xr = nr; xi = ni; }
__device__ __forceinline__ bf16x4 cscale_bf(const bf16x4 re, const bf16x4 im, float wr, float wi, bool want_im) {
    bf16x4 o;
#pragma unroll
    for (int k = 0; k < 4; k += 2) {
        const float r0 = __uint_as_float((unsigned)(unsigned short)re[k] << 16), r1 = __uint_as_float((unsigned)(unsigned short)re[k + 1] << 16);
        const float i0 = __uint_as_float((unsigned)(unsigned short)im[k] << 16), i1 = __uint_as_float((unsigned)(unsigned short)im[k + 1] << 16);
        const unsigned w = want_im ? pk2(wr * i0 + wi * r0, wr * i1 + wi * r1) : pk2(wr * r0 - wi * i0, wr * r1 - wi * i1);
        o[k] = (short)(w & 0xffffu); o[k + 1] = (short)(w >> 16);
    }
    return o;
}
template <int DIR>
__device__ __forceinline__ void s5_local_dir(const bf16_t* UZ, unsigned char* ws, int gw, int NGW, int lane) {
    float* E = (float*)(ws + WS_E);
    const int pair = gw & 127, g = pair & 63, fr = lane & 15, fq = lane >> 4;
    const bf16_t* Bb = (const bf16_t*)(ws + WS_BB) + (size_t)pair * 128 * 16;
    bf16x4 Bre[4][4], Bim[4][4]; float a1r[4], a1i[4], a64r[4], a64i[4], wr_[4], wi_[4];
#pragma unroll
    for (int t = 0; t < 4; ++t) {
        const int p = 16 * t + fr;
        const bf16x4 b_re = *(const bf16x4*)(Bb + (2 * p) * 16 + 4 * fq), b_im = *(const bf16x4*)(Bb + (2 * p + 1) * 16 + 4 * fq);
        const f32x4 ap = ((const f32x4*)(ws + WS_APOW))[pair * 64 + p];
        const float ar = ap.x, ai = ap.y;
        float r2 = ar, i2 = ai; cmul(r2, i2, ar, ai);
        float r4 = r2, i4 = i2; cmul(r4, i4, r2, i2);
        float r8 = r4, i8 = i4; cmul(r8, i8, r4, i4);
        float r12 = r8, i12 = i8; cmul(r12, i12, r4, i4);
        float r16 = r8, i16 = i8; cmul(r16, i16, r8, i8);
        float r32 = r16, i32 = i16; cmul(r32, i32, r16, i16);
        float r48 = r32, i48 = i32; cmul(r48, i48, r16, i16);
        a1r[t] = ar; a1i[t] = ai; a64r[t] = ap.z; a64i[t] = ap.w;
        const int e = DIR ? fq : 3 - fq;
        wr_[t] = e == 0 ? 1.f : e == 1 ? r4 : e == 2 ? r8 : r12; wi_[t] = e == 0 ? 0.f : e == 1 ? i4 : e == 2 ? i8 : i12;
#pragma unroll
        for (int m = 0; m < 4; ++m) {
            const int em = DIR ? m : 3 - m;
            const float pr = em == 0 ? 1.f : em == 1 ? r16 : em == 2 ? r32 : r48, pi = em == 0 ? 0.f : em == 1 ? i16 : em == 2 ? i32 : i48;
            Bre[m][t] = cscale_bf(b_re, b_im, pr, pi, false); Bim[m][t] = cscale_bf(b_re, b_im, pr, pi, true);
        }
    }
    const int qd = gw >> 7, b = qd >> 2, q = qd & 3;
    if (qd >= 16) return;
    const int c0 = 17 * q, c1 = q < 3 ? c0 + 17 : 67;
    float Rr[4] = {0.f, 0.f, 0.f, 0.f}, Ri[4] = {0.f, 0.f, 0.f, 0.f};
    float* ebase = E + ((size_t)((b * 2 + DIR) * 64 + g) * NCHUNK) * 128;
    bf16x4 Un[4];
    load_uf(Un, UZ, chunk_rowbase(b, DIR, c0), g, lane);
    for (int c = c0; c < c1; ++c) {
        bf16x4 Uf[4];
#pragma unroll
        for (int m = 0; m < 4; ++m) Uf[m] = Un[m];
        if (c + 1 < c1) load_uf(Un, UZ, chunk_rowbase(b, DIR, c + 1), g, lane);
        float* e = ebase + (size_t)c * 128;
#pragma unroll
        for (int t = 0; t < 4; ++t) {
            f32x4 cr = {0.f, 0.f, 0.f, 0.f}, ci = {0.f, 0.f, 0.f, 0.f};
#pragma unroll
            for (int m = 0; m < 4; ++m) {
                cr = __builtin_amdgcn_mfma_f32_16x16x16bf16_1k(Uf[m], Bre[m][t], cr, 0, 0, 0);
                ci = __builtin_amdgcn_mfma_f32_16x16x16bf16_1k(Uf[m], Bim[m][t], ci, 0, 0, 0);
            }
            f32x2 s2 = {DIR ? cr[3] : cr[0], DIR ? ci[3] : ci[0]};
#pragma unroll
            for (int ii = 1; ii < 4; ++ii) { const int i = DIR ? 3 - ii : ii;
                s2 = cmac(s2, (f32x2){a1r[t], a1r[t]}, (f32x2){-a1i[t], a1i[t]}, (f32x2){cr[i], ci[i]}); }
            s2 = cmac(s2, (f32x2){wr_[t], wr_[t]}, (f32x2){-wi_[t], wi_[t]}, (f32x2){0.f, 0.f});
            float sr = s2.x, si = s2.y;
            sr += __shfl_xor(sr, 16); si += __shfl_xor(si, 16); sr += __shfl_xor(sr, 32); si += __shfl_xor(si, 32);
            if (fq == 0) { e[16 * t + fr] = Rr[t]; e[64 + 16 * t + fr] = Ri[t]; }
            const float nr = fmaf(a64r[t], Rr[t], fmaf(-a64i[t], Ri[t], sr)), ni = fmaf(a64r[t], Ri[t], fmaf(a64i[t], Rr[t], si)); Rr[t] = nr; Ri[t] = ni;
        }
    }
    float* fin = q < 3 ? (float*)(ws + WS_QE) + ((size_t)((b * 2 + DIR) * 64 + g) * 3 + q) * 128 : ebase + (size_t)67 * 128;
    if (fq == 0) {
#pragma unroll
        for (int t = 0; t < 4; ++t) { fin[16 * t + fr] = Rr[t]; fin[64 + 16 * t + fr] = Ri[t]; }
    }
}
__device__ __forceinline__ void s5_local_phase(LAS unsigned char* lds, const bf16_t* UZ, unsigned char* ws) {
    const int lane = threadIdx.x & 63, wave = __builtin_amdgcn_readfirstlane(threadIdx.x >> 6);
    const int gw = blockIdx.x * 8 + wave, NGW = gridDim.x * 8;
    if ((gw & 127) >> 6) s5_local_dir<1>(UZ, ws, gw, NGW, lane); else s5_local_dir<0>(UZ, ws, gw, NGW, lane);
}
__device__ __forceinline__ void s5_carry_phase(unsigned char* ws) {
    const int gt = blockIdx.x * 128 + (threadIdx.x & 127);
    if (threadIdx.x >= 128 || gt >= NB * 2 * 64 * 64) return;
    const int p = gt & 63, g = (gt >> 6) & 63, bd = gt >> 12, dir = bd & 1;
    const f32x4 ap = ((const f32x4*)(ws + WS_APOW))[(dir * 64 + g) * 64 + p];
    float* e = (float*)(ws + WS_E) + ((size_t)(bd * 64 + g) * NCHUNK) * 128 + p;
    float er[NCHUNK - 1], ei[NCHUNK - 1];
#pragma unroll
    for (int c = 0; c < NCHUNK - 1; ++c) { er[c] = e[c * 128]; ei[c] = e[c * 128 + 64]; }
    float xr = 0.f, xi = 0.f;
#pragma unroll
    for (int c = 0; c < NCHUNK - 1; ++c) {
        const float nr = ap.z * xr - ap.w * xi + er[c], ni = ap.z * xi + ap.w * xr + ei[c];
        er[c] = xr; ei[c] = xi; xr = nr; xi = ni;
    }
#pragma unroll
    for (int c = 0; c < NCHUNK - 1; ++c) { e[c * 128] = er[c]; e[c * 128 + 64] = ei[c]; }
    e[(NCHUNK - 1) * 128] = xr; e[(NCHUNK - 1) * 128 + 64] = xi;
}
__device__ __forceinline__ f32x2 s5_carry(const f32x2 pre, const f32x2 (&qe)[3], const f32x4 ap, int c) {
    const int q = c / 17, k = c - 17 * q;
    if (q == 0) return pre;
    float A1r = ap.z, A1i = ap.w;
    float A2r = A1r, A2i = A1i; cmul(A2r, A2i, A1r, A1i);
    float A4r = A2r, A4i = A2i; cmul(A4r, A4i, A2r, A2i);
    float A8r = A4r, A8i = A4i; cmul(A8r, A8i, A4r, A4i);
    float A16r = A8r, A16i = A8i; cmul(A16r, A16i, A8r, A8i);
    float A17r = A16r, A17i = A16i; cmul(A17r, A17i, A1r, A1i);
    float sr = qe[0].x, si = qe[0].y;
    if (q >= 2) { cmul(sr, si, A17r, A17i); sr += qe[1].x; si += qe[1].y; }
    if (q >= 3) { cmul(sr, si, A17r, A17i); sr += qe[2].x; si += qe[2].y; }
    if (k & 1) cmul(sr, si, A1r, A1i);
    if (k & 2) cmul(sr, si, A2r, A2i);
    if (k & 4) cmul(sr, si, A4r, A4i);
    if (k & 8) cmul(sr, si, A8r, A8i);
    if (k & 16) cmul(sr, si, A16r, A16i);
    return (f32x2){pre.x + sr, pre.y + si};
}
constexpr int BUT_BYTES = 64 * 80, XB_BYTES = 16 * XB_PITCH;
__device__ __forceinline__ float bf_at(const u32x4& lo, const u32x4& hi, int r) { const unsigned w = (r < 8 ? lo : hi)[(r & 7) >> 1]; return (r & 1) ? bf_hi(w) : bf_lo(w); }
__device__ __forceinline__ void s5_out_phase(LAS unsigned char* lds, const bf16_t* UZ, const unsigned char* ws, const float* dskip, bf16_t* YG) {
    const int lane = threadIdx.x & 63, wave = __builtin_amdgcn_readfirstlane(threadIdx.x >> 6);
    LAS unsigned char* wl = lds + wave * S5_WAVE_LDS;
    const int gw = blockIdx.x * 8 + wave, NGW = gridDim.x * 8;
    const float* E = (const float*)(ws + WS_E);
    const int g = gw & 63, fr = lane & 15, fq = lane >> 4;
    const f32x4 dsk = *(const f32x4*)(dskip + 16 * g + 4 * fq);
    bf16x4 Bf[2][8]; bf16x8 Cf[2][4]; f32x4 ap[2];
#pragma unroll
    for (int dir = 0; dir < 2; ++dir) {
        const int pair = dir * 64 + g;
        const bf16_t* Bb = (const bf16_t*)(ws + WS_BB) + (size_t)pair * 128 * 16;
        const bf16_t* Cm = (const bf16_t*)(ws + WS_CM) + (size_t)pair * 16 * 128;
#pragma unroll
        for (int nt = 0; nt < 8; ++nt) Bf[dir][nt] = *(const bf16x4*)(Bb + (16 * nt + fr) * 16 + 4 * fq);
#pragma unroll
        for (int ks = 0; ks < 4; ++ks) Cf[dir][ks] = *(const bf16x8*)(Cm + fr * 128 + 8 * fq + 32 * ks);
        ap[dir] = ((const f32x4*)(ws + WS_APOW))[pair * 64 + lane];
    }
    const int wofs = (fr >> 1) * 80 + (fr & 1) * 32 + 8 * fq;
    const int sstep = NGW >> 6;
    const float* QE = (const float*)(ws + WS_QE);
    bf16x4 Un[4]; f32x2 rp[2], rq[2][3];
#define S5_LOADRAW(bb, ttt) do { _Pragma("unroll") for (int dir = 0; dir < 2; ++dir) { const int c_ = dir ? 4 + 63 - (ttt) : 4 + (ttt); \
        const float* e_ = E + ((size_t)(((bb) * 2 + dir) * 64 + g) * NCHUNK + c_) * 128; rp[dir] = (f32x2){e_[lane], e_[64 + lane]}; \
        const float* q_ = QE + ((size_t)(((bb) * 2 + dir) * 64 + g) * 3) * 128; \
        _Pragma("unroll") for (int j = 0; j < 3; ++j) rq[dir][j] = (f32x2){q_[j * 128 + lane], q_[j * 128 + 64 + lane]}; } } while (0)
    { const int slot = gw >> 6, b = slot >> 6, tt = slot & 63;
      load_uf(Un, UZ, b * SEQ + 64 * tt, g, lane);
      S5_LOADRAW(b, tt); }
    for (int slot = gw >> 6; slot < 256; slot += sstep) {
        const int b = slot >> 6, tt = slot & 63, rowbase = b * SEQ + 64 * tt;
        bf16x4 Uf[4];
#pragma unroll
        for (int m = 0; m < 4; ++m) Uf[m] = Un[m];
        const f32x2 cF_ = s5_carry(rp[0], rq[0], ap[0], 4 + tt), cB_ = s5_carry(rp[1], rq[1], ap[1], 4 + 63 - tt);
        float xfr = cF_.x, xfi = cF_.y, xbr = cB_.x, xbi = cB_.y;
        if (slot + sstep < 256) { const int ns = slot + sstep, nb = ns >> 6, ntt = ns & 63;
            load_uf(Un, UZ, nb * SEQ + 64 * ntt, g, lane);
            S5_LOADRAW(nb, ntt); }
        f32x4 accY[4];
#pragma unroll
        for (int m = 0; m < 4; ++m) accY[m] = (f32x4){0.f, 0.f, 0.f, 0.f};
#pragma unroll
        for (int mm = 0; mm < 4; ++mm) {
            const int mf = mm, mb = 3 - mm;
#pragma unroll
            for (int nt = 0; nt < 8; ++nt) {
                const f32x4 z = {0.f, 0.f, 0.f, 0.f};
                const f32x4 cf = __builtin_amdgcn_mfma_f32_16x16x16bf16_1k(Uf[mf], Bf[0][nt], z, 0, 0, 0);
                const f32x4 cb = __builtin_amdgcn_mfma_f32_16x16x16bf16_1k(Uf[mb], Bf[1][nt], z, 0, 0, 0);
                u32x2 wf, wb; wf.x = pk2(cf[0], cf[1]); wf.y = pk2(cf[2], cf[3]); wb.x = pk2(cb[0], cb[1]); wb.y = pk2(cb[2], cb[3]);
                *(LAS u32x2*)(wl + nt * 640 + wofs) = wf;
                *(LAS u32x2*)(wl + BUT_BYTES + nt * 640 + wofs) = wb;
            }
            WAVE_LDS_FENCE();
            const LAS unsigned char* rp = wl + lane * 80;
            const u32x4 fre0 = *(const LAS u32x4*)(rp), fre1 = *(const LAS u32x4*)(rp + 16), fim0 = *(const LAS u32x4*)(rp + 32), fim1 = *(const LAS u32x4*)(rp + 48);
            const u32x4 bre0 = *(const LAS u32x4*)(rp + BUT_BYTES), bre1 = *(const LAS u32x4*)(rp + BUT_BYTES + 16), bim0 = *(const LAS u32x4*)(rp + BUT_BYTES + 32), bim1 = *(const LAS u32x4*)(rp + BUT_BYTES + 48);
            LAS unsigned char* xf = wl + 2 * BUT_BYTES; LAS unsigned char* xbk = xf + XB_BYTES;
#pragma unroll
            for (int rr = 0; rr < 16; ++rr) {
                const int r = rr, rb = 15 - rr;
                { const f32x2 bb = {bf_at(fre0, fre1, r), bf_at(fim0, fim1, r)};
                  const f32x2 n2 = cmac((f32x2){xfr, xfi}, (f32x2){ap[0].x, ap[0].x}, (f32x2){-ap[0].y, ap[0].y}, bb); xfr = n2.x; xfi = n2.y;
                  *(LAS unsigned*)(xf + r * XB_PITCH + lane * 4) = pk2(n2.x, n2.y); }
                { const f32x2 bb = {bf_at(bre0, bre1, rb), bf_at(bim0, bim1, rb)};
                  const f32x2 n2 = cmac((f32x2){xbr, xbi}, (f32x2){ap[1].x, ap[1].x}, (f32x2){-ap[1].y, ap[1].y}, bb); xbr = n2.x; xbi = n2.y;
                  *(LAS unsigned*)(xbk + rb * XB_PITCH + lane * 4) = pk2(n2.x, n2.y); }
            }
            WAVE_LDS_FENCE();
#pragma unroll
            for (int ks = 0; ks < 4; ++ks) {
                const bf16x8 Xf = *(const LAS bf16x8*)(xf + fr * XB_PITCH + (8 * fq + 32 * ks) * 2);
                const bf16x8 Xb = *(const LAS bf16x8*)(xbk + fr * XB_PITCH + (8 * fq + 32 * ks) * 2);
                accY[mf] = __builtin_amdgcn_mfma_f32_16x16x32_bf16(Cf[0][ks], Xf, accY[mf], 0, 0, 0);
                accY[mb] = __builtin_amdgcn_mfma_f32_16x16x32_bf16(Cf[1][ks], Xb, accY[mb], 0, 0, 0);
            }
        }
#pragma unroll
        for (int m = 0; m < 4; ++m) {
            const unsigned u0 = (unsigned)(unsigned short)Uf[m][0] | ((unsigned)(unsigned short)Uf[m][1] << 16), u1 = (unsigned)(unsigned short)Uf[m][2] | ((unsigned)(unsigned short)Uf[m][3] << 16);
            const float y0 = gelu_f(accY[m][0] + dsk[0] * bf_lo(u0)), y1 = gelu_f(accY[m][1] + dsk[1] * bf_hi(u0));
            const float y2 = gelu_f(accY[m][2] + dsk[2] * bf_lo(u1)), y3 = gelu_f(accY[m][3] + dsk[3] * bf_hi(u1));
            u32x2 w; w.x = pk2(y0, y1); w.y = pk2(y2, y3);
            *(u32x2*)(YG + (size_t)(rowbase + 16 * m + fr) * D + 16 * g + 4 * fq) = w;
        }
    }
}

__global__ void __launch_bounds__(512, 2) fwd_megakernel(Args a) {
    extern __shared__ __attribute__((aligned(16))) unsigned char lds_raw[];
    LAS unsigned char* lds = (LAS unsigned char*)lds_raw;
    cg::grid_group grid = cg::this_grid();
    unsigned char* ws = a.ws;
    volatile LAS unsigned* bst = (volatile LAS unsigned*)(lds + LDS_TOP);
    if (threadIdx.x < 2) bst[threadIdx.x] = 0u;
    __syncthreads();
    const XcdBarrier xbar = xcd_barrier_post((unsigned*)(ws + WS_BAR), bst);
    if (a.pad == 0x7ead) grid.sync();
    const int lo = a.ph_lo, hi = a.ph_hi;
    const int G = gridDim.x, bid = blockIdx.x;
    const float* mod0 = (const float*)(ws + WS_MOD);
    const float* mod1 = mod0 + 5 * 3072;
    bf16_t* H = (bf16_t*)(ws + WS_H);
    bf16_t* QKVZ = (bf16_t*)(ws + WS_QKVZ);
    bf16_t* AO = (bf16_t*)(ws + WS_AO);
    float* CTX1 = (float*)(ws + WS_CTX1);
#define IN(k) (lo <= (k) && (k) < hi)
#define SEAM(k) do { if (IN(k) && IN((k) + 1)) { xcd_barrier(xbar); if (SYNC_REP > 1) xcd_barrier(xbar); } } while (0)
#define REPB(k) ((((REP_MASK) >> (k)) & 1) != 0)
    if (IN(0)) p0_prologue(a, lds);
    if (IN(0) && REPB(0)) p0_prologue(a, lds);
    SEAM(0);
    if (IN(1)) norm_mod_phase(a.in[0], a.in[2], a.in[4], mod0, H);
    if (IN(1) && REPB(1)) norm_mod_phase(a.in[0], a.in[2], a.in[4], mod0, H);
    SEAM(1);
    if (IN(2)) { pg8::Gemm g{H, (const bf16_t*)(ws + WS_WQKVZ), MTOT, NQKVZ, D}; pg8::StaticOrder S; S.init(MTOT, NQKVZ, G, bid);
        EpiQKVZ E{QKVZ, (const float*)(ws + WS_ROPE)}; pg8::gemm_phase<EpiQKVZ, pg8::StaticOrder>(lds, g, S, E);
        p2_late_transposes(a, lds, (MTOT / 256) * (NQKVZ / 256) - 2 * G); }
    if (IN(2) && REPB(2)) { pg8::Gemm g{H, (const bf16_t*)(ws + WS_WQKVZ), MTOT, NQKVZ, D}; pg8::StaticOrder S; S.init(MTOT, NQKVZ, G, bid);
        EpiQKVZ E{QKVZ, (const float*)(ws + WS_ROPE)}; pg8::gemm_phase<EpiQKVZ, pg8::StaticOrder>(lds, g, S, E); }
    SEAM(2);
    if (IN(3)) attn_phase(lds, QKVZ, AO, a.in[8]);
    if (IN(3) && REPB(3)) attn_phase(lds, QKVZ, AO, a.in[8]);
    SEAM(3);
    if (IN(4)) { pg8::Gemm g{AO, (const bf16_t*)(ws + WS_WAO), NLAT, D, D}; PanelOrder S; S.init(NLAT, G, bid);
        EpiResidNorm<false> E{a.in[0], (bf16_t*)(ws + WS_X1), nullptr, mod0, a.in[4] + D, mod1, H, (float*)(ws + WS_STAT), (unsigned*)(ws + WS_CNT)};
        pg8::gemm_phase<EpiResidNorm<false>, PanelOrder>(lds, g, S, E);
        if (bid < 256) { const int rb = bid >> 4, cb = bid & 15;
            Epi64ResidNorm E2{a.in[2] + (size_t)rb * 64 * D, mod0 + 4 * 3072, a.in[4] + D, mod1 + 4 * 3072, H + (size_t)(NLAT + rb * 64) * D, cb * 64,
                              (float*)(ws + WS_STATC) + rb * 1024, (unsigned*)(ws + WS_CNTC) + rb * 64, cb};
            gemm64_tile<Epi64ResidNorm>(lds, AO + (size_t)(NLAT + rb * 64) * D, (const bf16_t*)(ws + WS_WAO) + (size_t)cb * 64 * D, E2); } }
    SEAM(5);
    if (IN(6)) { pg8::Gemm g{H, (const bf16_t*)(ws + WS_WSIN), NLAT, NUZ, D}; pg8::StaticOrder S; S.init(NLAT, NUZ, G, bid);
        EpiBf16 E{QKVZ, NUZ}; pg8::gemm_phase<EpiBf16, pg8::StaticOrder>(lds, g, S, E);
        if (bid < 256) { const int rb = bid >> 4, cb = bid & 15;
            Epi64Bf16 E2{QKVZ + (size_t)(NLAT + rb * 64) * NUZ + cb * 64, NUZ};
            gemm64_tile<Epi64Bf16>(lds, H + (size_t)(NLAT + rb * 64) * D, (const bf16_t*)(ws + WS_WSIN) + (size_t)cb * 64 * D, E2); } }
    SEAM(6);
    if (IN(7)) s5_local_phase(lds, QKVZ, ws);
    if (IN(7) && REPB(7)) s5_local_phase(lds, QKVZ, ws);
    SEAM(7);
    if (IN(9)) s5_out_phase(lds, QKVZ, ws, a.in[18], AO);
    if (IN(9) && REPB(9)) s5_out_phase(lds, QKVZ, ws, a.in[18], AO);
    SEAM(9);
    if (IN(10)) { pg8::Gemm g{AO, (const bf16_t*)(ws + WS_WGLU), NLAT, NUZ, D}; pg8::StaticOrder S; S.init(NLAT, NUZ, G, bid);
        EpiGlu E{H, QKVZ}; pg8::gemm_phase<EpiGlu, pg8::StaticOrder>(lds, g, S, E); }
    if (IN(10) && REPB(10)) { pg8::Gemm g{AO, (const bf16_t*)(ws + WS_WGLU), NLAT, NUZ, D}; pg8::StaticOrder S; S.init(NLAT, NUZ, G, bid);
        EpiGlu E{H, QKVZ}; pg8::gemm_phase<EpiGlu, pg8::StaticOrder>(lds, g, S, E); }
    SEAM(10);
    if (IN(11)) { pg8::Gemm g{H, (const bf16_t*)(ws + WS_WSOUT), NLAT, D, D}; PanelOrder S; S.init(NLAT, G, bid);
        EpiResidNorm<true> E{nullptr, (bf16_t*)(ws + WS_X1), a.out, mod1, a.in[21], nullptr, nullptr, (float*)(ws + WS_STAT) + 68 * 1024, (unsigned*)(ws + WS_CNT) + 68 * 64};
        pg8::gemm_phase<EpiResidNorm<true>, PanelOrder>(lds, g, S, E); }
#undef IN
#undef SEAM
}

extern "C" void kernel_launch(void* const* d_in, const int* in_sizes, int n_in, void* d_out, int out_size, void* d_ws, size_t ws_size, hipStream_t stream) {
    static int grid = 0;
    if (grid == 0) {
        int dev = 0, cus = 0, per_cu = 0;
        (void)hipGetDevice(&dev);
        (void)hipDeviceGetAttribute(&cus, hipDeviceAttributeMultiprocessorCount, dev);
        (void)hipFuncSetAttribute((const void*)fwd_megakernel, hipFuncAttributeMaxDynamicSharedMemorySize, LDS_BYTES);
        (void)hipOccupancyMaxActiveBlocksPerMultiprocessor(&per_cu, (const void*)fwd_megakernel, 512, LDS_BYTES);
        if (per_cu < 1) per_cu = 1;
        grid = cus * per_cu;
        if (n_in != 22 || ws_size < WS_END) { fprintf(stderr, "kernel_launch: unexpected n_in %d / ws_size %zu\n", n_in, ws_size); }
    }
    Args a{};
    for (int i = 0; i < 22; ++i) a.in[i] = (const float*)d_in[i];
    a.out = (float*)d_out; a.ws = (unsigned char*)d_ws; a.ph_lo = 0; a.ph_hi = 13;
    (void)hipMemsetAsync((char*)d_ws + WS_BAR, 0, BAR_ZERO_BYTES, stream);
    void* args[] = {&a};
    hipError_t e = hipLaunchCooperativeKernel((void*)fwd_megakernel, dim3(grid), dim3(512), args, LDS_BYTES, stream);
    if (e != hipSuccess) fprintf(stderr, "cooperative launch failed: %s (grid %d)\n", hipGetErrorString(e), grid);
}
```

```cpp
#include <hip/hip_runtime.h>
#include <hip/hip_cooperative_groups.h>
#include <cstdio>
#include <cstdint>
namespace cg = cooperative_groups;

#define LAS __attribute__((address_space(3)))
typedef unsigned short bf16_t;
typedef short bf16x8 __attribute__((ext_vector_type(8)));
typedef short bf16x4 __attribute__((ext_vector_type(4)));
typedef float f32x4 __attribute__((ext_vector_type(4)));
typedef float f32x2 __attribute__((ext_vector_type(2)));
typedef float f32x16 __attribute__((ext_vector_type(16)));
typedef unsigned u32x4 __attribute__((ext_vector_type(4)));
typedef unsigned u32x2 __attribute__((ext_vector_type(2)));
typedef __bf16 nbf2 __attribute__((ext_vector_type(2)));

constexpr int D = 1024, NB = 4, SEQ = 4096, CTXL = 256;
constexpr int NLAT = NB * SEQ;
constexpr int NCTX = NB * CTXL;
constexpr int MTOT = NLAT + NCTX;
constexpr int NQKVZ = 2560;
constexpr int NUZ = 2048;
constexpr int NCHUNK = 68;
constexpr float LOG2E = 1.4426950408889634f;

constexpr size_t MiB = 1u << 20;
constexpr size_t WS_MOD = 0;
constexpr size_t WS_BAR = 128 * 1024;
constexpr size_t WS_ROPE = 256 * 1024;
constexpr size_t WS_APOW = 512 * 1024;
constexpr size_t WS_BB = 1 * MiB;
constexpr size_t WS_CM = 1 * MiB + 512 * 1024;
constexpr size_t WS_WQKVZ = 2 * MiB;
constexpr size_t WS_WAO = 7 * MiB;
constexpr size_t WS_WSIN = 9 * MiB;
constexpr size_t WS_WGLU = 13 * MiB;
constexpr size_t WS_WSOUT = 17 * MiB;
constexpr size_t WS_CTX1 = 19 * MiB;
constexpr size_t WS_E = 23 * MiB;
constexpr size_t WS_H = 40 * MiB;
constexpr size_t WS_AO = 74 * MiB;
constexpr size_t WS_QKVZ = 108 * MiB;
constexpr size_t WS_STAT = 193 * MiB;
constexpr size_t WS_QE = 194 * MiB;
constexpr size_t WS_X1 = 195 * MiB;
constexpr size_t WS_END = 227 * MiB;
constexpr size_t WS_CNT = WS_BAR + 16384;
constexpr size_t WS_STATC = WS_STAT + 768 * 1024;
constexpr size_t WS_CNTC = WS_CNT + 2 * 68 * 256;
constexpr size_t BAR_ZERO_BYTES = 16384 + 2 * 68 * 256 + 16 * 256;

constexpr int S5_WAVE_LDS = 18944;
constexpr int LDS_TOP = 8 * S5_WAVE_LDS;
constexpr int LDS_BYTES = LDS_TOP + 6144;
#ifndef REP_MASK
#define REP_MASK 0
#endif
#ifndef SYNC_REP
#define SYNC_REP 1
#endif

__device__ __forceinline__ unsigned pk2(float lo, float hi) { f32x2 v = {lo, hi}; nbf2 r = __builtin_convertvector(v, nbf2); return __builtin_bit_cast(unsigned, r); }
__device__ __forceinline__ float bf_lo(unsigned w) { return __uint_as_float(w << 16); }
__device__ __forceinline__ float bf_hi(unsigned w) { return __uint_as_float(w & 0xffff0000u); }
__device__ __forceinline__ float fast_rcp(float x) { return __builtin_amdgcn_rcpf(x); }
__device__ __forceinline__ float fast_exp2(float x) { return __builtin_amdgcn_exp2f(x); }
__device__ __forceinline__ float silu_f(float z) { return z * fast_rcp(1.0f + fast_exp2(-z * LOG2E)); }
__device__ __forceinline__ float sigmoid_f(float z) { return fast_rcp(1.0f + fast_exp2(-z * LOG2E)); }
__device__ __forceinline__ float wave_sum(float v) {
#pragma unroll
    for (int o = 1; o < 64; o <<= 1) v += __shfl_xor(v, o);
    return v;
}
__device__ __forceinline__ float gelu_f(float v) {
    const float av = fabsf(v), d = av * 0.2316418882f + 1.0f;
    const float t = fast_rcp(d);
    float q = t * 0.5307027145f + (-0.7265760135f); q = q * t + 0.7107068705f; q = q * t + (-0.142248368f); q = q * t + 0.127414796f; q = q * t;
    const float e = fast_exp2((v * v) * (-0.72134752044f));
    const float m = v * (q * e), r = v - m;
    return v < 0.f ? m : r;
}
#define WAVE_LDS_FENCE() asm volatile("s_waitcnt lgkmcnt(0)" ::: "memory")
__device__ __forceinline__ f32x2 cmac(f32x2 x, f32x2 a_rr, f32x2 a_i, f32x2 c) { const f32x2 t = a_rr * x + c; const f32x2 xs = {x.y, x.x}; return a_i * xs + t; }

namespace pg8 {
constexpr int BM = 256, BK = 64, HALF = 128, HTB = HALF * BK * 2, NXCD = 8, WGM = 8;
__host__ __device__ __forceinline__ int lds_byte(int r, int c) { const int st = (r >> 4) * 2 + (c >> 5), rr = r & 15, cc = c & 31, ob = rr * 64 + cc * 2; return st * 1024 + (ob ^ (((ob >> 9) & 1) << 5)); }
__host__ __device__ __forceinline__ void stage_rc(int b, int& R, int& C) { const int st = b / 1024, sb = b % 1024, swz = sb ^ (((sb >> 9) & 1) << 5); R = (st >> 1) * 16 + swz / 64; C = (st & 1) * 32 + (swz % 64) / 2; }
__host__ __device__ __forceinline__ int perm32(int rho) { const int n = rho >> 4, i = rho & 15; return 8 * (i >> 2) + 4 * n + (i & 3); }
struct Unit { int pm, pn; };
struct Gemm { const bf16_t* A; const bf16_t* Bt; int M, N, K; };
struct StaticOrder {
    int nM, nN, nwg, G, c;
    __device__ void init(int M, int N, int G_, int c_) { nM = M / BM; nN = N / BM; nwg = nM * nN; G = G_; c = c_; }
    __device__ bool next(int i, Unit& u) const {
        const long L = (long)i * G + c; if (L >= nwg) return false;
        int wgid = (int)L; { const int q = nwg / NXCD, r = nwg % NXCD, xcd = wgid % NXCD, off = wgid / NXCD; wgid = (xcd < r ? xcd * (q + 1) : r * (q + 1) + (xcd - r) * q) + off; }
        const int nig = WGM * nN, gid = wgid / nig, fm = gid * WGM, gsz = (nM - fm) < WGM ? (nM - fm) : WGM;
        u.pm = fm + ((wgid % nig) % gsz); u.pn = (wgid % nig) / gsz; return true;
    }
};
template <class Epi, class Sched>
__device__ __forceinline__ void gemm_phase(LAS unsigned char* lds, const Gemm g, const Sched& S, const Epi& E) {
    const int tid = threadIdx.x, wid = __builtin_amdgcn_readfirstlane(tid >> 6), lane = tid & 63, wr = wid >> 2, wc = wid & 3, fr = lane & 15, fq = lane >> 4;
    const int K = g.K, nt = K / BK;
    unsigned voffA[2], voffB[2];
#pragma unroll
    for (int i = 0; i < 2; ++i) { int R, C; stage_rc(tid * 16 + i * 8192, R, C); const int Rb = Epi::PERM ? ((R & ~31) + perm32(R & 31)) : R;
        voffA[i] = (unsigned)(R * K + C) * 2u; voffB[i] = (unsigned)(Rb * K + C) * 2u; }
    const size_t kstep = (size_t)(BK * 2);
    const size_t hstep = (size_t)HALF * K * 2;
    const size_t tstep = 2 * hstep;
    const unsigned ldsw = (unsigned)wid * 1024u;
    const int aoff = lds_byte(wr * 64 + fr, fq * 8), boff = lds_byte(wc * 32 + fr, fq * 8);
#define PG8_SA(b, h) (((b) * 2 + (h)) * HTB)
#define PG8_SB(b, h) ((4 + (b) * 2 + (h)) * HTB)
#define PG8_STAGE(bufoff, gbase, voff) do { _Pragma("unroll") for (int _i = 0; _i < 2; ++_i) \
        __builtin_amdgcn_global_load_lds((const unsigned*)((const char*)(gbase) + (voff)[_i]), (LAS unsigned*)(lds + (bufoff) + ldsw + _i * 8192), 16, 0, 0); } while (0)
#define PG8_LDA(dst, b, h) do { _Pragma("unroll") for (int m = 0; m < 4; ++m) _Pragma("unroll") for (int k = 0; k < 2; ++k) dst[m][k] = *(const LAS bf16x8*)(lds + PG8_SA(b, h) + aoff + m * 2048 + k * 1024); } while (0)
#define PG8_LDB(dst, b, h) do { _Pragma("unroll") for (int n = 0; n < 2; ++n) _Pragma("unroll") for (int k = 0; k < 2; ++k) dst[n][k] = *(const LAS bf16x8*)(lds + PG8_SB(b, h) + boff + n * 2048 + k * 1024); } while (0)
#define PG8_MMA(ai, bj, At, Bt) do { __builtin_amdgcn_s_setprio(1); _Pragma("unroll") for (int m = 0; m < 4; ++m) _Pragma("unroll") for (int n = 0; n < 2; ++n) _Pragma("unroll") for (int k = 0; k < 2; ++k) \
        acc[ai][bj][m][n] = __builtin_amdgcn_mfma_f32_16x16x32_bf16(Bt[n][k], At[m][k], acc[ai][bj][m][n], 0, 0, 0); __builtin_amdgcn_s_setprio(0); } while (0)
#define PG8_WAIT_V(n) asm volatile("s_waitcnt vmcnt(" #n ")" ::: "memory")
#define PG8_WAIT_L(n) asm volatile("s_waitcnt lgkmcnt(" #n ")" ::: "memory")
#define PG8_BAR __builtin_amdgcn_s_barrier()
#define PG8_SCHED __builtin_amdgcn_sched_barrier(0)
    Unit cur, nxt; int ui = 0;
    if (!S.next(0, cur)) return;
    f32x4 acc[2][2][4][2];
#pragma unroll
    for (int a = 0; a < 2; ++a)
#pragma unroll
        for (int b = 0; b < 2; ++b)
#pragma unroll
            for (int m = 0; m < 4; ++m)
#pragma unroll
                for (int n = 0; n < 2; ++n) acc[a][b][m][n] = (f32x4){0.f, 0.f, 0.f, 0.f};
    bf16x8 At[4][2], B0[2][2], B1[2][2];
    const char* cA = (const char*)g.A + (size_t)cur.pm * tstep; const char* cB = (const char*)g.Bt + (size_t)cur.pn * tstep;
    PG8_STAGE(PG8_SB(0, 0), cB, voffB); PG8_STAGE(PG8_SB(0, 1), cB + hstep, voffB); PG8_STAGE(PG8_SA(0, 0), cA, voffA); PG8_STAGE(PG8_SA(0, 1), cA + hstep, voffA);
    if (wr == 1) PG8_BAR;
    PG8_WAIT_V(2); PG8_BAR;
    PG8_STAGE(PG8_SB(1, 0), cB + kstep, voffB); PG8_STAGE(PG8_SA(1, 0), cA + kstep, voffA); PG8_STAGE(PG8_SB(1, 1), cB + hstep + kstep, voffB);
    PG8_WAIT_V(6); PG8_BAR;
    for (;;) {
        const bool has_next = S.next(ui + 1, nxt);
        const char* nA = has_next ? (const char*)g.A + (size_t)nxt.pm * tstep : cA; const char* nB = has_next ? (const char*)g.Bt + (size_t)nxt.pn * tstep : cB;
        for (int t = 0; t < nt; t += 2) {
            const bool last = (t == nt - 2);
            const char* a1 = cA + (size_t)(t + 1) * kstep;
            const char* a2 = last ? nA : cA + (size_t)(t + 2) * kstep; const char* b2 = last ? nB : cB + (size_t)(t + 2) * kstep;
            const char* a3 = a2 + kstep; const char* b3 = b2 + kstep;
            PG8_LDB(B0, 0, 0); PG8_LDB(B1, 0, 1); PG8_SCHED; PG8_LDA(At, 0, 0); PG8_STAGE(PG8_SA(1, 1), a1 + hstep, voffA);
            PG8_WAIT_V(8); PG8_WAIT_L(0); PG8_BAR; PG8_MMA(0, 0, At, B0); PG8_MMA(0, 1, At, B1); PG8_BAR; PG8_SCHED;
            PG8_LDA(At, 0, 1); PG8_STAGE(PG8_SB(0, 0), b2, voffB); PG8_STAGE(PG8_SB(0, 1), b2 + hstep, voffB); PG8_STAGE(PG8_SA(0, 0), a2, voffA);
            PG8_WAIT_V(8); PG8_WAIT_L(0); PG8_BAR; PG8_MMA(1, 0, At, B0); PG8_MMA(1, 1, At, B1); PG8_BAR; PG8_SCHED;
            PG8_LDB(B0, 1, 0); PG8_LDB(B1, 1, 1); PG8_SCHED; PG8_LDA(At, 1, 0); PG8_STAGE(PG8_SA(0, 1), a2 + hstep, voffA);
            PG8_WAIT_V(8); PG8_WAIT_L(0); PG8_BAR; PG8_MMA(0, 0, At, B0); PG8_MMA(0, 1, At, B1); PG8_BAR; PG8_SCHED;
            PG8_LDA(At, 1, 1); PG8_STAGE(PG8_SB(1, 0), b3, voffB); PG8_STAGE(PG8_SB(1, 1), b3 + hstep, voffB); PG8_STAGE(PG8_SA(1, 0), a3, voffA);
            PG8_WAIT_V(8); PG8_WAIT_L(0); PG8_BAR; PG8_MMA(1, 0, At, B0); PG8_MMA(1, 1, At, B1); PG8_BAR; PG8_SCHED;
        }
        if (wr == 0) PG8_BAR;
        E(acc, cur, wr, wc, fr, fq, lds);
        if (!has_next) break;
#pragma unroll
        for (int a = 0; a < 2; ++a)
#pragma unroll
            for (int b = 0; b < 2; ++b)
#pragma unroll
                for (int m = 0; m < 4; ++m)
#pragma unroll
                    for (int n = 0; n < 2; ++n) acc[a][b][m][n] = (f32x4){0.f, 0.f, 0.f, 0.f};
        cur = nxt; cA = nA; cB = nB; ++ui;
        if (wr == 1) PG8_BAR;
    }
    PG8_WAIT_V(0);
    PG8_BAR;
#undef PG8_SA
#undef PG8_SB
#undef PG8_STAGE
#undef PG8_LDA
#undef PG8_LDB
#undef PG8_MMA
#undef PG8_WAIT_V
#undef PG8_WAIT_L
#undef PG8_BAR
#undef PG8_SCHED
}
}

struct EpiQKVZ {
    static constexpr bool PERM = true;
    bf16_t* O; const float* rope;
    __device__ __forceinline__ void operator()(f32x4 (&acc)[2][2][4][2], const pg8::Unit& u, int wr, int wc, int fr, int fq, LAS unsigned char* lds) const {
        const float qs = 0.125f * LOG2E;
#pragma unroll
        for (int ai = 0; ai < 2; ++ai)
#pragma unroll
            for (int m = 0; m < 4; ++m) {
                const int r = u.pm * 256 + ai * 128 + wr * 64 + m * 16 + fr;
                const bool lat = r < NLAT;
                const int t = r & (SEQ - 1);
                const int val = (wc & 1) ? (t & 63) : (t >> 6);
                const f32x4 cs = *(const f32x4*)(rope + val * 32 + 4 * fq), sn = *(const f32x4*)(rope + val * 32 + 16 + 4 * fq);
                bf16_t* rowp = O + (size_t)r * NQKVZ;
#pragma unroll
                for (int bj = 0; bj < 2; ++bj) {
                    const int cb = u.pn * 256 + bj * 128 + wc * 32;
                    f32x4 t1 = acc[ai][bj][m][0], t2 = acc[ai][bj][m][1];
                    if (cb < 1280 && lat) { const f32x4 o1 = t1 * cs - t2 * sn, o2 = t2 * cs + t1 * sn; t1 = o1; t2 = o2; }
                    if (cb < 1024) { t1 = t1 * qs; t2 = t2 * qs; }
                    u32x4 w; w.x = pk2(t1[0], t1[1]); w.y = pk2(t1[2], t1[3]); w.z = pk2(t2[0], t2[1]); w.w = pk2(t2[2], t2[3]);
                    *(u32x4*)(rowp + cb + 8 * fq) = w;
                }
            }
    }
};
struct EpiResid {
    static constexpr bool PERM = true;
    const float* base_lat; float* out_lat; const float* base_ctx; float* out_ctx; const float* mod;
    __device__ __forceinline__ void operator()(f32x4 (&acc)[2][2][4][2], const pg8::Unit& u, int wr, int wc, int fr, int fq, LAS unsigned char* lds) const {
#pragma unroll
        for (int ai = 0; ai < 2; ++ai) {
            const int r0 = u.pm * 256 + ai * 128;
            const bool lat = r0 < NLAT;
            const int v = lat ? (r0 >> 12) : 4;
            const float* gp = mod + v * 3072 + 2048;
            const float* bp = lat ? base_lat : base_ctx - (size_t)NLAT * D;
            float* op = lat ? out_lat : out_ctx - (size_t)NLAT * D;
#pragma unroll
            for (int bj = 0; bj < 2; ++bj) {
                const int c0 = u.pn * 256 + bj * 128 + wc * 32 + 8 * fq;
                const f32x4 g0 = *(const f32x4*)(gp + c0), g1 = *(const f32x4*)(gp + c0 + 4);
#pragma unroll
                for (int m = 0; m < 4; ++m) {
                    const size_t off = (size_t)(r0 + wr * 64 + m * 16 + fr) * D + c0;
                    const f32x4 x0 = *(const f32x4*)(bp + off), x1 = *(const f32x4*)(bp + off + 4);
                    *(f32x4*)(op + off) = x0 + g0 * acc[ai][bj][m][0];
                    *(f32x4*)(op + off + 4) = x1 + g1 * acc[ai][bj][m][1];
                }
            }
        }
    }
};
struct EpiBf16 {
    static constexpr bool PERM = true;
    bf16_t* O; int ldc;
    __device__ __forceinline__ void operator()(f32x4 (&acc)[2][2][4][2], const pg8::Unit& u, int wr, int wc, int fr, int fq, LAS unsigned char* lds) const {
#pragma unroll
        for (int ai = 0; ai < 2; ++ai)
#pragma unroll
            for (int m = 0; m < 4; ++m) {
                bf16_t* rowp = O + (size_t)(u.pm * 256 + ai * 128 + wr * 64 + m * 16 + fr) * ldc + u.pn * 256 + wc * 32 + 8 * fq;
#pragma unroll
                for (int bj = 0; bj < 2; ++bj) {
                    const f32x4 v0 = acc[ai][bj][m][0], v1 = acc[ai][bj][m][1];
                    u32x4 w; w.x = pk2(v0[0], v0[1]); w.y = pk2(v0[2], v0[3]); w.z = pk2(v1[0], v1[1]); w.w = pk2(v1[2], v1[3]);
                    *(u32x4*)(rowp + bj * 128) = w;
                }
            }
    }
};
struct EpiGlu {
    static constexpr bool PERM = true;
    bf16_t* O; const bf16_t* UZ;
    __device__ __forceinline__ void operator()(f32x4 (&acc)[2][2][4][2], const pg8::Unit& u, int wr, int wc, int fr, int fq, LAS unsigned char* lds) const {
#pragma unroll
        for (int ai = 0; ai < 2; ++ai)
#pragma unroll
            for (int m = 0; m < 4; ++m) {
                const int r = u.pm * 256 + ai * 128 + wr * 64 + m * 16 + fr;
                const int oc = u.pn * 128 + wc * 32 + 8 * fq;
                const u32x4 zw = *(const u32x4*)(UZ + (size_t)r * NUZ + 1024 + oc);
                const f32x4 a0 = acc[ai][0][m][0], a1 = acc[ai][0][m][1], g0 = acc[ai][1][m][0], g1 = acc[ai][1][m][1];
                float o[8];
                o[0] = a0[0] * sigmoid_f(g0[0]) * silu_f(bf_lo(zw.x)); o[1] = a0[1] * sigmoid_f(g0[1]) * silu_f(bf_hi(zw.x));
                o[2] = a0[2] * sigmoid_f(g0[2]) * silu_f(bf_lo(zw.y)); o[3] = a0[3] * sigmoid_f(g0[3]) * silu_f(bf_hi(zw.y));
                o[4] = a1[0] * sigmoid_f(g1[0]) * silu_f(bf_lo(zw.z)); o[5] = a1[1] * sigmoid_f(g1[1]) * silu_f(bf_hi(zw.z));
                o[6] = a1[2] * sigmoid_f(g1[2]) * silu_f(bf_lo(zw.w)); o[7] = a1[3] * sigmoid_f(g1[3]) * silu_f(bf_hi(zw.w));
                u32x4 w; w.x = pk2(o[0], o[1]); w.y = pk2(o[2], o[3]); w.z = pk2(o[4], o[5]); w.w = pk2(o[6], o[7]);
                *(u32x4*)(O + (size_t)r * D + oc) = w;
            }
    }
};


#define XB_TMO      128
#define XB_XCNT(j)  (256  + 64 * (j))
#define XB_XSUB(j)  (1280 + 64 * (j))
#define XB_XGEN(j)  (2304 + 64 * (j))
#define XB_TOP      3328
#define XB_TOPGEN   3392
#define XCD_BAR_WORDS 3456
#define XB_SPIN_CAP (1u << 18)
__device__ __forceinline__ unsigned xb_ld(unsigned* p)              { return __hip_atomic_load(p, __ATOMIC_RELAXED, __HIP_MEMORY_SCOPE_AGENT); }
__device__ __forceinline__ unsigned xb_add(unsigned* p, unsigned v) { return __hip_atomic_fetch_add(p, v, __ATOMIC_RELAXED, __HIP_MEMORY_SCOPE_AGENT); }
__device__ __forceinline__ unsigned xb_xcc_id() { return (unsigned)__builtin_amdgcn_s_getreg((3 << 11) | 20) & 0xFu; }
#define XB_SPIN(cond, bar) do { unsigned _sp = 0; while (cond) { __builtin_amdgcn_s_sleep(1); \
    if ((++_sp & 255u) == 0u) { if (xb_ld(&(bar)[XB_TMO])) break; if (_sp > XB_SPIN_CAP) { atomicAdd(&(bar)[XB_TMO], 1u); break; } } } } while (0)
struct XcdBarrier { unsigned* bar; unsigned x; volatile LAS unsigned* st; };
__device__ __forceinline__ XcdBarrier xcd_barrier_post(unsigned* bar, volatile LAS unsigned* st) {
    XcdBarrier b; b.bar = bar; b.x = xb_xcc_id(); b.st = st;
    if (threadIdx.x == 0) (void)xb_add(&bar[XB_XCNT(b.x)], 1u);
    return b;
}
__device__ __forceinline__ void xcd_barrier_complete(unsigned* bar, unsigned x, unsigned& nloc, unsigned& nx) {
    const unsigned G = gridDim.x * gridDim.y * gridDim.z;
    unsigned sum, cnt, mine, sp = 0u;
    for (;;) {
        sum = 0u; cnt = 0u; mine = 0u;
#pragma unroll
        for (unsigned j = 0; j < 16; ++j) { const unsigned c = xb_ld(&bar[XB_XCNT(j)]); sum += c; cnt += (c > 0u) ? 1u : 0u; mine = (j == x) ? c : mine; }
        if (sum == G) break;
        __builtin_amdgcn_s_sleep(1);
        if ((++sp & 255u) == 0u) { if (xb_ld(&bar[XB_TMO])) break; if (sp > XB_SPIN_CAP) { atomicAdd(&bar[XB_TMO], 1u); break; } }
    }
    nloc = mine > 0u ? mine : 1u; nx = cnt > 0u ? cnt : 1u;
}
__device__ __forceinline__ void xcd_barrier(const XcdBarrier& b) {
    asm volatile("s_waitcnt vmcnt(0)" ::: "memory");
    __syncthreads();
    if (threadIdx.x == 0) {
        unsigned* bar = b.bar;
        __builtin_amdgcn_s_waitcnt(0);
        unsigned nloc = b.st[0], nx = b.st[1];
        if (nloc == 0u) { xcd_barrier_complete(bar, b.x, nloc, nx); b.st[0] = nloc; b.st[1] = nx; }
        const unsigned old = xb_add(&bar[XB_XSUB(b.x)], 1u);
        const unsigned gen = old / nloc;
        if (old + 1u == (gen + 1u) * nloc) {
            __builtin_amdgcn_fence(__ATOMIC_RELEASE, "agent");
            asm volatile("s_waitcnt vmcnt(0)" ::: "memory");
            const unsigned og = xb_add(&bar[XB_TOP], 1u);
            const unsigned tg = og / nx;
            if (og + 1u == (tg + 1u) * nx) xb_add(&bar[XB_TOPGEN], 1u);
            else XB_SPIN(xb_ld(&bar[XB_TOPGEN]) == tg, bar);
            __builtin_amdgcn_fence(__ATOMIC_ACQUIRE, "agent");
            xb_add(&bar[XB_XGEN(b.x)], 1u);
            asm volatile("s_waitcnt vmcnt(0)" ::: "memory");
        } else {
            XB_SPIN(xb_ld(&bar[XB_XGEN(b.x)]) == gen, bar);
            __builtin_amdgcn_fence(__ATOMIC_ACQUIRE, "agent");
            asm volatile("s_waitcnt vmcnt(0)" ::: "memory");
        }
    }
    __syncthreads();
}


struct PanelOrder {
    int ntiles, G, c;
    __device__ void init(int M, int G_, int c_) { ntiles = (M / 256) * 4; G = G_; c = c_; }
    __device__ bool next(int i, pg8::Unit& u) const {
        const int L = i * G + c; if (L >= ntiles) return false;
        if (L < 256) { const int xcd = L & 7, j = L >> 3; u.pm = xcd * 8 + (j >> 2); u.pn = j & 3; }
        else { const int Lc = L - 256; u.pm = 64 + (Lc >> 2); u.pn = Lc & 3; }
        return true;
    }
};
template <bool FINAL>
struct EpiResidNorm {
    static constexpr bool PERM = true;
    const float* xin; bf16_t* X1; float* out;
    const float* mod;
    const float* nw;
    const float* mod_next;
    bf16_t* H;
    float* stat; unsigned* cnt;
    __device__ __forceinline__ void operator()(f32x4 (&acc)[2][2][4][2], const pg8::Unit& u, int wr, int wc, int fr, int fq, LAS unsigned char* lds) const {
        LAS float* P = (LAS float*)(lds + LDS_TOP + 64);
        LAS float* S = P + 1024;
        const int tid = threadIdx.x;
        asm volatile("s_waitcnt vmcnt(0)" ::: "memory"); __syncthreads();
        LAS unsigned char* park = lds + tid * 16;
        float q[2][4];
#pragma unroll
        for (int ai = 0; ai < 2; ++ai) {
            const int r0 = u.pm * 256 + ai * 128;
            const float* gp = mod + (r0 >> 12) * 3072 + 2048;
#pragma unroll
            for (int m = 0; m < 4; ++m) q[ai][m] = 0.f;
#pragma unroll
            for (int bj = 0; bj < 2; ++bj) {
                const int c0 = u.pn * 256 + bj * 128 + wc * 32 + 8 * fq;
                const f32x4 g0 = *(const f32x4*)(gp + c0), g1 = *(const f32x4*)(gp + c0 + 4);
#pragma unroll
                for (int m = 0; m < 4; ++m) {
                    const size_t off = (size_t)(r0 + wr * 64 + m * 16 + fr) * D + c0;
                    f32x4 b0, b1;
                    if (FINAL) { const u32x4 w = *(const u32x4*)(X1 + off); b0 = (f32x4){bf_lo(w.x), bf_hi(w.x), bf_lo(w.y), bf_hi(w.y)}; b1 = (f32x4){bf_lo(w.z), bf_hi(w.z), bf_lo(w.w), bf_hi(w.w)}; }
                    else { b0 = *(const f32x4*)(xin + off); b1 = *(const f32x4*)(xin + off + 4); }
                    const f32x4 x0 = b0 + g0 * acc[ai][bj][m][0], x1 = b1 + g1 * acc[ai][bj][m][1];
                    u32x4 w; w.x = pk2(x0[0], x0[1]); w.y = pk2(x0[2], x0[3]); w.z = pk2(x1[0], x1[1]); w.w = pk2(x1[2], x1[3]);
                    *(LAS u32x4*)(park + ((ai * 2 + bj) * 4 + m) * 8192) = w;
                    if (!FINAL) *(u32x4*)(X1 + off) = w;
                    q[ai][m] += ((x0[0] * x0[0] + x0[1] * x0[1]) + (x0[2] * x0[2] + x0[3] * x0[3])) + ((x1[0] * x1[0] + x1[1] * x1[1]) + (x1[2] * x1[2] + x1[3] * x1[3]));
                }
            }
        }
#pragma unroll
        for (int ai = 0; ai < 2; ++ai)
#pragma unroll
            for (int m = 0; m < 4; ++m) {
                float t = q[ai][m]; t += __shfl_xor(t, 16); t += __shfl_xor(t, 32);
                if (fq == 0) P[(ai * 128 + wr * 64 + m * 16 + fr) * 4 + wc] = t;
            }
        __syncthreads();
        float* st = stat + (size_t)u.pm * 1024;
        if (tid < 256) { const f32x4 p = *(const LAS f32x4*)(P + tid * 4);
            __hip_atomic_store(st + u.pn * 256 + tid, (p[0] + p[1]) + (p[2] + p[3]), __ATOMIC_RELAXED, __HIP_MEMORY_SCOPE_AGENT); }
        asm volatile("s_waitcnt vmcnt(0)" ::: "memory");
        __syncthreads();
        if (tid == 0) {
            __hip_atomic_fetch_add(cnt + 64 * u.pm, 1u, __ATOMIC_RELAXED, __HIP_MEMORY_SCOPE_AGENT);
            unsigned sp = 0;
            while (__hip_atomic_load(cnt + 64 * u.pm, __ATOMIC_RELAXED, __HIP_MEMORY_SCOPE_AGENT) < 4u) { __builtin_amdgcn_s_sleep(1); if (++sp > (1u << 20)) break; }
        }
        __syncthreads();
        if (tid < 256) {
            float t = 0.f;
#pragma unroll
            for (int k = 0; k < 4; ++k) t += __hip_atomic_load(st + k * 256 + tid, __ATOMIC_RELAXED, __HIP_MEMORY_SCOPE_AGENT);
            S[tid] = 1.0f / sqrtf(t * (1.0f / D) + 1e-6f);
        }
        __syncthreads();
#pragma unroll
        for (int ai = 0; ai < 2; ++ai) {
            const int r0 = u.pm * 256 + ai * 128;
            const float* mp = FINAL ? nullptr : mod_next + (r0 >> 12) * 3072;
#pragma unroll
            for (int bj = 0; bj < 2; ++bj) {
                const int c0 = u.pn * 256 + bj * 128 + wc * 32 + 8 * fq;
                f32x4 w0 = *(const f32x4*)(nw + c0), w1 = *(const f32x4*)(nw + c0 + 4), s0, s1;
                if (!FINAL) { w0 = w0 * (*(const f32x4*)(mp + 1024 + c0) + 1.0f); w1 = w1 * (*(const f32x4*)(mp + 1024 + c0 + 4) + 1.0f); s0 = *(const f32x4*)(mp + c0); s1 = *(const f32x4*)(mp + c0 + 4); }
#pragma unroll
                for (int m = 0; m < 4; ++m) {
                    const int rl = ai * 128 + wr * 64 + m * 16 + fr;
                    const float rstd = S[rl];
                    const size_t off = (size_t)(u.pm * 256 + rl) * D + c0;
                    const u32x4 xw = *(const LAS u32x4*)(park + ((ai * 2 + bj) * 4 + m) * 8192);
                    const f32x4 x0 = {bf_lo(xw.x), bf_hi(xw.x), bf_lo(xw.y), bf_hi(xw.y)}, x1 = {bf_lo(xw.z), bf_hi(xw.z), bf_lo(xw.w), bf_hi(xw.w)};
                    if (FINAL) { *(f32x4*)(out + off) = x0 * rstd * w0; *(f32x4*)(out + off + 4) = x1 * rstd * w1; }
                    else { const f32x4 y0 = x0 * rstd * w0 + s0, y1 = x1 * rstd * w1 + s1;
                        u32x4 w; w.x = pk2(y0[0], y0[1]); w.y = pk2(y0[2], y0[3]); w.z = pk2(y1[0], y1[1]); w.w = pk2(y1[2], y1[3]);
                        *(u32x4*)(H + off) = w; }
                }
            }
        }
        __syncthreads();
    }
};

template <class Epi>
__device__ __forceinline__ void gemm64_tile(LAS unsigned char* lds, const bf16_t* A, const bf16_t* Bt, const Epi& E) {
    constexpr int K = 1024, BK = 128, PITCH = BK * 2 + 16, NKT = K / BK;
    const int tid = threadIdx.x, lane = tid & 63, wave = __builtin_amdgcn_readfirstlane(tid >> 6), fr = lane & 15, fq = lane >> 4, wr = wave >> 1, wc = wave & 1;
    LAS unsigned char* As = lds; LAS unsigned char* Bs = lds + 64 * PITCH;
    const int srow = tid >> 4, sch = tid & 15;
    const bf16_t* ga = A + (size_t)srow * K + sch * 8; const bf16_t* gb = Bt + (size_t)srow * K + sch * 8;
    u32x4 ra[2], rb[2];
#pragma unroll
    for (int i = 0; i < 2; ++i) { ra[i] = *(const u32x4*)(ga + (size_t)(32 * i) * K); rb[i] = *(const u32x4*)(gb + (size_t)(32 * i) * K); }
    f32x4 acc[2] = {(f32x4){0.f, 0.f, 0.f, 0.f}, (f32x4){0.f, 0.f, 0.f, 0.f}};
    for (int kt = 0; kt < NKT; ++kt) {
        __syncthreads();
#pragma unroll
        for (int i = 0; i < 2; ++i) { *(LAS u32x4*)(As + (srow + 32 * i) * PITCH + sch * 16) = ra[i]; *(LAS u32x4*)(Bs + (srow + 32 * i) * PITCH + sch * 16) = rb[i]; }
        __syncthreads();
        if (kt + 1 < NKT) {
#pragma unroll
            for (int i = 0; i < 2; ++i) { ra[i] = *(const u32x4*)(ga + (size_t)(32 * i) * K + (kt + 1) * BK); rb[i] = *(const u32x4*)(gb + (size_t)(32 * i) * K + (kt + 1) * BK); }
        }
#pragma unroll
        for (int ks = 0; ks < 4; ++ks) {
            const bf16x8 Af = *(const LAS bf16x8*)(As + (16 * wr + fr) * PITCH + (32 * ks + 8 * fq) * 2);
#pragma unroll
            for (int n = 0; n < 2; ++n) {
                const bf16x8 Bf = *(const LAS bf16x8*)(Bs + (32 * wc + 16 * n + fr) * PITCH + (32 * ks + 8 * fq) * 2);
                acc[n] = __builtin_amdgcn_mfma_f32_16x16x32_bf16(Bf, Af, acc[n], 0, 0, 0);
            }
        }
    }
    __syncthreads();
    E(acc, wr, wc, fr, fq, lds);
}
struct Epi64Bf16 {
    bf16_t* O; int ldc;
    __device__ __forceinline__ void operator()(f32x4 (&acc)[2], int wr, int wc, int fr, int fq, LAS unsigned char* lds) const {
#pragma unroll
        for (int n = 0; n < 2; ++n) { u32x2 w; w.x = pk2(acc[n][0], acc[n][1]); w.y = pk2(acc[n][2], acc[n][3]);
            *(u32x2*)(O + (size_t)(16 * wr + fr) * ldc + 32 * wc + 16 * n + 4 * fq) = w; }
    }
};
struct Epi64ResidNorm {
    const float* base; const float* modc; const float* nw; const float* modc_next; bf16_t* H;
    int col0; float* stat; unsigned* cnt;
    int cb;
    __device__ __forceinline__ void operator()(f32x4 (&acc)[2], int wr, int wc, int fr, int fq, LAS unsigned char* lds) const {
        LAS float* P = (LAS float*)(lds + LDS_TOP + 64);
        LAS float* S = P + 128;
        const int tid = threadIdx.x, row = 16 * wr + fr;
        f32x4 x[2]; float q = 0.f;
#pragma unroll
        for (int n = 0; n < 2; ++n) { const int c = col0 + 32 * wc + 16 * n + 4 * fq;
            x[n] = *(const f32x4*)(base + (size_t)row * D + c) + *(const f32x4*)(modc + 2048 + c) * acc[n];
            q += (x[n][0] * x[n][0] + x[n][1] * x[n][1]) + (x[n][2] * x[n][2] + x[n][3] * x[n][3]); }
        q += __shfl_xor(q, 16); q += __shfl_xor(q, 32);
        if (fq == 0) P[row * 2 + wc] = q;
        __syncthreads();
        if (tid < 64) __hip_atomic_store(stat + cb * 64 + tid, P[tid * 2] + P[tid * 2 + 1], __ATOMIC_RELAXED, __HIP_MEMORY_SCOPE_AGENT);
        asm volatile("s_waitcnt vmcnt(0)" ::: "memory");
        __syncthreads();
        if (tid == 0) {
            __hip_atomic_fetch_add(cnt, 1u, __ATOMIC_RELAXED, __HIP_MEMORY_SCOPE_AGENT);
            unsigned sp = 0;
            while (__hip_atomic_load(cnt, __ATOMIC_RELAXED, __HIP_MEMORY_SCOPE_AGENT) < 16u) { __builtin_amdgcn_s_sleep(1); if (++sp > (1u << 20)) break; }
        }
        __syncthreads();
        if (tid < 64) { float t = 0.f;
#pragma unroll
            for (int k = 0; k < 16; ++k) t += __hip_atomic_load(stat + k * 64 + tid, __ATOMIC_RELAXED, __HIP_MEMORY_SCOPE_AGENT);
            S[tid] = 1.0f / sqrtf(t * (1.0f / D) + 1e-6f); }
        __syncthreads();
        const float rstd = S[row];
#pragma unroll
        for (int n = 0; n < 2; ++n) { const int c = col0 + 32 * wc + 16 * n + 4 * fq;
            const f32x4 y = x[n] * rstd * *(const f32x4*)(nw + c) * (*(const f32x4*)(modc_next + 1024 + c) + 1.0f) + *(const f32x4*)(modc_next + c);
            u32x2 w; w.x = pk2(y[0], y[1]); w.y = pk2(y[2], y[3]);
            *(u32x2*)(H + (size_t)row * D + c) = w; }
        __syncthreads();
    }
};

struct Args {
    const float* in[22];
    float* out;
    unsigned char* ws;
    int ph_lo, ph_hi, pad, pad2;
};

__device__ __forceinline__ void transpose_item(const float* W, int K, int N, bf16_t* WT, int k0, int n0, int dst_row0, LAS float* scr, int lane, bool perm = false) {
    float wv[32];
#pragma unroll
    for (int i = 0; i < 32; ++i) wv[i] = W[(size_t)(k0 + 2 * i + (lane >> 5)) * N + n0 + (lane & 31)];
#pragma unroll
    for (int i = 0; i < 32; ++i) scr[(2 * i + (lane >> 5)) * 33 + (lane & 31)] = wv[i];
    WAVE_LDS_FENCE();
    const int c = lane & 7;
#pragma unroll
    for (int j = 0; j < 4; ++j) { const int n = (lane >> 3) + 8 * j; const LAS float* s = scr + (8 * c) * 33 + n;
        u32x4 o; o.x = pk2(s[0 * 33], s[1 * 33]); o.y = pk2(s[2 * 33], s[3 * 33]); o.z = pk2(s[4 * 33], s[5 * 33]); o.w = pk2(s[6 * 33], s[7 * 33]);
        const int nd = perm ? 8 * ((n & 15) >> 2) + 4 * (n >> 4) + (n & 3) : n;
        *(u32x4*)(WT + (size_t)(dst_row0 + nd) * K + k0 + 8 * c) = o; }
    WAVE_LDS_FENCE();
}

__device__ __forceinline__ void p0_prologue(const Args& a, LAS unsigned char* lds) {
    const int tid = threadIdx.x, lane = tid & 63, wave = tid >> 6, bid = blockIdx.x, G = gridDim.x;
    unsigned char* ws = a.ws;
    if (bid < 192) {
        LAS float* sv = (LAS float*)lds;
        LAS float* red = (LAS float*)(lds + 20480);
        const int layer = bid / 96, n0 = (bid % 96) * 32;
        const int c4 = lane & 7, kk = lane >> 3;
        const float* wp = a.in[5] + (size_t)layer * D * 3072 + (size_t)(wave * 128 + kk) * 3072 + n0 + 4 * c4;
        f32x4 w[16];
#pragma unroll
        for (int i = 0; i < 16; ++i) w[i] = *(const f32x4*)(wp + (size_t)(8 * i) * 3072);
        float cx[10];
#pragma unroll
        for (int j = 0; j < 10; ++j) { const int idx = tid + 512 * j, v = idx >> 10, k = idx & 1023; cx[j] = v < 4 ? a.in[1][v * D + k] : a.in[3][k]; }
#pragma unroll
        for (int j = 0; j < 10; ++j) sv[tid + 512 * j] = cx[j] / (1.0f + expf(-cx[j]));
        __syncthreads();
        f32x4 acc[5];
#pragma unroll
        for (int v = 0; v < 5; ++v) acc[v] = (f32x4){0.f, 0.f, 0.f, 0.f};
#pragma unroll
        for (int i = 0; i < 16; ++i) {
#pragma unroll
            for (int v = 0; v < 5; ++v) acc[v] += w[i] * sv[v * D + wave * 128 + 8 * i + kk];
        }
#pragma unroll
        for (int v = 0; v < 5; ++v)
#pragma unroll
            for (int j = 0; j < 4; ++j) { float t = acc[v][j]; t += __shfl_xor(t, 8); t += __shfl_xor(t, 16); t += __shfl_xor(t, 32); acc[v][j] = t; }
        if (kk == 0) {
#pragma unroll
            for (int v = 0; v < 5; ++v) *(LAS f32x4*)(red + (wave * 5 + v) * 32 + 4 * c4) = acc[v];
        }
        __syncthreads();
        if (tid < 160) { const int v = tid >> 5, c = tid & 31; float t = 0.f;
#pragma unroll
            for (int q = 0; q < 8; ++q) t += red[(q * 5 + v) * 32 + c];
            ((float*)(ws + WS_MOD))[(layer * 5 + v) * 3072 + n0 + c] = t + a.in[6][layer * 3072 + n0 + c]; }
        __syncthreads();
    }
    if (bid >= 192 && bid < 208) {
        const int id = (bid - 192) * 512 + tid;
        const int dg = id >> 6, p = id & 63;
        const float lre = a.in[11][id], lim = a.in[12][id], dt = expf(a.in[13][dg]);
        const float mag = expf(lre * dt), ar = mag * cosf(lim * dt), ai = mag * sinf(lim * dt);
        float pr = ar, pi = ai;
#pragma unroll
        for (int s = 0; s < 6; ++s) { const float nr = pr * pr - pi * pi, ni = 2.f * pr * pi; pr = nr; pi = ni; }
        ((f32x4*)(ws + WS_APOW))[id] = (f32x4){ar, ai, pr, pi};
        const float den = lre * lre + lim * lim, nr_ = ar - 1.0f, ni_ = ai;
        const float cr = (nr_ * lre + ni_ * lim) / den, ci = (ni_ * lre - nr_ * lim) / den;
        bf16_t* Bb = (bf16_t*)(ws + WS_BB) + (size_t)dg * 128 * 16;
        bf16_t* Cm = (bf16_t*)(ws + WS_CM) + (size_t)dg * 16 * 128;
        const float* bre = a.in[14] + (size_t)id * 16; const float* bim = a.in[15] + (size_t)id * 16;
#pragma unroll
        for (int h = 0; h < 16; h += 2) {
            const float r0 = cr * bre[h] - ci * bim[h], i0 = cr * bim[h] + ci * bre[h], r1 = cr * bre[h + 1] - ci * bim[h + 1], i1 = cr * bim[h + 1] + ci * bre[h + 1];
            *(unsigned*)(Bb + (2 * p) * 16 + h) = pk2(r0, r1); *(unsigned*)(Bb + (2 * p + 1) * 16 + h) = pk2(i0, i1);
        }
        const float* cre = a.in[16] + (size_t)dg * 16 * 64; const float* cim = a.in[17] + (size_t)dg * 16 * 64;
#pragma unroll
        for (int h = 0; h < 16; ++h) *(unsigned*)(Cm + h * 128 + 2 * p) = pk2(cre[h * 64 + p], -cim[h * 64 + p]);
    }
    if (bid >= 208 && bid < 210) {
        const int id = (bid - 208) * 512 + tid;
        const int val = id >> 4, f = id & 15;
        const float inv = powf(10000.0f, -(float)f / 16.0f), ang = (float)val * inv;
        float* rp = (float*)(ws + WS_ROPE);
        rp[val * 32 + f] = cosf(ang); rp[val * 32 + 16 + f] = sinf(ang);
    }
    LAS float* scr = (LAS float*)(lds + wave * 16384);
    const int gw = bid * 8 + wave, NGW = G * 8;
    constexpr int I0 = 16 * 80, I1 = 16 * 32;
    for (int it = gw; it < I0 + I1; it += NGW) {
        int r = it;
        if (r < I0) { const int nb = r % 80, kb = r / 80; transpose_item(a.in[7], D, NQKVZ, (bf16_t*)(ws + WS_WQKVZ), kb * 64, nb * 32, nb * 32, scr, lane, nb * 32 < 1280); continue; } r -= I0;
        { const int nb = r % 32, kb = r / 32; transpose_item(a.in[9], D, D, (bf16_t*)(ws + WS_WAO), kb * 64, nb * 32, nb * 32, scr, lane); }
    }
}
__device__ __forceinline__ void p2_late_transposes(const Args& a, LAS unsigned char* lds, int w0) {
    const int tid = threadIdx.x, lane = tid & 63, wave = tid >> 6, bid = blockIdx.x, G = gridDim.x;
    unsigned char* ws = a.ws;
    LAS float* scr = (LAS float*)(lds + wave * 16384);
    const bool all = (w0 <= 0 || w0 >= G);
    if (!all && bid < w0) return;
    const int gw = ((all ? bid : bid - w0) * 8 + wave), NGW = (all ? G : G - w0) * 8;
    constexpr int I2 = 16 * 64, I3 = 16 * 64, I4 = 16 * 32;
    for (int it = gw; it < I2 + I3 + I4; it += NGW) {
        int r = it;
        if (r < I2) { const int nb = r % 64, kb = r / 64; transpose_item(a.in[10], D, NUZ, (bf16_t*)(ws + WS_WSIN), kb * 64, nb * 32, nb * 32, scr, lane); continue; } r -= I2;
        if (r < I3) { const int nb = r % 64, kb = r / 64, n0 = nb * 32; const int dst = 256 * ((n0 & 1023) >> 7) + 128 * (n0 >> 10) + (n0 & 127);
                      transpose_item(a.in[19], D, NUZ, (bf16_t*)(ws + WS_WGLU), kb * 64, n0, dst, scr, lane); continue; } r -= I3;
        { const int nb = r % 32, kb = r / 32; transpose_item(a.in[20], D, D, (bf16_t*)(ws + WS_WSOUT), kb * 64, nb * 32, nb * 32, scr, lane); }
    }
}

__device__ __forceinline__ const float* norm_src(const float* xlat, const float* xctx, int r) { return r < NLAT ? xlat + (size_t)r * D : xctx + (size_t)(r - NLAT) * D; }
__device__ __forceinline__ void norm_mod_phase(const float* xlat, const float* xctx, const float* nw, const float* mod, bf16_t* H) {
    const int lane = threadIdx.x & 63, gw = blockIdx.x * 8 + (threadIdx.x >> 6), NGW = gridDim.x * 8;
    f32x4 w4[4];
#pragma unroll
    for (int j = 0; j < 4; ++j) w4[j] = ((const f32x4*)nw)[lane + 64 * j];
    const int per = NLAT / NGW;
    const int nrows = per + ((gw < NCTX && NGW >= NCTX) ? 1 : 0);
    if (NLAT % NGW != 0 || NGW < NCTX) {
        for (int r = gw; r < MTOT; r += NGW) {
            const float* xr = norm_src(xlat, xctx, r); const float* mp = mod + (r < NLAT ? (r >> 12) : 4) * 3072;
            f32x4 v[4]; float s = 0.f;
#pragma unroll
            for (int j = 0; j < 4; ++j) { v[j] = ((const f32x4*)xr)[lane + 64 * j]; s += (v[j].x * v[j].x + v[j].y * v[j].y) + (v[j].z * v[j].z + v[j].w * v[j].w); }
            const float rstd = 1.0f / sqrtf(wave_sum(s) * (1.0f / D) + 1e-6f);
            unsigned long long* o8 = (unsigned long long*)(H + (size_t)r * D) + lane;
#pragma unroll
            for (int j = 0; j < 4; ++j) { const f32x4 sh = ((const f32x4*)mp)[lane + 64 * j], sc = ((const f32x4*)(mp + 1024))[lane + 64 * j];
                const f32x4 y = v[j] * rstd * w4[j] * (sc + 1.0f) + sh; o8[64 * j] = (unsigned long long)pk2(y.x, y.y) | ((unsigned long long)pk2(y.z, y.w) << 32); }
        }
        return;
    }
    const int r0 = gw * per;
    f32x4 g4[4], sh4[4];
    { const float* mp = mod + (r0 >> 12) * 3072;
#pragma unroll
      for (int j = 0; j < 4; ++j) { g4[j] = w4[j] * (((const f32x4*)(mp + 1024))[lane + 64 * j] + 1.0f); sh4[j] = ((const f32x4*)mp)[lane + 64 * j]; } }
    f32x4 nx[4];
#pragma unroll
    for (int j = 0; j < 4; ++j) nx[j] = ((const f32x4*)(xlat + (size_t)r0 * D))[lane + 64 * j];
    for (int k = 0; k < nrows; ++k) {
        const bool isc = k == per;
        const int r = isc ? NLAT + gw : r0 + k;
        f32x4 v[4];
#pragma unroll
        for (int j = 0; j < 4; ++j) v[j] = nx[j];
        if (k + 1 < nrows) { const float* xr = (k + 1 == per) ? xctx + (size_t)gw * D : xlat + (size_t)(r0 + k + 1) * D;
#pragma unroll
            for (int j = 0; j < 4; ++j) nx[j] = ((const f32x4*)xr)[lane + 64 * j]; }
        if (isc) { const float* mp = mod + 4 * 3072;
#pragma unroll
            for (int j = 0; j < 4; ++j) { g4[j] = w4[j] * (((const f32x4*)(mp + 1024))[lane + 64 * j] + 1.0f); sh4[j] = ((const f32x4*)mp)[lane + 64 * j]; } }
        float s = 0.f;
#pragma unroll
        for (int j = 0; j < 4; ++j) s += (v[j].x * v[j].x + v[j].y * v[j].y) + (v[j].z * v[j].z + v[j].w * v[j].w);
        const float rstd = 1.0f / sqrtf(wave_sum(s) * (1.0f / D) + 1e-6f);
        unsigned long long* o8 = (unsigned long long*)(H + (size_t)r * D) + lane;
#pragma unroll
        for (int j = 0; j < 4; ++j) {
            const f32x4 y = v[j] * rstd * g4[j] + sh4[j];
            o8[64 * j] = (unsigned long long)pk2(y.x, y.y) | ((unsigned long long)pk2(y.z, y.w) << 32);
        }
    }
}
__device__ __forceinline__ void final_norm_phase(float* out, const float* nw) {
    const int lane = threadIdx.x & 63, gw = blockIdx.x * 8 + (threadIdx.x >> 6), NGW = gridDim.x * 8;
    f32x4 w4[4];
#pragma unroll
    for (int j = 0; j < 4; ++j) w4[j] = ((const f32x4*)nw)[lane + 64 * j];
    f32x4 nx[4];
#pragma unroll
    for (int j = 0; j < 4; ++j) nx[j] = ((const f32x4*)(out + (size_t)gw * D))[lane + 64 * j];
    for (int r = gw; r < NLAT; r += NGW) {
        f32x4* xr = (f32x4*)(out + (size_t)r * D);
        f32x4 v[4]; float s = 0.f;
#pragma unroll
        for (int j = 0; j < 4; ++j) v[j] = nx[j];
        if (r + NGW < NLAT) {
#pragma unroll
            for (int j = 0; j < 4; ++j) nx[j] = ((const f32x4*)(out + (size_t)(r + NGW) * D))[lane + 64 * j]; }
#pragma unroll
        for (int j = 0; j < 4; ++j) s += (v[j].x * v[j].x + v[j].y * v[j].y) + (v[j].z * v[j].z + v[j].w * v[j].w);
        const float rstd = 1.0f / sqrtf(wave_sum(s) * (1.0f / D) + 1e-6f);
#pragma unroll
        for (int j = 0; j < 4; ++j) xr[lane + 64 * j] = v[j] * rstd * w4[j];
    }
}

constexpr int KS_PITCH = 144, VT_PITCH = 264, VT_OFF = 128 * KS_PITCH;
constexpr int ATT_BUF = 36864;
constexpr float ATT_THR = 8.0f;
#define MFMA32(a, b, c) __builtin_amdgcn_mfma_f32_32x32x16_bf16((a), (b), (c), 0, 0, 0)
__device__ __forceinline__ void attn_phase(LAS unsigned char* lds, const bf16_t* QKVZ, bf16_t* AO, const float* sink) {
    const int tid = threadIdx.x, lane = tid & 63, wave = __builtin_amdgcn_readfirstlane(tid >> 6);
    const int ql = lane & 31, hh = lane >> 5, hq = wave & 3, qh = wave >> 2;
    int pb = 0;
    const bool bal = gridDim.x == 256;
    const int bi = blockIdx.x;
    int ctx_it = -1;
    { const int m = bi & 127, h = bi >> 7;
      if (m < 4) ctx_it = h * 4 + m; else if (m >= 124) ctx_it = 8 + h * 4 + (m - 124); else if (m >= 116) ctx_it = 16 + h * 8 + (m - 116); }
    const int nit = bal ? (ctx_it >= 0 ? 3 : 2) : (544 - bi + (int)gridDim.x - 1) / (int)gridDim.x;
#define ATT_ITEM(kk) (bal ? ((kk) == 0 ? bi : ((kk) == 1 ? 256 + ((bi + 8) & 255) : 512 + ctx_it)) : bi + (kk) * (int)gridDim.x)
#define ATT_QROW0(it) ((it) < 512 ? ((it) >> 7) * SEQ + (((it) >> 2) & 31) * 128 : NLAT + (((it) - 512) >> 3) * CTXL + ((((it) - 512) >> 2) & 1) * 128)
#define ATT_LOADQ(Q, it) do { const int qr0_ = ATT_QROW0(it), hd_ = ((it) & 3) * 4 + hq; _Pragma("unroll") for (int qt = 0; qt < 2; ++qt) _Pragma("unroll") for (int ks = 0; ks < 4; ++ks) \
        Q[qt][ks] = *(const bf16x8*)(QKVZ + (size_t)(qr0_ + 64 * qh + 32 * qt + ql) * NQKVZ + hd_ * 64 + 16 * ks + 8 * hh); } while (0)
#define ATT_LOADKV0(it) do { const bool ic_ = (it) >= 512; const int b_ = ic_ ? ((it) - 512) >> 3 : (it) >> 7, nb_ = ((it) >> 2) & 31, kh_ = (it) & 3; \
        const int kr0_ = ic_ ? NLAT + b_ * CTXL : b_ * SEQ + (nb_ == 0 ? 0 : nb_ - 1) * 128; \
        _Pragma("unroll") for (int i = 0; i < 2; ++i) { const int c = tid + 512 * i, key = c >> 3, dc = c & 7; kr[i] = *(const u32x4*)(QKVZ + (size_t)(kr0_ + key) * NQKVZ + 1024 + kh_ * 64 + dc * 8); } \
        va = *(const u32x4*)(QKVZ + (size_t)(kr0_ + 2 * kp) * NQKVZ + 1280 + kh_ * 64 + dcv * 8); \
        vb = *(const u32x4*)(QKVZ + (size_t)(kr0_ + 2 * kp + 1) * NQKVZ + 1280 + kh_ * 64 + dcv * 8); } while (0)
    const int kp = tid & 63, dcv = tid >> 6;
    u32x4 kr[2], va, vb;
    bf16x8 Qn[2][4];
    if (nit > 0) { ATT_LOADQ(Qn, ATT_ITEM(0)); ATT_LOADKV0(ATT_ITEM(0)); }
    for (int k = 0; k < nit; ++k) {
        const int item = ATT_ITEM(k);
        int b, kh, qrow0, nblk; bool isctx;
        if (item < 512) { b = item >> 7; nblk = (item >> 2) & 31; kh = item & 3; qrow0 = b * SEQ + nblk * 128; isctx = false; }
        else { const int r = item - 512; b = r >> 3; kh = r & 3; qrow0 = NLAT + b * CTXL + ((r >> 2) & 1) * 128; isctx = true; nblk = 0; }
        const int head = kh * 4 + hq;
        bf16x8 Qf[2][4];
#pragma unroll
        for (int qt = 0; qt < 2; ++qt)
#pragma unroll
            for (int ks = 0; ks < 4; ++ks) Qf[qt][ks] = Qn[qt][ks];
        f32x16 O[2][2];
#pragma unroll
        for (int dt = 0; dt < 2; ++dt)
#pragma unroll
            for (int qt = 0; qt < 2; ++qt)
#pragma unroll
                for (int i = 0; i < 16; ++i) O[dt][qt][i] = 0.f;
        const float sk = sink[head] * LOG2E;
        float m_[2] = {sk, sk}, l_[2]; l_[0] = l_[1] = (hh == 0) ? 1.0f : 0.0f;
        const int ntiles = isctx ? 2 : 5;
        int tcur = (!isctx && nblk == 0) ? 1 : 0;
        while (tcur < ntiles) {
            const int mode = (!isctx && tcur == 0) ? 1 : ((!isctx && tcur == 2) ? 2 : 0);
            LAS unsigned char* Ks = lds + pb * ATT_BUF; LAS unsigned char* Vt = Ks + VT_OFF; pb ^= 1;
            {
#pragma unroll
                for (int i = 0; i < 2; ++i) { const int c = tid + 512 * i, key = c >> 3, dc = c & 7; *(LAS u32x4*)(Ks + key * KS_PITCH + dc * 16) = kr[i]; }
                LAS unsigned char* vp = Vt + (dcv * 8) * VT_PITCH + kp * 4;
#pragma unroll
                for (int e = 0; e < 4; ++e) {
                    const unsigned wa = va[e], wb = vb[e];
                    *(LAS unsigned*)(vp + (2 * e) * VT_PITCH) = (wa & 0xffffu) | (wb << 16);
                    *(LAS unsigned*)(vp + (2 * e + 1) * VT_PITCH) = (wa >> 16) | (wb & 0xffff0000u);
                }
            }
            __syncthreads();
            int tnext = tcur + 1; if (!isctx && tnext == 2 && nblk == 31) tnext = 3;
            if (tnext < ntiles) {
                const int krow0 = isctx ? NLAT + b * CTXL + tnext * 128 : (tnext < 3 ? b * SEQ + (nblk - 1 + tnext) * 128 : NLAT + b * CTXL + (tnext - 3) * 128);
#pragma unroll
                for (int i = 0; i < 2; ++i) { const int c = tid + 512 * i, key = c >> 3, dc = c & 7; kr[i] = *(const u32x4*)(QKVZ + (size_t)(krow0 + key) * NQKVZ + 1024 + kh * 64 + dc * 8); }
                va = *(const u32x4*)(QKVZ + (size_t)(krow0 + 2 * kp) * NQKVZ + 1280 + kh * 64 + dcv * 8);
                vb = *(const u32x4*)(QKVZ + (size_t)(krow0 + 2 * kp + 1) * NQKVZ + 1280 + kh * 64 + dcv * 8);
            }
            tcur = tnext;
#pragma unroll 1
            for (int sub = 0; sub < 2; ++sub) {
                if ((mode == 1 && sub < qh) || (mode == 2 && sub > qh)) continue;
                f32x16 S[2][2];
#pragma unroll
                for (int kt = 0; kt < 2; ++kt)
#pragma unroll
                    for (int qt = 0; qt < 2; ++qt)
#pragma unroll
                        for (int i = 0; i < 16; ++i) S[kt][qt][i] = -m_[qt];
#pragma unroll
                for (int kt = 0; kt < 2; ++kt)
#pragma unroll
                    for (int ks = 0; ks < 4; ++ks) {
                        const bf16x8 Kf = *(const LAS bf16x8*)(Ks + (64 * sub + 32 * kt + ql) * KS_PITCH + (16 * ks + 8 * hh) * 2);
                        S[kt][0] = MFMA32(Kf, Qf[0][ks], S[kt][0]);
                        S[kt][1] = MFMA32(Kf, Qf[1][ks], S[kt][1]);
                    }
                if (mode) {
#pragma unroll
                    for (int kt = 0; kt < 2; ++kt)
#pragma unroll
                        for (int qt = 0; qt < 2; ++qt)
#pragma unroll
                            for (int i = 0; i < 16; ++i) {
                                const int j = 64 * sub + 32 * kt + 8 * (i >> 2) + 4 * hh + (i & 3), iq = 64 * qh + 32 * qt + ql;
                                const bool valid = (mode == 1) ? (j >= iq) : (j <= iq);
                                S[kt][qt][i] = valid ? S[kt][qt][i] : -1e30f;
                            }
                }
#pragma unroll
                for (int qt = 0; qt < 2; ++qt) {
                    float mx = S[0][qt][0];
#pragma unroll
                    for (int kt = 0; kt < 2; ++kt)
#pragma unroll
                        for (int i = 0; i < 16; ++i) mx = fmaxf(mx, S[kt][qt][i]);
                    { const auto rr = __builtin_amdgcn_permlane32_swap(__float_as_uint(mx), __float_as_uint(mx), false, false);
                      mx = fmaxf(__uint_as_float(rr[0]), __uint_as_float(rr[1])); }
                    float alpha = 1.0f;
                    if (!__builtin_expect(__all(mx <= ATT_THR), 1)) {
                        const float dlt = fmaxf(mx, 0.0f);
                        alpha = fast_exp2(-dlt); m_[qt] += dlt;
#pragma unroll
                        for (int i = 0; i < 16; ++i) { O[0][qt][i] *= alpha; O[1][qt][i] *= alpha; }
#pragma unroll
                        for (int kt = 0; kt < 2; ++kt)
#pragma unroll
                            for (int i = 0; i < 16; ++i) S[kt][qt][i] -= dlt;
                    }
                    float rs = 0.f;
#pragma unroll
                    for (int kt = 0; kt < 2; ++kt)
#pragma unroll
                        for (int i = 0; i < 16; ++i) { const float p = fast_exp2(S[kt][qt][i]); S[kt][qt][i] = p; rs += p; }
                    l_[qt] = l_[qt] * alpha + rs;
                }
#pragma unroll
                for (int kt = 0; kt < 2; ++kt)
#pragma unroll
                    for (int s2 = 0; s2 < 2; ++s2) {
                        bf16x8 Pf[2];
#pragma unroll
                        for (int qt = 0; qt < 2; ++qt) {
                            u32x4 w; w.x = pk2(S[kt][qt][8 * s2 + 0], S[kt][qt][8 * s2 + 1]); w.y = pk2(S[kt][qt][8 * s2 + 2], S[kt][qt][8 * s2 + 3]);
                            w.z = pk2(S[kt][qt][8 * s2 + 4], S[kt][qt][8 * s2 + 5]); w.w = pk2(S[kt][qt][8 * s2 + 6], S[kt][qt][8 * s2 + 7]);
                            Pf[qt] = __builtin_bit_cast(bf16x8, w);
                        }
#pragma unroll
                        for (int dt = 0; dt < 2; ++dt) {
                            const LAS unsigned char* ap = Vt + (32 * dt + ql) * VT_PITCH + (64 * sub + 32 * kt + 16 * s2 + 4 * hh) * 2;
                            const u32x2 lo = *(const LAS u32x2*)ap, hi = *(const LAS u32x2*)(ap + 16);
                            u32x4 w; w.x = lo.x; w.y = lo.y; w.z = hi.x; w.w = hi.y;
                            const bf16x8 Vf = __builtin_bit_cast(bf16x8, w);
                            O[dt][0] = MFMA32(Vf, Pf[0], O[dt][0]);
                            O[dt][1] = MFMA32(Vf, Pf[1], O[dt][1]);
                        }
                    }
            }
        }
        u32x2 zr[2][2][4];
#pragma unroll
        for (int qt = 0; qt < 2; ++qt)
#pragma unroll
            for (int dt = 0; dt < 2; ++dt)
#pragma unroll
                for (int a4 = 0; a4 < 4; ++a4)
                    zr[qt][dt][a4] = *(const u32x2*)(QKVZ + (size_t)(qrow0 + 64 * qh + 32 * qt + ql) * NQKVZ + 1536 + head * 64 + 32 * dt + 8 * a4 + 4 * hh);
        if (k + 1 < nit) { ATT_LOADQ(Qn, ATT_ITEM(k + 1)); ATT_LOADKV0(ATT_ITEM(k + 1)); }
#pragma unroll
        for (int qt = 0; qt < 2; ++qt) {
            const auto lr_ = __builtin_amdgcn_permlane32_swap(__float_as_uint(l_[qt]), __float_as_uint(l_[qt]), false, false);
            const float lt = __uint_as_float(lr_[0]) + __uint_as_float(lr_[1]), inv = 1.0f / lt;
            const size_t row = (size_t)(qrow0 + 64 * qh + 32 * qt + ql);
#pragma unroll
            for (int dt = 0; dt < 2; ++dt)
#pragma unroll
                for (int a4 = 0; a4 < 4; ++a4) {
                    const int d0 = 32 * dt + 8 * a4 + 4 * hh;
                    const u32x2 zw = zr[qt][dt][a4];
                    const float o0 = O[dt][qt][4 * a4 + 0] * inv * silu_f(bf_lo(zw.x)), o1 = O[dt][qt][4 * a4 + 1] * inv * silu_f(bf_hi(zw.x));
                    const float o2 = O[dt][qt][4 * a4 + 2] * inv * silu_f(bf_lo(zw.y)), o3 = O[dt][qt][4 * a4 + 3] * inv * silu_f(bf_hi(zw.y));
                    u32x2 w; w.x = pk2(o0, o1); w.y = pk2(o2, o3);
                    *(u32x2*)(AO + row * D + head * 64 + d0) = w;
                }
        }
    }
    __syncthreads();
}

constexpr int BU_PITCH = 132;
constexpr int XB_PITCH = 272;
template <bool OUT>
__device__ __forceinline__ void s5_chunk(LAS unsigned char* wl, const bf16x4 (&Uf)[4], const bf16x4 (&Bf)[8], const bf16x8 (&Cf)[4],
                                         float ar, float ai, float& xr, float& xi, int dir, f32x4 (&accY)[4], int lane) {
    LAS float* bu = (LAS float*)wl;
    LAS unsigned char* xb = wl + 16 * BU_PITCH * 4;
    const int fr = lane & 15, fq = lane >> 4;
#pragma unroll
    for (int mm = 0; mm < 4; ++mm) {
        const int m = dir ? 3 - mm : mm;
#pragma unroll
        for (int nt = 0; nt < 8; ++nt) {
            f32x4 c = {0.f, 0.f, 0.f, 0.f};
            c = __builtin_amdgcn_mfma_f32_16x16x16bf16_1k(m == 0 ? Uf[0] : m == 1 ? Uf[1] : m == 2 ? Uf[2] : Uf[3], Bf[nt], c, 0, 0, 0);
#pragma unroll
            for (int i = 0; i < 4; ++i) bu[(4 * fq + i) * BU_PITCH + 16 * nt + fr] = c[i];
        }
        WAVE_LDS_FENCE();
#pragma unroll
        for (int rr = 0; rr < 16; ++rr) {
            const int r = dir ? 15 - rr : rr;
            const f32x2 bb = *(const LAS f32x2*)(bu + r * BU_PITCH + 2 * lane);
            const float nr = fmaf(ar, xr, fmaf(-ai, xi, bb.x)), ni = fmaf(ar, xi, fmaf(ai, xr, bb.y));
            xr = nr; xi = ni;
            if (OUT) *(LAS unsigned*)(xb + r * XB_PITCH + lane * 4) = pk2(nr, ni);
        }
        if (OUT) {
            WAVE_LDS_FENCE();
            f32x4 y = (m == 0 ? accY[0] : m == 1 ? accY[1] : m == 2 ? accY[2] : accY[3]);
#pragma unroll
            for (int ks = 0; ks < 4; ++ks) {
                const bf16x8 Xf = *(const LAS bf16x8*)(xb + fr * XB_PITCH + (8 * fq + 32 * ks) * 2);
                y = __builtin_amdgcn_mfma_f32_16x16x32_bf16(Cf[ks], Xf, y, 0, 0, 0);
            }
            if (m == 0) accY[0] = y; else if (m == 1) accY[1] = y; else if (m == 2) accY[2] = y; else accY[3] = y;
        }
    }
}
__device__ __forceinline__ int chunk_rowbase(int b, int dir, int c) {
    if (dir == 0) return c < 4 ? NLAT + b * CTXL + 64 * c : b * SEQ + 64 * (c - 4);
    return c < 4 ? NLAT + b * CTXL + 64 * (3 - c) : b * SEQ + 64 * (63 - (c - 4));
}
__device__ __forceinline__ void load_uf(bf16x4 (&Uf)[4], const bf16_t* UZ, int rowbase, int g, int lane) {
#pragma unroll
    for (int m = 0; m < 4; ++m) Uf[m] = *(const bf16x4*)(UZ + (size_t)(rowbase + 16 * m + (lane & 15)) * NUZ + 16 * g + 4 * (lane >> 4));
}
__device__ __forceinline__ void cmul(float& xr, float& xi, float ar, float ai) { const float nr = xr * ar - xi * ai, ni = xr * ai + xi * ar; xr = nr; xi = ni; }
__device__ __forceinline__ bf16x4 cscale_bf(const bf16x4 re, const bf16x4 im, float wr, float wi, bool want_im) {
    bf16x4 o;
#pragma unroll
    for (int k = 0; k < 4; k += 2) {
        const float r0 = __uint_as_float((unsigned)(unsigned short)re[k] << 16), r1 = __uint_as_float((unsigned)(unsigned short)re[k + 1] << 16);
        const float i0 = __uint_as_float((unsigned)(unsigned short)im[k] << 16), i1 = __uint_as_float((unsigned)(unsigned short)im[k + 1] << 16);
        const unsigned w = want_im ? pk2(wr * i0 + wi * r0, wr * i1 + wi * r1) : pk2(wr * r0 - wi * i0, wr * r1 - wi * i1);
        o[k] = (short)(w & 0xffffu); o[k + 1] = (short)(w >> 16);
    }
    return o;
}
template <int DIR>
__device__ __forceinline__ void s5_local_dir(const bf16_t* UZ, unsigned char* ws, int gw, int NGW, int lane) {
    float* E = (float*)(ws + WS_E);
    const int pair = gw & 127, g = pair & 63, fr = lane & 15, fq = lane >> 4;
    const bf16_t* Bb = (const bf16_t*)(ws + WS_BB) + (size_t)pair * 128 * 16;
    bf16x4 Bre[4][4], Bim[4][4]; float a1r[4], a1i[4], a64r[4], a64i[4], wr_[4], wi_[4];
#pragma unroll
    for (int t = 0; t < 4; ++t) {
        const int p = 16 * t + fr;
        const bf16x4 b_re = *(const bf16x4*)(Bb + (2 * p) * 16 + 4 * fq), b_im = *(const bf16x4*)(Bb + (2 * p + 1) * 16 + 4 * fq);
        const f32x4 ap = ((const f32x4*)(ws + WS_APOW))[pair * 64 + p];
        const float ar = ap.x, ai = ap.y;
        float r2 = ar, i2 = ai; cmul(r2, i2, ar, ai);
        float r4 = r2, i4 = i2; cmul(r4, i4, r2, i2);
        float r8 = r4, i8 = i4; cmul(r8, i8, r4, i4);
        float r12 = r8, i12 = i8; cmul(r12, i12, r4, i4);
        float r16 = r8, i16 = i8; cmul(r16, i16, r8, i8);
        float r32 = r16, i32 = i16; cmul(r32, i32, r16, i16);
        float r48 = r32, i48 = i32; cmul(r48, i48, r16, i16);
        a1r[t] = ar; a1i[t] = ai; a64r[t] = ap.z; a64i[t] = ap.w;
        const int e = DIR ? fq : 3 - fq;
        wr_[t] = e == 0 ? 1.f : e == 1 ? r4 : e == 2 ? r8 : r12; wi_[t] = e == 0 ? 0.f : e == 1 ? i4 : e == 2 ? i8 : i12;
#pragma unroll
        for (int m = 0; m < 4; ++m) {
            const int em = DIR ? m : 3 - m;
            const float pr = em == 0 ? 1.f : em == 1 ? r16 : em == 2 ? r32 : r48, pi = em == 0 ? 0.f : em == 1 ? i16 : em == 2 ? i32 : i48;
            Bre[m][t] = cscale_bf(b_re, b_im, pr, pi, false); Bim[m][t] = cscale_bf(b_re, b_im, pr, pi, true);
        }
    }
    const int qd = gw >> 7, b = qd >> 2, q = qd & 3;
    if (qd >= 16) return;
    const int c0 = 17 * q, c1 = q < 3 ? c0 + 17 : 67;
    float Rr[4] = {0.f, 0.f, 0.f, 0.f}, Ri[4] = {0.f, 0.f, 0.f, 0.f};
    float* ebase = E + ((size_t)((b * 2 + DIR) * 64 + g) * NCHUNK) * 128;
    bf16x4 Un[4];
    load_uf(Un, UZ, chunk_rowbase(b, DIR, c0), g, lane);
    for (int c = c0; c < c1; ++c) {
        bf16x4 Uf[4];
#pragma unroll
        for (int m = 0; m < 4; ++m) Uf[m] = Un[m];
        if (c + 1 < c1) load_uf(Un, UZ, chunk_rowbase(b, DIR, c + 1), g, lane);
        float* e = ebase + (size_t)c * 128;
#pragma unroll
        for (int t = 0; t < 4; ++t) {
            f32x4 cr = {0.f, 0.f, 0.f, 0.f}, ci = {0.f, 0.f, 0.f, 0.f};
#pragma unroll
            for (int m = 0; m < 4; ++m) {
                cr = __builtin_amdgcn_mfma_f32_16x16x16bf16_1k(Uf[m], Bre[m][t], cr, 0, 0, 0);
                ci = __builtin_amdgcn_mfma_f32_16x16x16bf16_1k(Uf[m], Bim[m][t], ci, 0, 0, 0);
            }
            f32x2 s2 = {DIR ? cr[3] : cr[0], DIR ? ci[3] : ci[0]};
#pragma unroll
            for (int ii = 1; ii < 4; ++ii) { const int i = DIR ? 3 - ii : ii;
                s2 = cmac(s2, (f32x2){a1r[t], a1r[t]}, (f32x2){-a1i[t], a1i[t]}, (f32x2){cr[i], ci[i]}); }
            s2 = cmac(s2, (f32x2){wr_[t], wr_[t]}, (f32x2){-wi_[t], wi_[t]}, (f32x2){0.f, 0.f});
            float sr = s2.x, si = s2.y;
            sr += __shfl_xor(sr, 16); si += __shfl_xor(si, 16); sr += __shfl_xor(sr, 32); si += __shfl_xor(si, 32);
            if (fq == 0) { e[16 * t + fr] = Rr[t]; e[64 + 16 * t + fr] = Ri[t]; }
            const float nr = fmaf(a64r[t], Rr[t], fmaf(-a64i[t], Ri[t], sr)), ni = fmaf(a64r[t], Ri[t], fmaf(a64i[t], Rr[t], si)); Rr[t] = nr; Ri[t] = ni;
        }
    }
    float* fin = q < 3 ? (float*)(ws + WS_QE) + ((size_t)((b * 2 + DIR) * 64 + g) * 3 + q) * 128 : ebase + (size_t)67 * 128;
    if (fq == 0) {
#pragma unroll
        for (int t = 0; t < 4; ++t) { fin[16 * t + fr] = Rr[t]; fin[64 + 16 * t + fr] = Ri[t]; }
    }
}
__device__ __forceinline__ void s5_local_phase(LAS unsigned char* lds, const bf16_t* UZ, unsigned char* ws) {
    const int lane = threadIdx.x & 63, wave = __builtin_amdgcn_readfirstlane(threadIdx.x >> 6);
    const int gw = blockIdx.x * 8 + wave, NGW = gridDim.x * 8;
    if ((gw & 127) >> 6) s5_local_dir<1>(UZ, ws, gw, NGW, lane); else s5_local_dir<0>(UZ, ws, gw, NGW, lane);
}
__device__ __forceinline__ void s5_carry_phase(unsigned char* ws) {
    const int gt = blockIdx.x * 128 + (threadIdx.x & 127);
    if (threadIdx.x >= 128 || gt >= NB * 2 * 64 * 64) return;
    const int p = gt & 63, g = (gt >> 6) & 63, bd = gt >> 12, dir = bd & 1;
    const f32x4 ap = ((const f32x4*)(ws + WS_APOW))[(dir * 64 + g) * 64 + p];
    float* e = (float*)(ws + WS_E) + ((size_t)(bd * 64 + g) * NCHUNK) * 128 + p;
    float er[NCHUNK - 1], ei[NCHUNK - 1];
#pragma unroll
    for (int c = 0; c < NCHUNK - 1; ++c) { er[c] = e[c * 128]; ei[c] = e[c * 128 + 64]; }
    float xr = 0.f, xi = 0.f;
#pragma unroll
    for (int c = 0; c < NCHUNK - 1; ++c) {
        const float nr = ap.z * xr - ap.w * xi + er[c], ni = ap.z * xi + ap.w * xr + ei[c];
        er[c] = xr; ei[c] = xi; xr = nr; xi = ni;
    }
#pragma unroll
    for (int c = 0; c < NCHUNK - 1; ++c) { e[c * 128] = er[c]; e[c * 128 + 64] = ei[c]; }
    e[(NCHUNK - 1) * 128] = xr; e[(NCHUNK - 1) * 128 + 64] = xi;
}
__device__ __forceinline__ f32x2 s5_carry(const f32x2 pre, const f32x2 (&qe)[3], const f32x4 ap, int c) {
    const int q = c / 17, k = c - 17 * q;
    if (q == 0) return pre;
    float A1r = ap.z, A1i = ap.w;
    float A2r = A1r, A2i = A1i; cmul(A2r, A2i, A1r, A1i);
    float A4r = A2r, A4i = A2i; cmul(A4r, A4i, A2r, A2i);
    float A8r = A4r, A8i = A4i; cmul(A8r, A8i, A4r, A4i);
    float A16r = A8r, A16i = A8i; cmul(A16r, A16i, A8r, A8i);
    float A17r = A16r, A17i = A16i; cmul(A17r, A17i, A1r, A1i);
    float sr = qe[0].x, si = qe[0].y;
    if (q >= 2) { cmul(sr, si, A17r, A17i); sr += qe[1].x; si += qe[1].y; }
    if (q >= 3) { cmul(sr, si, A17r, A17i); sr += qe[2].x; si += qe[2].y; }
    if (k & 1) cmul(sr, si, A1r, A1i);
    if (k & 2) cmul(sr, si, A2r, A2i);
    if (k & 4) cmul(sr, si, A4r, A4i);
    if (k & 8) cmul(sr, si, A8r, A8i);
    if (k & 16) cmul(sr, si, A16r, A16i);
    return (f32x2){pre.x + sr, pre.y + si};
}
constexpr int BUT_BYTES = 64 * 80, XB_BYTES = 16 * XB_PITCH;
__device__ __forceinline__ float bf_at(const u32x4& lo, const u32x4& hi, int r) { const unsigned w = (r < 8 ? lo : hi)[(r & 7) >> 1]; return (r & 1) ? bf_hi(w) : bf_lo(w); }
__device__ __forceinline__ void s5_out_phase(LAS unsigned char* lds, const bf16_t* UZ, const unsigned char* ws, const float* dskip, bf16_t* YG) {
    const int lane = threadIdx.x & 63, wave = __builtin_amdgcn_readfirstlane(threadIdx.x >> 6);
    LAS unsigned char* wl = lds + wave * S5_WAVE_LDS;
    const int gw = blockIdx.x * 8 + wave, NGW = gridDim.x * 8;
    const float* E = (const float*)(ws + WS_E);
    const int g = gw & 63, fr = lane & 15, fq = lane >> 4;
    const f32x4 dsk = *(const f32x4*)(dskip + 16 * g + 4 * fq);
    bf16x4 Bf[2][8]; bf16x8 Cf[2][4]; f32x4 ap[2];
#pragma unroll
    for (int dir = 0; dir < 2; ++dir) {
        const int pair = dir * 64 + g;
        const bf16_t* Bb = (const bf16_t*)(ws + WS_BB) + (size_t)pair * 128 * 16;
        const bf16_t* Cm = (const bf16_t*)(ws + WS_CM) + (size_t)pair * 16 * 128;
#pragma unroll
        for (int nt = 0; nt < 8; ++nt) Bf[dir][nt] = *(const bf16x4*)(Bb + (16 * nt + fr) * 16 + 4 * fq);
#pragma unroll
        for (int ks = 0; ks < 4; ++ks) Cf[dir][ks] = *(const bf16x8*)(Cm + fr * 128 + 8 * fq + 32 * ks);
        ap[dir] = ((const f32x4*)(ws + WS_APOW))[pair * 64 + lane];
    }
    const int wofs = (fr >> 1) * 80 + (fr & 1) * 32 + 8 * fq;
    const int sstep = NGW >> 6;
    const float* QE = (const float*)(ws + WS_QE);
    bf16x4 Un[4]; f32x2 rp[2], rq[2][3];
#define S5_LOADRAW(bb, ttt) do { _Pragma("unroll") for (int dir = 0; dir < 2; ++dir) { const int c_ = dir ? 4 + 63 - (ttt) : 4 + (ttt); \
        const float* e_ = E + ((size_t)(((bb) * 2 + dir) * 64 + g) * NCHUNK + c_) * 128; rp[dir] = (f32x2){e_[lane], e_[64 + lane]}; \
        const float* q_ = QE + ((size_t)(((bb) * 2 + dir) * 64 + g) * 3) * 128; \
        _Pragma("unroll") for (int j = 0; j < 3; ++j) rq[dir][j] = (f32x2){q_[j * 128 + lane], q_[j * 128 + 64 + lane]}; } } while (0)
    { const int slot = gw >> 6, b = slot >> 6, tt = slot & 63;
      load_uf(Un, UZ, b * SEQ + 64 * tt, g, lane);
      S5_LOADRAW(b, tt); }
    for (int slot = gw >> 6; slot < 256; slot += sstep) {
        const int b = slot >> 6, tt = slot & 63, rowbase = b * SEQ + 64 * tt;
        bf16x4 Uf[4];
#pragma unroll
        for (int m = 0; m < 4; ++m) Uf[m] = Un[m];
        const f32x2 cF_ = s5_carry(rp[0], rq[0], ap[0], 4 + tt), cB_ = s5_carry(rp[1], rq[1], ap[1], 4 + 63 - tt);
        float xfr = cF_.x, xfi = cF_.y, xbr = cB_.x, xbi = cB_.y;
        if (slot + sstep < 256) { const int ns = slot + sstep, nb = ns >> 6, ntt = ns & 63;
            load_uf(Un, UZ, nb * SEQ + 64 * ntt, g, lane);
            S5_LOADRAW(nb, ntt); }
        f32x4 accY[4];
#pragma unroll
        for (int m = 0; m < 4; ++m) accY[m] = (f32x4){0.f, 0.f, 0.f, 0.f};
#pragma unroll
        for (int mm = 0; mm < 4; ++mm) {
            const int mf = mm, mb = 3 - mm;
#pragma unroll
            for (int nt = 0; nt < 8; ++nt) {
                const f32x4 z = {0.f, 0.f, 0.f, 0.f};
                const f32x4 cf = __builtin_amdgcn_mfma_f32_16x16x16bf16_1k(Uf[mf], Bf[0][nt], z, 0, 0, 0);
                const f32x4 cb = __builtin_amdgcn_mfma_f32_16x16x16bf16_1k(Uf[mb], Bf[1][nt], z, 0, 0, 0);
                u32x2 wf, wb; wf.x = pk2(cf[0], cf[1]); wf.y = pk2(cf[2], cf[3]); wb.x = pk2(cb[0], cb[1]); wb.y = pk2(cb[2], cb[3]);
                *(LAS u32x2*)(wl + nt * 640 + wofs) = wf;
                *(LAS u32x2*)(wl + BUT_BYTES + nt * 640 + wofs) = wb;
            }
            WAVE_LDS_FENCE();
            const LAS unsigned char* rp = wl + lane * 80;
            const u32x4 fre0 = *(const LAS u32x4*)(rp), fre1 = *(const LAS u32x4*)(rp + 16), fim0 = *(const LAS u32x4*)(rp + 32), fim1 = *(const LAS u32x4*)(rp + 48);
            const u32x4 bre0 = *(const LAS u32x4*)(rp + BUT_BYTES), bre1 = *(const LAS u32x4*)(rp + BUT_BYTES + 16), bim0 = *(const LAS u32x4*)(rp + BUT_BYTES + 32), bim1 = *(const LAS u32x4*)(rp + BUT_BYTES + 48);
            LAS unsigned char* xf = wl + 2 * BUT_BYTES; LAS unsigned char* xbk = xf + XB_BYTES;
#pragma unroll
            for (int rr = 0; rr < 16; ++rr) {
                const int r = rr, rb = 15 - rr;
                { const f32x2 bb = {bf_at(fre0, fre1, r), bf_at(fim0, fim1, r)};
                  const f32x2 n2 = cmac((f32x2){xfr, xfi}, (f32x2){ap[0].x, ap[0].x}, (f32x2){-ap[0].y, ap[0].y}, bb); xfr = n2.x; xfi = n2.y;
                  *(LAS unsigned*)(xf + r * XB_PITCH + lane * 4) = pk2(n2.x, n2.y); }
                { const f32x2 bb = {bf_at(bre0, bre1, rb), bf_at(bim0, bim1, rb)};
                  const f32x2 n2 = cmac((f32x2){xbr, xbi}, (f32x2){ap[1].x, ap[1].x}, (f32x2){-ap[1].y, ap[1].y}, bb); xbr = n2.x; xbi = n2.y;
                  *(LAS unsigned*)(xbk + rb * XB_PITCH + lane * 4) = pk2(n2.x, n2.y); }
            }
            WAVE_LDS_FENCE();
#pragma unroll
            for (int ks = 0; ks < 4; ++ks) {
                const bf16x8 Xf = *(const LAS bf16x8*)(xf + fr * XB_PITCH + (8 * fq + 32 * ks) * 2);
                const bf16x8 Xb = *(const LAS bf16x8*)(xbk + fr * XB_PITCH + (8 * fq + 32 * ks) * 2);
                accY[mf] = __builtin_amdgcn_mfma_f32_16x16x32_bf16(Cf[0][ks], Xf, accY[mf], 0, 0, 0);
                accY[mb] = __builtin_amdgcn_mfma_f32_16x16x32_bf16(Cf[1][ks], Xb, accY[mb], 0, 0, 0);
            }
        }
#pragma unroll
        for (int m = 0; m < 4; ++m) {
            const unsigned u0 = (unsigned)(unsigned short)Uf[m][0] | ((unsigned)(unsigned short)Uf[m][1] << 16), u1 = (unsigned)(unsigned short)Uf[m][2] | ((unsigned)(unsigned short)Uf[m][3] << 16);
            const float y0 = gelu_f(accY[m][0] + dsk[0] * bf_lo(u0)), y1 = gelu_f(accY[m][1] + dsk[1] * bf_hi(u0));
            const float y2 = gelu_f(accY[m][2] + dsk[2] * bf_lo(u1)), y3 = gelu_f(accY[m][3] + dsk[3] * bf_hi(u1));
            u32x2 w; w.x = pk2(y0, y1); w.y = pk2(y2, y3);
            *(u32x2*)(YG + (size_t)(rowbase + 16 * m + fr) * D + 16 * g + 4 * fq) = w;
        }
    }
}

__global__ void __launch_bounds__(512, 2) fwd_megakernel(Args a) {
    extern __shared__ __attribute__((aligned(16))) unsigned char lds_raw[];
    LAS unsigned char* lds = (LAS unsigned char*)lds_raw;
    cg::grid_group grid = cg::this_grid();
    unsigned char* ws = a.ws;
    volatile LAS unsigned* bst = (volatile LAS unsigned*)(lds + LDS_TOP);
    if (threadIdx.x < 2) bst[threadIdx.x] = 0u;
    __syncthreads();
    const XcdBarrier xbar = xcd_barrier_post((unsigned*)(ws + WS_BAR), bst);
    if (a.pad == 0x7ead) grid.sync();
    const int lo = a.ph_lo, hi = a.ph_hi;
    const int G = gridDim.x, bid = blockIdx.x;
    const float* mod0 = (const float*)(ws + WS_MOD);
    const float* mod1 = mod0 + 5 * 3072;
    bf16_t* H = (bf16_t*)(ws + WS_H);
    bf16_t* QKVZ = (bf16_t*)(ws + WS_QKVZ);
    bf16_t* AO = (bf16_t*)(ws + WS_AO);
    float* CTX1 = (float*)(ws + WS_CTX1);
#define IN(k) (lo <= (k) && (k) < hi)
#define SEAM(k) do { if (IN(k) && IN((k) + 1)) { xcd_barrier(xbar); if (SYNC_REP > 1) xcd_barrier(xbar); } } while (0)
#define REPB(k) ((((REP_MASK) >> (k)) & 1) != 0)
    if (IN(0)) p0_prologue(a, lds);
    if (IN(0) && REPB(0)) p0_prologue(a, lds);
    SEAM(0);
    if (IN(1)) norm_mod_phase(a.in[0], a.in[2], a.in[4], mod0, H);
    if (IN(1) && REPB(1)) norm_mod_phase(a.in[0], a.in[2], a.in[4], mod0, H);
    SEAM(1);
    if (IN(2)) { pg8::Gemm g{H, (const bf16_t*)(ws + WS_WQKVZ), MTOT, NQKVZ, D}; pg8::StaticOrder S; S.init(MTOT, NQKVZ, G, bid);
        EpiQKVZ E{QKVZ, (const float*)(ws + WS_ROPE)}; pg8::gemm_phase<EpiQKVZ, pg8::StaticOrder>(lds, g, S, E);
        p2_late_transposes(a, lds, (MTOT / 256) * (NQKVZ / 256) - 2 * G); }
    if (IN(2) && REPB(2)) { pg8::Gemm g{H, (const bf16_t*)(ws + WS_WQKVZ), MTOT, NQKVZ, D}; pg8::StaticOrder S; S.init(MTOT, NQKVZ, G, bid);
        EpiQKVZ E{QKVZ, (const float*)(ws + WS_ROPE)}; pg8::gemm_phase<EpiQKVZ, pg8::StaticOrder>(lds, g, S, E); }
    SEAM(2);
    if (IN(3)) attn_phase(lds, QKVZ, AO, a.in[8]);
    if (IN(3) && REPB(3)) attn_phase(lds, QKVZ, AO, a.in[8]);
    SEAM(3);
    if (IN(4)) { pg8::Gemm g{AO, (const bf16_t*)(ws + WS_WAO), NLAT, D, D}; PanelOrder S; S.init(NLAT, G, bid);
        EpiResidNorm<false> E{a.in[0], (bf16_t*)(ws + WS_X1), nullptr, mod0, a.in[4] + D, mod1, H, (float*)(ws + WS_STAT), (unsigned*)(ws + WS_CNT)};
        pg8::gemm_phase<EpiResidNorm<false>, PanelOrder>(lds, g, S, E);
        if (bid < 256) { const int rb = bid >> 4, cb = bid & 15;
            Epi64ResidNorm E2{a.in[2] + (size_t)rb * 64 * D, mod0 + 4 * 3072, a.in[4] + D, mod1 + 4 * 3072, H + (size_t)(NLAT + rb * 64) * D, cb * 64,
                              (float*)(ws + WS_STATC) + rb * 1024, (unsigned*)(ws + WS_CNTC) + rb * 64, cb};
            gemm64_tile<Epi64ResidNorm>(lds, AO + (size_t)(NLAT + rb * 64) * D, (const bf16_t*)(ws + WS_WAO) + (size_t)cb * 64 * D, E2); } }
    SEAM(5);
    if (IN(6)) { pg8::Gemm g{H, (const bf16_t*)(ws + WS_WSIN), NLAT, NUZ, D}; pg8::StaticOrder S; S.init(NLAT, NUZ, G, bid);
        EpiBf16 E{QKVZ, NUZ}; pg8::gemm_phase<EpiBf16, pg8::StaticOrder>(lds, g, S, E);
        if (bid < 256) { const int rb = bid >> 4, cb = bid & 15;
            Epi64Bf16 E2{QKVZ + (size_t)(NLAT + rb * 64) * NUZ + cb * 64, NUZ};
            gemm64_tile<Epi64Bf16>(lds, H + (size_t)(NLAT + rb * 64) * D, (const bf16_t*)(ws + WS_WSIN) + (size_t)cb * 64 * D, E2); } }
    SEAM(6);
    if (IN(7)) s5_local_phase(lds, QKVZ, ws);
    if (IN(7) && REPB(7)) s5_local_phase(lds, QKVZ, ws);
    SEAM(7);
    if (IN(9)) s5_out_phase(lds, QKVZ, ws, a.in[18], AO);
    if (IN(9) && REPB(9)) s5_out_phase(lds, QKVZ, ws, a.in[18], AO);
    SEAM(9);
    if (IN(10)) { pg8::Gemm g{AO, (const bf16_t*)(ws + WS_WGLU), NLAT, NUZ, D}; pg8::StaticOrder S; S.init(NLAT, NUZ, G, bid);
        EpiGlu E{H, QKVZ}; pg8::gemm_phase<EpiGlu, pg8::StaticOrder>(lds, g, S, E); }
    if (IN(10) && REPB(10)) { pg8::Gemm g{AO, (const bf16_t*)(ws + WS_WGLU), NLAT, NUZ, D}; pg8::StaticOrder S; S.init(NLAT, NUZ, G, bid);
        EpiGlu E{H, QKVZ}; pg8::gemm_phase<EpiGlu, pg8::StaticOrder>(lds, g, S, E); }
    SEAM(10);
    if (IN(11)) { pg8::Gemm g{H, (const bf16_t*)(ws + WS_WSOUT), NLAT, D, D}; PanelOrder S; S.init(NLAT, G, bid);
        EpiResidNorm<true> E{nullptr, (bf16_t*)(ws + WS_X1), a.out, mod1, a.in[21], nullptr, nullptr, (float*)(ws + WS_STAT) + 68 * 1024, (unsigned*)(ws + WS_CNT) + 68 * 64};
        pg8::gemm_phase<EpiResidNorm<true>, PanelOrder>(lds, g, S, E); }
#undef IN
#undef SEAM
}

extern "C" void kernel_launch(void* const* d_in, const int* in_sizes, int n_in, void* d_out, int out_size, void* d_ws, size_t ws_size, hipStream_t stream) {
    static int grid = 0;
    if (grid == 0) {
        int dev = 0, cus = 0, per_cu = 0;
        (void)hipGetDevice(&dev);
        (void)hipDeviceGetAttribute(&cus, hipDeviceAttributeMultiprocessorCount, dev);
        (void)hipFuncSetAttribute((const void*)fwd_megakernel, hipFuncAttributeMaxDynamicSharedMemorySize, LDS_BYTES);
        (void)hipOccupancyMaxActiveBlocksPerMultiprocessor(&per_cu, (const void*)fwd_megakernel, 512, LDS_BYTES);
        if (per_cu < 1) per_cu = 1;
        grid = cus * per_cu;
        if (n_in != 22 || ws_size < WS_END) { fprintf(stderr, "kernel_launch: unexpected n_in %d / ws_size %zu\n", n_in, ws_size); }
    }
    Args a{};
    for (int i = 0; i < 22; ++i) a.in[i] = (const float*)d_in[i];
    a.out = (float*)d_out; a.ws = (unsigned char*)d_ws; a.ph_lo = 0; a.ph_hi = 13;
    (void)hipMemsetAsync((char*)d_ws + WS_BAR, 0, BAR_ZERO_BYTES, stream);
    void* args[] = {&a};
    hipError_t e = hipLaunchCooperativeKernel((void*)fwd_megakernel, dim3(grid), dim3(512), args, LDS_BYTES, stream);
    if (e != hipSuccess) fprintf(stderr, "cooperative launch failed: %s (grid %d)\n", hipGetErrorString(e), grid);
}
```

```cpp
#include <hip/hip_runtime.h>
#include <hip/hip_cooperative_groups.h>
#include <cstdio>
#include <cstdint>
namespace cg = cooperative_groups;

#define LAS __attribute__((address_space(3)))
typedef unsigned short bf16_t;
typedef short bf16x8 __attribute__((ext_vector_type(8)));
typedef short bf16x4 __attribute__((ext_vector_type(4)));
typedef float f32x4 __attribute__((ext_vector_type(4)));
typedef float f32x2 __attribute__((ext_vector_type(2)));
typedef float f32x16 __attribute__((ext_vector_type(16)));
typedef unsigned u32x4 __attribute__((ext_vector_type(4)));
typedef unsigned u32x2 __attribute__((ext_vector_type(2)));
typedef __bf16 nbf2 __attribute__((ext_vector_type(2)));

constexpr int D = 1024, NB = 4, SEQ = 4096, CTXL = 256;
constexpr int NLAT = NB * SEQ;
constexpr int NCTX = NB * CTXL;
constexpr int MTOT = NLAT + NCTX;
constexpr int NQKVZ = 2560;
constexpr int NUZ = 2048;
constexpr int NCHUNK = 68;
constexpr float LOG2E = 1.4426950408889634f;

constexpr size_t MiB = 1u << 20;
constexpr size_t WS_MOD = 0;
constexpr size_t WS_BAR = 128 * 1024;
constexpr size_t WS_ROPE = 256 * 1024;
constexpr size_t WS_APOW = 512 * 1024;
constexpr size_t WS_BB = 1 * MiB;
constexpr size_t WS_CM = 1 * MiB + 512 * 1024;
constexpr size_t WS_WQKVZ = 2 * MiB;
constexpr size_t WS_WAO = 7 * MiB;
constexpr size_t WS_WSIN = 9 * MiB;
constexpr size_t WS_WGLU = 13 * MiB;
constexpr size_t WS_WSOUT = 17 * MiB;
constexpr size_t WS_CTX1 = 19 * MiB;
constexpr size_t WS_E = 23 * MiB;
constexpr size_t WS_H = 40 * MiB;
constexpr size_t WS_AO = 74 * MiB;
constexpr size_t WS_QKVZ = 108 * MiB;
constexpr size_t WS_STAT = 193 * MiB;
constexpr size_t WS_QE = 194 * MiB;
constexpr size_t WS_X1 = 195 * MiB;
constexpr size_t WS_END = 227 * MiB;
constexpr size_t WS_CNT = WS_BAR + 16384;
constexpr size_t WS_STATC = WS_STAT + 768 * 1024;
constexpr size_t WS_CNTC = WS_CNT + 2 * 68 * 256;
constexpr size_t BAR_ZERO_BYTES = 16384 + 2 * 68 * 256 + 16 * 256;

constexpr int S5_WAVE_LDS = 18944;
constexpr int LDS_TOP = 8 * S5_WAVE_LDS;
constexpr int LDS_BYTES = LDS_TOP + 6144;
#ifndef REP_MASK
#define REP_MASK 0
#endif
#ifndef SYNC_REP
#define SYNC_REP 1
#endif

__device__ __forceinline__ unsigned pk2(float lo, float hi) { f32x2 v = {lo, hi}; nbf2 r = __builtin_convertvector(v, nbf2); return __builtin_bit_cast(unsigned, r); }
__device__ __forceinline__ float bf_lo(unsigned w) { return __uint_as_float(w << 16); }
__device__ __forceinline__ float bf_hi(unsigned w) { return __uint_as_float(w & 0xffff0000u); }
__device__ __forceinline__ float fast_rcp(float x) { return __builtin_amdgcn_rcpf(x); }
__device__ __forceinline__ float fast_exp2(float x) { return __builtin_amdgcn_exp2f(x); }
__device__ __forceinline__ float silu_f(float z) { return z * fast_rcp(1.0f + fast_exp2(-z * LOG2E)); }
__device__ __forceinline__ float sigmoid_f(float z) { return fast_rcp(1.0f + fast_exp2(-z * LOG2E)); }
__device__ __forceinline__ float wave_sum(float v) {
#pragma unroll
    for (int o = 1; o < 64; o <<= 1) v += __shfl_xor(v, o);
    return v;
}
__device__ __forceinline__ float gelu_f(float v) {
    const float av = fabsf(v), d = av * 0.2316418882f + 1.0f;
    const float t = fast_rcp(d);
    float q = t * 0.5307027145f + (-0.7265760135f); q = q * t + 0.7107068705f; q = q * t + (-0.142248368f); q = q * t + 0.127414796f; q = q * t;
    const float e = fast_exp2((v * v) * (-0.72134752044f));
    const float m = v * (q * e), r = v - m;
    return v < 0.f ? m : r;
}
#define WAVE_LDS_FENCE() asm volatile("s_waitcnt lgkmcnt(0)" ::: "memory")
__device__ __forceinline__ f32x2 cmac(f32x2 x, f32x2 a_rr, f32x2 a_i, f32x2 c) { const f32x2 t = a_rr * x + c; const f32x2 xs = {x.y, x.x}; return a_i * xs + t; }

namespace pg8 {
constexpr int BM = 256, BK = 64, HALF = 128, HTB = HALF * BK * 2, NXCD = 8, WGM = 8;
__host__ __device__ __forceinline__ int lds_byte(int r, int c) { const int st = (r >> 4) * 2 + (c >> 5), rr = r & 15, cc = c & 31, ob = rr * 64 + cc * 2; return st * 1024 + (ob ^ (((ob >> 9) & 1) << 5)); }
__host__ __device__ __forceinline__ void stage_rc(int b, int& R, int& C) { const int st = b / 1024, sb = b % 1024, swz = sb ^ (((sb >> 9) & 1) << 5); R = (st >> 1) * 16 + swz / 64; C = (st & 1) * 32 + (swz % 64) / 2; }
__host__ __device__ __forceinline__ int perm32(int rho) { const int n = rho >> 4, i = rho & 15; return 8 * (i >> 2) + 4 * n + (i & 3); }
struct Unit { int pm, pn; };
struct Gemm { const bf16_t* A; const bf16_t* Bt; int M, N, K; };
struct StaticOrder {
    int nM, nN, nwg, G, c;
    __device__ void init(int M, int N, int G_, int c_) { nM = M / BM; nN = N / BM; nwg = nM * nN; G = G_; c = c_; }
    __device__ bool next(int i, Unit& u) const {
        const long L = (long)i * G + c; if (L >= nwg) return false;
        int wgid = (int)L; { const int q = nwg / NXCD, r = nwg % NXCD, xcd = wgid % NXCD, off = wgid / NXCD; wgid = (xcd < r ? xcd * (q + 1) : r * (q + 1) + (xcd - r) * q) + off; }
        const int nig = WGM * nN, gid = wgid / nig, fm = gid * WGM, gsz = (nM - fm) < WGM ? (nM - fm) : WGM;
        u.pm = fm + ((wgid % nig) % gsz); u.pn = (wgid % nig) / gsz; return true;
    }
};
template <class Epi, class Sched>
__device__ __forceinline__ void gemm_phase(LAS unsigned char* lds, const Gemm g, const Sched& S, const Epi& E) {
    const int tid = threadIdx.x, wid = __builtin_amdgcn_readfirstlane(tid >> 6), lane = tid & 63, wr = wid >> 2, wc = wid & 3, fr = lane & 15, fq = lane >> 4;
    const int K = g.K, nt = K / BK;
    unsigned voffA[2], voffB[2];
#pragma unroll
    for (int i = 0; i < 2; ++i) { int R, C; stage_rc(tid * 16 + i * 8192, R, C); const int Rb = Epi::PERM ? ((R & ~31) + perm32(R & 31)) : R;
        voffA[i] = (unsigned)(R * K + C) * 2u; voffB[i] = (unsigned)(Rb * K + C) * 2u; }
    const size_t kstep = (size_t)(BK * 2);
    const size_t hstep = (size_t)HALF * K * 2;
    const size_t tstep = 2 * hstep;
    const unsigned ldsw = (unsigned)wid * 1024u;
    const int aoff = lds_byte(wr * 64 + fr, fq * 8), boff = lds_byte(wc * 32 + fr, fq * 8);
#define PG8_SA(b, h) (((b) * 2 + (h)) * HTB)
#define PG8_SB(b, h) ((4 + (b) * 2 + (h)) * HTB)
#define PG8_STAGE(bufoff, gbase, voff) do { _Pragma("unroll") for (int _i = 0; _i < 2; ++_i) \
        __builtin_amdgcn_global_load_lds((const unsigned*)((const char*)(gbase) + (voff)[_i]), (LAS unsigned*)(lds + (bufoff) + ldsw + _i * 8192), 16, 0, 0); } while (0)
#define PG8_LDA(dst, b, h) do { _Pragma("unroll") for (int m = 0; m < 4; ++m) _Pragma("unroll") for (int k = 0; k < 2; ++k) dst[m][k] = *(const LAS bf16x8*)(lds + PG8_SA(b, h) + aoff + m * 2048 + k * 1024); } while (0)
#define PG8_LDB(dst, b, h) do { _Pragma("unroll") for (int n = 0; n < 2; ++n) _Pragma("unroll") for (int k = 0; k < 2; ++k) dst[n][k] = *(const LAS bf16x8*)(lds + PG8_SB(b, h) + boff + n * 2048 + k * 1024); } while (0)
#define PG8_MMA(ai, bj, At, Bt) do { __builtin_amdgcn_s_setprio(1); _Pragma("unroll") for (int m = 0; m < 4; ++m) _Pragma("unroll") for (int n = 0; n < 2; ++n) _Pragma("unroll") for (int k = 0; k < 2; ++k) \
        acc[ai][bj][m][n] = __builtin_amdgcn_mfma_f32_16x16x32_bf16(Bt[n][k], At[m][k], acc[ai][bj][m][n], 0, 0, 0); __builtin_amdgcn_s_setprio(0); } while (0)
#define PG8_WAIT_V(n) asm volatile("s_waitcnt vmcnt(" #n ")" ::: "memory")
#define PG8_WAIT_L(n) asm volatile("s_waitcnt lgkmcnt(" #n ")" ::: "memory")
#define PG8_BAR __builtin_amdgcn_s_barrier()
#define PG8_SCHED __builtin_amdgcn_sched_barrier(0)
    Unit cur, nxt; int ui = 0;
    if (!S.next(0, cur)) return;
    f32x4 acc[2][2][4][2];
#pragma unroll
    for (int a = 0; a < 2; ++a)
#pragma unroll
        for (int b = 0; b < 2; ++b)
#pragma unroll
            for (int m = 0; m < 4; ++m)
#pragma unroll
                for (int n = 0; n < 2; ++n) acc[a][b][m][n] = (f32x4){0.f, 0.f, 0.f, 0.f};
    bf16x8 At[4][2], B0[2][2], B1[2][2];
    const char* cA = (const char*)g.A + (size_t)cur.pm * tstep; const char* cB = (const char*)g.Bt + (size_t)cur.pn * tstep;
    PG8_STAGE(PG8_SB(0, 0), cB, voffB); PG8_STAGE(PG8_SB(0, 1), cB + hstep, voffB); PG8_STAGE(PG8_SA(0, 0), cA, voffA); PG8_STAGE(PG8_SA(0, 1), cA + hstep, voffA);
    if (wr == 1) PG8_BAR;
    PG8_WAIT_V(2); PG8_BAR;
    PG8_STAGE(PG8_SB(1, 0), cB + kstep, voffB); PG8_STAGE(PG8_SA(1, 0), cA + kstep, voffA); PG8_STAGE(PG8_SB(1, 1), cB + hstep + kstep, voffB);
    PG8_WAIT_V(6); PG8_BAR;
    for (;;) {
        const bool has_next = S.next(ui + 1, nxt);
        const char* nA = has_next ? (const char*)g.A + (size_t)nxt.pm * tstep : cA; const char* nB = has_next ? (const char*)g.Bt + (size_t)nxt.pn * tstep : cB;
        for (int t = 0; t < nt; t += 2) {
            const bool last = (t == nt - 2);
            const char* a1 = cA + (size_t)(t + 1) * kstep;
            const char* a2 = last ? nA : cA + (size_t)(t + 2) * kstep; const char* b2 = last ? nB : cB + (size_t)(t + 2) * kstep;
            const char* a3 = a2 + kstep; const char* b3 = b2 + kstep;
            PG8_LDB(B0, 0, 0); PG8_LDB(B1, 0, 1); PG8_SCHED; PG8_LDA(At, 0, 0); PG8_STAGE(PG8_SA(1, 1), a1 + hstep, voffA);
            PG8_WAIT_V(8); PG8_WAIT_L(0); PG8_BAR; PG8_MMA(0, 0, At, B0); PG8_MMA(0, 1, At, B1); PG8_BAR; PG8_SCHED;
            PG8_LDA(At, 0, 1); PG8_STAGE(PG8_SB(0, 0), b2, voffB); PG8_STAGE(PG8_SB(0, 1), b2 + hstep, voffB); PG8_STAGE(PG8_SA(0, 0), a2, voffA);
            PG8_WAIT_V(8); PG8_WAIT_L(0); PG8_BAR; PG8_MMA(1, 0, At, B0); PG8_MMA(1, 1, At, B1); PG8_BAR; PG8_SCHED;
            PG8_LDB(B0, 1, 0); PG8_LDB(B1, 1, 1); PG8_SCHED; PG8_LDA(At, 1, 0); PG8_STAGE(PG8_SA(0, 1), a2 + hstep, voffA);
            PG8_WAIT_V(8); PG8_WAIT_L(0); PG8_BAR; PG8_MMA(0, 0, At, B0); PG8_MMA(0, 1, At, B1); PG8_BAR; PG8_SCHED;
            PG8_LDA(At, 1, 1); PG8_STAGE(PG8_SB(1, 0), b3, voffB); PG8_STAGE(PG8_SB(1, 1), b3 + hstep, voffB); PG8_STAGE(PG8_SA(1, 0), a3, voffA);
            PG8_WAIT_V(8); PG8_WAIT_L(0); PG8_BAR; PG8_MMA(1, 0, At, B0); PG8_MMA(1, 1, At, B1); PG8_BAR; PG8_SCHED;
        }
        if (wr == 0) PG8_BAR;
        E(acc, cur, wr, wc, fr, fq, lds);
        if (!has_next) break;
#pragma unroll
        for (int a = 0; a < 2; ++a)
#pragma unroll
            for (int b = 0; b < 2; ++b)
#pragma unroll
                for (int m = 0; m < 4; ++m)
#pragma unroll
                    for (int n = 0; n < 2; ++n) acc[a][b][m][n] = (f32x4){0.f, 0.f, 0.f, 0.f};
        cur = nxt; cA = nA; cB = nB; ++ui;
        if (wr == 1) PG8_BAR;
    }
    PG8_WAIT_V(0);
    PG8_BAR;
#undef PG8_SA
#undef PG8_SB
#undef PG8_STAGE
#undef PG8_LDA
#undef PG8_LDB
#undef PG8_MMA
#undef PG8_WAIT_V
#undef PG8_WAIT_L
#undef PG8_BAR
#undef PG8_SCHED
}
}

struct EpiQKVZ {
    static constexpr bool PERM = true;
    bf16_t* O; const float* rope;
    __device__ __forceinline__ void operator()(f32x4 (&acc)[2][2][4][2], const pg8::Unit& u, int wr, int wc, int fr, int fq, LAS unsigned char* lds) const {
        const float qs = 0.125f * LOG2E;
#pragma unroll
        for (int ai = 0; ai < 2; ++ai)
#pragma unroll
            for (int m = 0; m < 4; ++m) {
                const int r = u.pm * 256 + ai * 128 + wr * 64 + m * 16 + fr;
                const bool lat = r < NLAT;
                const int t = r & (SEQ - 1);
                const int val = (wc & 1) ? (t & 63) : (t >> 6);
                const f32x4 cs = *(const f32x4*)(rope + val * 32 + 4 * fq), sn = *(const f32x4*)(rope + val * 32 + 16 + 4 * fq);
                bf16_t* rowp = O + (size_t)r * NQKVZ;
#pragma unroll
                for (int bj = 0; bj < 2; ++bj) {
                    const int cb = u.pn * 256 + bj * 128 + wc * 32;
                    f32x4 t1 = acc[ai][bj][m][0], t2 = acc[ai][bj][m][1];
                    if (cb < 1280 && lat) { const f32x4 o1 = t1 * cs - t2 * sn, o2 = t2 * cs + t1 * sn; t1 = o1; t2 = o2; }
                    if (cb < 1024) { t1 = t1 * qs; t2 = t2 * qs; }
                    u32x4 w; w.x = pk2(t1[0], t1[1]); w.y = pk2(t1[2], t1[3]); w.z = pk2(t2[0], t2[1]); w.w = pk2(t2[2], t2[3]);
                    *(u32x4*)(rowp + cb + 8 * fq) = w;
                }
            }
    }
};
struct EpiResid {
    static constexpr bool PERM = true;
    const float* base_lat; float* out_lat; const float* base_ctx; float* out_ctx; const float* mod;
    __device__ __forceinline__ void operator()(f32x4 (&acc)[2][2][4][2], const pg8::Unit& u, int wr, int wc, int fr, int fq, LAS unsigned char* lds) const {
#pragma unroll
        for (int ai = 0; ai < 2; ++ai) {
            const int r0 = u.pm * 256 + ai * 128;
            const bool lat = r0 < NLAT;
            const int v = lat ? (r0 >> 12) : 4;
            const float* gp = mod + v * 3072 + 2048;
            const float* bp = lat ? base_lat : base_ctx - (size_t)NLAT * D;
            float* op = lat ? out_lat : out_ctx - (size_t)NLAT * D;
#pragma unroll
            for (int bj = 0; bj < 2; ++bj) {
                const int c0 = u.pn * 256 + bj * 128 + wc * 32 + 8 * fq;
                const f32x4 g0 = *(const f32x4*)(gp + c0), g1 = *(const f32x4*)(gp + c0 + 4);
#pragma unroll
                for (int m = 0; m < 4; ++m) {
                    const size_t off = (size_t)(r0 + wr * 64 + m * 16 + fr) * D + c0;
                    const f32x4 x0 = *(const f32x4*)(bp + off), x1 = *(const f32x4*)(bp + off + 4);
                    *(f32x4*)(op + off) = x0 + g0 * acc[ai][bj][m][0];
                    *(f32x4*)(op + off + 4) = x1 + g1 * acc[ai][bj][m][1];
                }
            }
        }
    }
};
struct EpiBf16 {
    static constexpr bool PERM = true;
    bf16_t* O; int ldc;
    __device__ __forceinline__ void operator()(f32x4 (&acc)[2][2][4][2], const pg8::Unit& u, int wr, int wc, int fr, int fq, LAS unsigned char* lds) const {
#pragma unroll
        for (int ai = 0; ai < 2; ++ai)
#pragma unroll
            for (int m = 0; m < 4; ++m) {
                bf16_t* rowp = O + (size_t)(u.pm * 256 + ai * 128 + wr * 64 + m * 16 + fr) * ldc + u.pn * 256 + wc * 32 + 8 * fq;
#pragma unroll
                for (int bj = 0; bj < 2; ++bj) {
                    const f32x4 v0 = acc[ai][bj][m][0], v1 = acc[ai][bj][m][1];
                    u32x4 w; w.x = pk2(v0[0], v0[1]); w.y = pk2(v0[2], v0[3]); w.z = pk2(v1[0], v1[1]); w.w = pk2(v1[2], v1[3]);
                    *(u32x4*)(rowp + bj * 128) = w;
                }
            }
    }
};
struct EpiGlu {
    static constexpr bool PERM = true;
    bf16_t* O; const bf16_t* UZ;
    __device__ __forceinline__ void operator()(f32x4 (&acc)[2][2][4][2], const pg8::Unit& u, int wr, int wc, int fr, int fq, LAS unsigned char* lds) const {
#pragma unroll
        for (int ai = 0; ai < 2; ++ai)
#pragma unroll
            for (int m = 0; m < 4; ++m) {
                const int r = u.pm * 256 + ai * 128 + wr * 64 + m * 16 + fr;
                const int oc = u.pn * 128 + wc * 32 + 8 * fq;
                const u32x4 zw = *(const u32x4*)(UZ + (size_t)r * NUZ + 1024 + oc);
                const f32x4 a0 = acc[ai][0][m][0], a1 = acc[ai][0][m][1], g0 = acc[ai][1][m][0], g1 = acc[ai][1][m][1];
                float o[8];
                o[0] = a0[0] * sigmoid_f(g0[0]) * silu_f(bf_lo(zw.x)); o[1] = a0[1] * sigmoid_f(g0[1]) * silu_f(bf_hi(zw.x));
                o[2] = a0[2] * sigmoid_f(g0[2]) * silu_f(bf_lo(zw.y)); o[3] = a0[3] * sigmoid_f(g0[3]) * silu_f(bf_hi(zw.y));
                o[4] = a1[0] * sigmoid_f(g1[0]) * silu_f(bf_lo(zw.z)); o[5] = a1[1] * sigmoid_f(g1[1]) * silu_f(bf_hi(zw.z));
                o[6] = a1[2] * sigmoid_f(g1[2]) * silu_f(bf_lo(zw.w)); o[7] = a1[3] * sigmoid_f(g1[3]) * silu_f(bf_hi(zw.w));
                u32x4 w; w.x = pk2(o[0], o[1]); w.y = pk2(o[2], o[3]); w.z = pk2(o[4], o[5]); w.w = pk2(o[6], o[7]);
                *(u32x4*)(O + (size_t)r * D + oc) = w;
            }
    }
};


#define XB_TMO      128
#define XB_XCNT(j)  (256  + 64 * (j))
#define XB_XSUB(j)  (1280 + 64 * (j))
#define XB_XGEN(j)  (2304 + 64 * (j))
#define XB_TOP      3328
#define XB_TOPGEN   3392
#define XCD_BAR_WORDS 3456
#define XB_SPIN_CAP (1u << 18)
__device__ __forceinline__ unsigned xb_ld(unsigned* p)              { return __hip_atomic_load(p, __ATOMIC_RELAXED, __HIP_MEMORY_SCOPE_AGENT); }
__device__ __forceinline__ unsigned xb_add(unsigned* p, unsigned v) { return __hip_atomic_fetch_add(p, v, __ATOMIC_RELAXED, __HIP_MEMORY_SCOPE_AGENT); }
__device__ __forceinline__ unsigned xb_xcc_id() { return (unsigned)__builtin_amdgcn_s_getreg((3 << 11) | 20) & 0xFu; }
#define XB_SPIN(cond, bar) do { unsigned _sp = 0; while (cond) { __builtin_amdgcn_s_sleep(1); \
    if ((++_sp & 255u) == 0u) { if (xb_ld(&(bar)[XB_TMO])) break; if (_sp > XB_SPIN_CAP) { atomicAdd(&(bar)[XB_TMO], 1u); break; } } } } while (0)
struct XcdBarrier { unsigned* bar; unsigned x; volatile LAS unsigned* st; };
__device__ __forceinline__ XcdBarrier xcd_barrier_post(unsigned* bar, volatile LAS unsigned* st) {
    XcdBarrier b; b.bar = bar; b.x = xb_xcc_id(); b.st = st;
    if (threadIdx.x == 0) (void)xb_add(&bar[XB_XCNT(b.x)], 1u);
    return b;
}
__device__ __forceinline__ void xcd_barrier_complete(unsigned* bar, unsigned x, unsigned& nloc, unsigned& nx) {
    const unsigned G = gridDim.x * gridDim.y * gridDim.z;
    unsigned sum, cnt, mine, sp = 0u;
    for (;;) {
        sum = 0u; cnt = 0u; mine = 0u;
#pragma unroll
        for (unsigned j = 0; j < 16; ++j) { const unsigned c = xb_ld(&bar[XB_XCNT(j)]); sum += c; cnt += (c > 0u) ? 1u : 0u; mine = (j == x) ? c : mine; }
        if (sum == G) break;
        __builtin_amdgcn_s_sleep(1);
        if ((++sp & 255u) == 0u) { if (xb_ld(&bar[XB_TMO])) break; if (sp > XB_SPIN_CAP) { atomicAdd(&bar[XB_TMO], 1u); break; } }
    }
    nloc = mine > 0u ? mine : 1u; nx = cnt > 0u ? cnt : 1u;
}
__device__ __forceinline__ void xcd_barrier(const XcdBarrier& b) {
    asm volatile("s_waitcnt vmcnt(0)" ::: "memory");
    __syncthreads();
    if (threadIdx.x == 0) {
        unsigned* bar = b.bar;
        __builtin_amdgcn_s_waitcnt(0);
        unsigned nloc = b.st[0], nx = b.st[1];
        if (nloc == 0u) { xcd_barrier_complete(bar, b.x, nloc, nx); b.st[0] = nloc; b.st[1] = nx; }
        const unsigned old = xb_add(&bar[XB_XSUB(b.x)], 1u);
        const unsigned gen = old / nloc;
        if (old + 1u == (gen + 1u) * nloc) {
            __builtin_amdgcn_fence(__ATOMIC_RELEASE, "agent");
            asm volatile("s_waitcnt vmcnt(0)" ::: "memory");
            const unsigned og = xb_add(&bar[XB_TOP], 1u);
            const unsigned tg = og / nx;
            if (og + 1u == (tg + 1u) * nx) xb_add(&bar[XB_TOPGEN], 1u);
            else XB_SPIN(xb_ld(&bar[XB_TOPGEN]) == tg, bar);
            __builtin_amdgcn_fence(__ATOMIC_ACQUIRE, "agent");
            xb_add(&bar[XB_XGEN(b.x)], 1u);
            asm volatile("s_waitcnt vmcnt(0)" ::: "memory");
        } else {
            XB_SPIN(xb_ld(&bar[XB_XGEN(b.x)]) == gen, bar);
            __builtin_amdgcn_fence(__ATOMIC_ACQUIRE, "agent");
            asm volatile("s_waitcnt vmcnt(0)" ::: "memory");
        }
    }
    __syncthreads();
}


struct PanelOrder {
    int ntiles, G, c;
    __device__ void init(int M, int G_, int c_) { ntiles = (M / 256) * 4; G = G_; c = c_; }
    __device__ bool next(int i, pg8::Unit& u) const {
        const int L = i * G + c; if (L >= ntiles) return false;
        if (L < 256) { const int xcd = L & 7, j = L >> 3; u.pm = xcd * 8 + (j >> 2); u.pn = j & 3; }
        else { const int Lc = L - 256; u.pm = 64 + (Lc >> 2); u.pn = Lc & 3; }
        return true;
    }
};
template <bool FINAL>
struct EpiResidNorm {
    static constexpr bool PERM = true;
    const float* xin; bf16_t* X1; float* out;
    const float* mod;
    const float* nw;
    const float* mod_next;
    bf16_t* H;
    float* stat; unsigned* cnt;
    __device__ __forceinline__ void operator()(f32x4 (&acc)[2][2][4][2], const pg8::Unit& u, int wr, int wc, int fr, int fq, LAS unsigned char* lds) const {
        LAS float* P = (LAS float*)(lds + LDS_TOP + 64);
        LAS float* S = P + 1024;
        const int tid = threadIdx.x;
        asm volatile("s_waitcnt vmcnt(0)" ::: "memory"); __syncthreads();
        LAS unsigned char* park = lds + tid * 16;
        float q[2][4];
#pragma unroll
        for (int ai = 0; ai < 2; ++ai) {
            const int r0 = u.pm * 256 + ai * 128;
            const float* gp = mod + (r0 >> 12) * 3072 + 2048;
#pragma unroll
            for (int m = 0; m < 4; ++m) q[ai][m] = 0.f;
#pragma unroll
            for (int bj = 0; bj < 2; ++bj) {
                const int c0 = u.pn * 256 + bj * 128 + wc * 32 + 8 * fq;
                const f32x4 g0 = *(const f32x4*)(gp + c0), g1 = *(const f32x4*)(gp + c0 + 4);
#pragma unroll
                for (int m = 0; m < 4; ++m) {
                    const size_t off = (size_t)(r0 + wr * 64 + m * 16 + fr) * D + c0;
                    f32x4 b0, b1;
                    if (FINAL) { const u32x4 w = *(const u32x4*)(X1 + off); b0 = (f32x4){bf_lo(w.x), bf_hi(w.x), bf_lo(w.y), bf_hi(w.y)}; b1 = (f32x4){bf_lo(w.z), bf_hi(w.z), bf_lo(w.w), bf_hi(w.w)}; }
                    else { b0 = *(const f32x4*)(xin + off); b1 = *(const f32x4*)(xin + off + 4); }
                    const f32x4 x0 = b0 + g0 * acc[ai][bj][m][0], x1 = b1 + g1 * acc[ai][bj][m][1];
                    u32x4 w; w.x = pk2(x0[0], x0[1]); w.y = pk2(x0[2], x0[3]); w.z = pk2(x1[0], x1[1]); w.w = pk2(x1[2], x1[3]);
                    *(LAS u32x4*)(park + ((ai * 2 + bj) * 4 + m) * 8192) = w;
                    if (!FINAL) *(u32x4*)(X1 + off) = w;
                    q[ai][m] += ((x0[0] * x0[0] + x0[1] * x0[1]) + (x0[2] * x0[2] + x0[3] * x0[3])) + ((x1[0] * x1[0] + x1[1] * x1[1]) + (x1[2] * x1[2] + x1[3] * x1[3]));
                }
            }
        }
#pragma unroll
        for (int ai = 0; ai < 2; ++ai)
#pragma unroll
            for (int m = 0; m < 4; ++m) {
                float t = q[ai][m]; t += __shfl_xor(t, 16); t += __shfl_xor(t, 32);
                if (fq == 0) P[(ai * 128 + wr * 64 + m * 16 + fr) * 4 + wc] = t;
            }
        __syncthreads();
        float* st = stat + (size_t)u.pm * 1024;
        if (tid < 256) { const f32x4 p = *(const LAS f32x4*)(P + tid * 4);
            __hip_atomic_store(st + u.pn * 256 + tid, (p[0] + p[1]) + (p[2] + p[3]), __ATOMIC_RELAXED, __HIP_MEMORY_SCOPE_AGENT); }
        asm volatile("s_waitcnt vmcnt(0)" ::: "memory");
        __syncthreads();
        if (tid == 0) {
            __hip_atomic_fetch_add(cnt + 64 * u.pm, 1u, __ATOMIC_RELAXED, __HIP_MEMORY_SCOPE_AGENT);
            unsigned sp = 0;
            while (__hip_atomic_load(cnt + 64 * u.pm, __ATOMIC_RELAXED, __HIP_MEMORY_SCOPE_AGENT) < 4u) { __builtin_amdgcn_s_sleep(1); if (++sp > (1u << 20)) break; }
        }
        __syncthreads();
        if (tid < 256) {
            float t = 0.f;
#pragma unroll
            for (int k = 0; k < 4; ++k) t += __hip_atomic_load(st + k * 256 + tid, __ATOMIC_RELAXED, __HIP_MEMORY_SCOPE_AGENT);
            S[tid] = 1.0f / sqrtf(t * (1.0f / D) + 1e-6f);
        }
        __syncthreads();
#pragma unroll
        for (int ai = 0; ai < 2; ++ai) {
            const int r0 = u.pm * 256 + ai * 128;
            const float* mp = FINAL ? nullptr : mod_next + (r0 >> 12) * 3072;
#pragma unroll
            for (int bj = 0; bj < 2; ++bj) {
                const int c0 = u.pn * 256 + bj * 128 + wc * 32 + 8 * fq;
                f32x4 w0 = *(const f32x4*)(nw + c0), w1 = *(const f32x4*)(nw + c0 + 4), s0, s1;
                if (!FINAL) { w0 = w0 * (*(const f32x4*)(mp + 1024 + c0) + 1.0f); w1 = w1 * (*(const f32x4*)(mp + 1024 + c0 + 4) + 1.0f); s0 = *(const f32x4*)(mp + c0); s1 = *(const f32x4*)(mp + c0 + 4); }
#pragma unroll
                for (int m = 0; m < 4; ++m) {
                    const int rl = ai * 128 + wr * 64 + m * 16 + fr;
                    const float rstd = S[rl];
                    const size_t off = (size_t)(u.pm * 256 + rl) * D + c0;
                    const u32x4 xw = *(const LAS u32x4*)(park + ((ai * 2 + bj) * 4 + m) * 8192);
                    const f32x4 x0 = {bf_lo(xw.x), bf_hi(xw.x), bf_lo(xw.y), bf_hi(xw.y)}, x1 = {bf_lo(xw.z), bf_hi(xw.z), bf_lo(xw.w), bf_hi(xw.w)};
                    if (FINAL) { *(f32x4*)(out + off) = x0 * rstd * w0; *(f32x4*)(out + off + 4) = x1 * rstd * w1; }
                    else { const f32x4 y0 = x0 * rstd * w0 + s0, y1 = x1 * rstd * w1 + s1;
                        u32x4 w; w.x = pk2(y0[0], y0[1]); w.y = pk2(y0[2], y0[3]); w.z = pk2(y1[0], y1[1]); w.w = pk2(y1[2], y1[3]);
                        *(u32x4*)(H + off) = w; }
                }
            }
        }
        __syncthreads();
    }
};

template <class Epi>
__device__ __forceinline__ void gemm64_tile(LAS unsigned char* lds, const bf16_t* A, const bf16_t* Bt, const Epi& E) {
    constexpr int K = 1024, BK = 128, PITCH = BK * 2 + 16, NKT = K / BK;
    const int tid = threadIdx.x, lane = tid & 63, wave = __builtin_amdgcn_readfirstlane(tid >> 6), fr = lane & 15, fq = lane >> 4, wr = wave >> 1, wc = wave & 1;
    LAS unsigned char* As = lds; LAS unsigned char* Bs = lds + 64 * PITCH;
    const int srow = tid >> 4, sch = tid & 15;
    const bf16_t* ga = A + (size_t)srow * K + sch * 8; const bf16_t* gb = Bt + (size_t)srow * K + sch * 8;
    u32x4 ra[2], rb[2];
#pragma unroll
    for (int i = 0; i < 2; ++i) { ra[i] = *(const u32x4*)(ga + (size_t)(32 * i) * K); rb[i] = *(const u32x4*)(gb + (size_t)(32 * i) * K); }
    f32x4 acc[2] = {(f32x4){0.f, 0.f, 0.f, 0.f}, (f32x4){0.f, 0.f, 0.f, 0.f}};
    for (int kt = 0; kt < NKT; ++kt) {
        __syncthreads();
#pragma unroll
        for (int i = 0; i < 2; ++i) { *(LAS u32x4*)(As + (srow + 32 * i) * PITCH + sch * 16) = ra[i]; *(LAS u32x4*)(Bs + (srow + 32 * i) * PITCH + sch * 16) = rb[i]; }
        __syncthreads();
        if (kt + 1 < NKT) {
#pragma unroll
            for (int i = 0; i < 2; ++i) { ra[i] = *(const u32x4*)(ga + (size_t)(32 * i) * K + (kt + 1) * BK); rb[i] = *(const u32x4*)(gb + (size_t)(32 * i) * K + (kt + 1) * BK); }
        }
#pragma unroll
        for (int ks = 0; ks < 4; ++ks) {
            const bf16x8 Af = *(const LAS bf16x8*)(As + (16 * wr + fr) * PITCH + (32 * ks + 8 * fq) * 2);
#pragma unroll
            for (int n = 0; n < 2; ++n) {
                const bf16x8 Bf = *(const LAS bf16x8*)(Bs + (32 * wc + 16 * n + fr) * PITCH + (32 * ks + 8 * fq) * 2);
                acc[n] = __builtin_amdgcn_mfma_f32_16x16x32_bf16(Bf, Af, acc[n], 0, 0, 0);
            }
        }
    }
    __syncthreads();
    E(acc, wr, wc, fr, fq, lds);
}
struct Epi64Bf16 {
    bf16_t* O; int ldc;
    __device__ __forceinline__ void operator()(f32x4 (&acc)[2], int wr, int wc, int fr, int fq, LAS unsigned char* lds) const {
#pragma unroll
        for (int n = 0; n < 2; ++n) { u32x2 w; w.x = pk2(acc[n][0], acc[n][1]); w.y = pk2(acc[n][2], acc[n][3]);
            *(u32x2*)(O + (size_t)(16 * wr + fr) * ldc + 32 * wc + 16 * n + 4 * fq) = w; }
    }
};
struct Epi64ResidNorm {
    const float* base; const float* modc; const float* nw; const float* modc_next; bf16_t* H;
    int col0; float* stat; unsigned* cnt;
    int cb;
    __device__ __forceinline__ void operator()(f32x4 (&acc)[2], int wr, int wc, int fr, int fq, LAS unsigned char* lds) const {
        LAS float* P = (LAS float*)(lds + LDS_TOP + 64);
        LAS float* S = P + 128;
        const int tid = threadIdx.x, row = 16 * wr + fr;
        f32x4 x[2]; float q = 0.f;
#pragma unroll
        for (int n = 0; n < 2; ++n) { const int c = col0 + 32 * wc + 16 * n + 4 * fq;
            x[n] = *(const f32x4*)(base + (size_t)row * D + c) + *(const f32x4*)(modc + 2048 + c) * acc[n];
            q += (x[n][0] * x[n][0] + x[n][1] * x[n][1]) + (x[n][2] * x[n][2] + x[n][3] * x[n][3]); }
        q += __shfl_xor(q, 16); q += __shfl_xor(q, 32);
        if (fq == 0) P[row * 2 + wc] = q;
        __syncthreads();
        if (tid < 64) __hip_atomic_store(stat + cb * 64 + tid, P[tid * 2] + P[tid * 2 + 1], __ATOMIC_RELAXED, __HIP_MEMORY_SCOPE_AGENT);
        asm volatile("s_waitcnt vmcnt(0)" ::: "memory");
        __syncthreads();
        if (tid == 0) {
            __hip_atomic_fetch_add(cnt, 1u, __ATOMIC_RELAXED, __HIP_MEMORY_SCOPE_AGENT);
            unsigned sp = 0;
            while (__hip_atomic_load(cnt, __ATOMIC_RELAXED, __HIP_MEMORY_SCOPE_AGENT) < 16u) { __builtin_amdgcn_s_sleep(1); if (++sp > (1u << 20)) break; }
        }
        __syncthreads();
        if (tid < 64) { float t = 0.f;
#pragma unroll
            for (int k = 0; k < 16; ++k) t += __hip_atomic_load(stat + k * 64 + tid, __ATOMIC_RELAXED, __HIP_MEMORY_SCOPE_AGENT);
            S[tid] = 1.0f / sqrtf(t * (1.0f / D) + 1e-6f); }
        __syncthreads();
        const float rstd = S[row];
#pragma unroll
        for (int n = 0; n < 2; ++n) { const int c = col0 + 32 * wc + 16 * n + 4 * fq;
            const f32x4 y = x[n] * rstd * *(const f32x4*)(nw + c) * (*(const f32x4*)(modc_next + 1024 + c) + 1.0f) + *(const f32x4*)(modc_next + c);
            u32x2 w; w.x = pk2(y[0], y[1]); w.y = pk2(y[2], y[3]);
            *(u32x2*)(H + (size_t)row * D + c) = w; }
        __syncthreads();
    }
};

struct Args {
    const float* in[22];
    float* out;
    unsigned char* ws;
    int ph_lo, ph_hi, pad, pad2;
};

__device__ __forceinline__ void transpose_item(const float* W, int K, int N, bf16_t* WT, int k0, int n0, int dst_row0, LAS float* scr, int lane, bool perm = false) {
    float wv[32];
#pragma unroll
    for (int i = 0; i < 32; ++i) wv[i] = W[(size_t)(k0 + 2 * i + (lane >> 5)) * N + n0 + (lane & 31)];
#pragma unroll
    for (int i = 0; i < 32; ++i) scr[(2 * i + (lane >> 5)) * 33 + (lane & 31)] = wv[i];
    WAVE_LDS_FENCE();
    const int c = lane & 7;
#pragma unroll
    for (int j = 0; j < 4; ++j) { const int n = (lane >> 3) + 8 * j; const LAS float* s = scr + (8 * c) * 33 + n;
        u32x4 o; o.x = pk2(s[0 * 33], s[1 * 33]); o.y = pk2(s[2 * 33], s[3 * 33]); o.z = pk2(s[4 * 33], s[5 * 33]); o.w = pk2(s[6 * 33], s[7 * 33]);
        const int nd = perm ? 8 * ((n & 15) >> 2) + 4 * (n >> 4) + (n & 3) : n;
        *(u32x4*)(WT + (size_t)(dst_row0 + nd) * K + k0 + 8 * c) = o; }
    WAVE_LDS_FENCE();
}

__device__ __forceinline__ void p0_prologue(const Args& a, LAS unsigned char* lds) {
    const int tid = threadIdx.x, lane = tid & 63, wave = tid >> 6, bid = blockIdx.x, G = gridDim.x;
    unsigned char* ws = a.ws;
    if (bid < 192) {
        LAS float* sv = (LAS float*)lds;
        LAS float* red = (LAS float*)(lds + 20480);
        const int layer = bid / 96, n0 = (bid % 96) * 32;
        const int c4 = lane & 7, kk = lane >> 3;
        const float* wp = a.in[5] + (size_t)layer * D * 3072 + (size_t)(wave * 128 + kk) * 3072 + n0 + 4 * c4;
        f32x4 w[16];
#pragma unroll
        for (int i = 0; i < 16; ++i) w[i] = *(const f32x4*)(wp + (size_t)(8 * i) * 3072);
        float cx[10];
#pragma unroll
        for (int j = 0; j < 10; ++j) { const int idx = tid + 512 * j, v = idx >> 10, k = idx & 1023; cx[j] = v < 4 ? a.in[1][v * D + k] : a.in[3][k]; }
#pragma unroll
        for (int j = 0; j < 10; ++j) sv[tid + 512 * j] = cx[j] / (1.0f + expf(-cx[j]));
        __syncthreads();
        f32x4 acc[5];
#pragma unroll
        for (int v = 0; v < 5; ++v) acc[v] = (f32x4){0.f, 0.f, 0.f, 0.f};
#pragma unroll
        for (int i = 0; i < 16; ++i) {
#pragma unroll
            for (int v = 0; v < 5; ++v) acc[v] += w[i] * sv[v * D + wave * 128 + 8 * i + kk];
        }
#pragma unroll
        for (int v = 0; v < 5; ++v)
#pragma unroll
            for (int j = 0; j < 4; ++j) { float t = acc[v][j]; t += __shfl_xor(t, 8); t += __shfl_xor(t, 16); t += __shfl_xor(t, 32); acc[v][j] = t; }
        if (kk == 0) {
#pragma unroll
            for (int v = 0; v < 5; ++v) *(LAS f32x4*)(red + (wave * 5 + v) * 32 + 4 * c4) = acc[v];
        }
        __syncthreads();
        if (tid < 160) { const int v = tid >> 5, c = tid & 31; float t = 0.f;
#pragma unroll
            for (int q = 0; q < 8; ++q) t += red[(q * 5 + v) * 32 + c];
            ((float*)(ws + WS_MOD))[(layer * 5 + v) * 3072 + n0 + c] = t + a.in[6][layer * 3072 + n0 + c]; }
        __syncthreads();
    }
    if (bid >= 192 && bid < 208) {
        const int id = (bid - 192) * 512 + tid;
        const int dg = id >> 6, p = id & 63;
        const float lre = a.in[11][id], lim = a.in[12][id], dt = expf(a.in[13][dg]);
        const float mag = expf(lre * dt), ar = mag * cosf(lim * dt), ai = mag * sinf(lim * dt);
        float pr = ar, pi = ai;
#pragma unroll
        for (int s = 0; s < 6; ++s) { const float nr = pr * pr - pi * pi, ni = 2.f * pr * pi; pr = nr; pi = ni; }
        ((f32x4*)(ws + WS_APOW))[id] = (f32x4){ar, ai, pr, pi};
        const float den = lre * lre + lim * lim, nr_ = ar - 1.0f, ni_ = ai;
        const float cr = (nr_ * lre + ni_ * lim) / den, ci = (ni_ * lre - nr_ * lim) / den;
        bf16_t* Bb = (bf16_t*)(ws + WS_BB) + (size_t)dg * 128 * 16;
        bf16_t* Cm = (bf16_t*)(ws + WS_CM) + (size_t)dg * 16 * 128;
        const float* bre = a.in[14] + (size_t)id * 16; const float* bim = a.in[15] + (size_t)id * 16;
#pragma unroll
        for (int h = 0; h < 16; h += 2) {
            const float r0 = cr * bre[h] - ci * bim[h], i0 = cr * bim[h] + ci * bre[h], r1 = cr * bre[h + 1] - ci * bim[h + 1], i1 = cr * bim[h + 1] + ci * bre[h + 1];
            *(unsigned*)(Bb + (2 * p) * 16 + h) = pk2(r0, r1); *(unsigned*)(Bb + (2 * p + 1) * 16 + h) = pk2(i0, i1);
        }
        const float* cre = a.in[16] + (size_t)dg * 16 * 64; const float* cim = a.in[17] + (size_t)dg * 16 * 64;
#pragma unroll
        for (int h = 0; h < 16; ++h) *(unsigned*)(Cm + h * 128 + 2 * p) = pk2(cre[h * 64 + p], -cim[h * 64 + p]);
    }
    if (bid >= 208 && bid < 210) {
        const int id = (bid - 208) * 512 + tid;
        const int val = id >> 4, f = id & 15;
        const float inv = powf(10000.0f, -(float)f / 16.0f), ang = (float)val * inv;
        float* rp = (float*)(ws + WS_ROPE);
        rp[val * 32 + f] = cosf(ang); rp[val * 32 + 16 + f] = sinf(ang);
    }
    LAS float* scr = (LAS float*)(lds + wave * 16384);
    const int gw = bid * 8 + wave, NGW = G * 8;
    constexpr int I0 = 16 * 80, I1 = 16 * 32;
    for (int it = gw; it < I0 + I1; it += NGW) {
        int r = it;
        if (r < I0) { const int nb = r % 80, kb = r / 80; transpose_item(a.in[7], D, NQKVZ, (bf16_t*)(ws + WS_WQKVZ), kb * 64, nb * 32, nb * 32, scr, lane, nb * 32 < 1280); continue; } r -= I0;
        { const int nb = r % 32, kb = r / 32; transpose_item(a.in[9], D, D, (bf16_t*)(ws + WS_WAO), kb * 64, nb * 32, nb * 32, scr, lane); }
    }
}
__device__ __forceinline__ void p2_late_transposes(const Args& a, LAS unsigned char* lds, int w0) {
    const int tid = threadIdx.x, lane = tid & 63, wave = tid >> 6, bid = blockIdx.x, G = gridDim.x;
    unsigned char* ws = a.ws;
    LAS float* scr = (LAS float*)(lds + wave * 16384);
    const bool all = (w0 <= 0 || w0 >= G);
    if (!all && bid < w0) return;
    const int gw = ((all ? bid : bid - w0) * 8 + wave), NGW = (all ? G : G - w0) * 8;
    constexpr int I2 = 16 * 64, I3 = 16 * 64, I4 = 16 * 32;
    for (int it = gw; it < I2 + I3 + I4; it += NGW) {
        int r = it;
        if (r < I2) { const int nb = r % 64, kb = r / 64; transpose_item(a.in[10], D, NUZ, (bf16_t*)(ws + WS_WSIN), kb * 64, nb * 32, nb * 32, scr, lane); continue; } r -= I2;
        if (r < I3) { const int nb = r % 64, kb = r / 64, n0 = nb * 32; const int dst = 256 * ((n0 & 1023) >> 7) + 128 * (n0 >> 10) + (n0 & 127);
                      transpose_item(a.in[19], D, NUZ, (bf16_t*)(ws + WS_WGLU), kb * 64, n0, dst, scr, lane); continue; } r -= I3;
        { const int nb = r % 32, kb = r / 32; transpose_item(a.in[20], D, D, (bf16_t*)(ws + WS_WSOUT), kb * 64, nb * 32, nb * 32, scr, lane); }
    }
}

__device__ __forceinline__ const float* norm_src(const float* xlat, const float* xctx, int r) { return r < NLAT ? xlat + (size_t)r * D : xctx + (size_t)(r - NLAT) * D; }
__device__ __forceinline__ void norm_mod_phase(const float* xlat, const float* xctx, const float* nw, const float* mod, bf16_t* H) {
    const int lane = threadIdx.x & 63, gw = blockIdx.x * 8 + (threadIdx.x >> 6), NGW = gridDim.x * 8;
    f32x4 w4[4];
#pragma unroll
    for (int j = 0; j < 4; ++j) w4[j] = ((const f32x4*)nw)[lane + 64 * j];
    const int per = NLAT / NGW;
    const int nrows = per + ((gw < NCTX && NGW >= NCTX) ? 1 : 0);
    if (NLAT % NGW != 0 || NGW < NCTX) {
        for (int r = gw; r < MTOT; r += NGW) {
            const float* xr = norm_src(xlat, xctx, r); const float* mp = mod + (r < NLAT ? (r >> 12) : 4) * 3072;
            f32x4 v[4]; float s = 0.f;
#pragma unroll
            for (int j = 0; j < 4; ++j) { v[j] = ((const f32x4*)xr)[lane + 64 * j]; s += (v[j].x * v[j].x + v[j].y * v[j].y) + (v[j].z * v[j].z + v[j].w * v[j].w); }
            const float rstd = 1.0f / sqrtf(wave_sum(s) * (1.0f / D) + 1e-6f);
            unsigned long long* o8 = (unsigned long long*)(H + (size_t)r * D) + lane;
#pragma unroll
            for (int j = 0; j < 4; ++j) { const f32x4 sh = ((const f32x4*)mp)[lane + 64 * j], sc = ((const f32x4*)(mp + 1024))[lane + 64 * j];
                const f32x4 y = v[j] * rstd * w4[j] * (sc + 1.0f) + sh; o8[64 * j] = (unsigned long long)pk2(y.x, y.y) | ((unsigned long long)pk2(y.z, y.w) << 32); }
        }
        return;
    }
    const int r0 = gw * per;
    f32x4 g4[4], sh4[4];
    { const float* mp = mod + (r0 >> 12) * 3072;
#pragma unroll
      for (int j = 0; j < 4; ++j) { g4[j] = w4[j] * (((const f32x4*)(mp + 1024))[lane + 64 * j] + 1.0f); sh4[j] = ((const f32x4*)mp)[lane + 64 * j]; } }
    f32x4 nx[4];
#pragma unroll
    for (int j = 0; j < 4; ++j) nx[j] = ((const f32x4*)(xlat + (size_t)r0 * D))[lane + 64 * j];
    for (int k = 0; k < nrows; ++k) {
        const bool isc = k == per;
        const int r = isc ? NLAT + gw : r0 + k;
        f32x4 v[4];
#pragma unroll
        for (int j = 0; j < 4; ++j) v[j] = nx[j];
        if (k + 1 < nrows) { const float* xr = (k + 1 == per) ? xctx + (size_t)gw * D : xlat + (size_t)(r0 + k + 1) * D;
#pragma unroll
            for (int j = 0; j < 4; ++j) nx[j] = ((const f32x4*)xr)[lane + 64 * j]; }
        if (isc) { const float* mp = mod + 4 * 3072;
#pragma unroll
            for (int j = 0; j < 4; ++j) { g4[j] = w4[j] * (((const f32x4*)(mp + 1024))[lane + 64 * j] + 1.0f); sh4[j] = ((const f32x4*)mp)[lane + 64 * j]; } }
        float s = 0.f;
#pragma unroll
        for (int j = 0; j < 4; ++j) s += (v[j].x * v[j].x + v[j].y * v[j].y) + (v[j].z * v[j].z + v[j].w * v[j].w);
        const float rstd = 1.0f / sqrtf(wave_sum(s) * (1.0f / D) + 1e-6f);
        unsigned long long* o8 = (unsigned long long*)(H + (size_t)r * D) + lane;
#pragma unroll
        for (int j = 0; j < 4; ++j) {
            const f32x4 y = v[j] * rstd * g4[j] + sh4[j];
            o8[64 * j] = (unsigned long long)pk2(y.x, y.y) | ((unsigned long long)pk2(y.z, y.w) << 32);
        }
    }
}
__device__ __forceinline__ void final_norm_phase(float* out, const float* nw) {
    const int lane = threadIdx.x & 63, gw = blockIdx.x * 8 + (threadIdx.x >> 6), NGW = gridDim.x * 8;
    f32x4 w4[4];
#pragma unroll
    for (int j = 0; j < 4; ++j) w4[j] = ((const f32x4*)nw)[lane + 64 * j];
    f32x4 nx[4];
#pragma unroll
    for (int j = 0; j < 4; ++j) nx[j] = ((const f32x4*)(out + (size_t)gw * D))[lane + 64 * j];
    for (int r = gw; r < NLAT; r += NGW) {
        f32x4* xr = (f32x4*)(out + (size_t)r * D);
        f32x4 v[4]; float s = 0.f;
#pragma unroll
        for (int j = 0; j < 4; ++j) v[j] = nx[j];
        if (r + NGW < NLAT) {
#pragma unroll
            for (int j = 0; j < 4; ++j) nx[j] = ((const f32x4*)(out + (size_t)(r + NGW) * D))[lane + 64 * j]; }
#pragma unroll
        for (int j = 0; j < 4; ++j) s += (v[j].x * v[j].x + v[j].y * v[j].y) + (v[j].z * v[j].z + v[j].w * v[j].w);
        const float rstd = 1.0f / sqrtf(wave_sum(s) * (1.0f / D) + 1e-6f);
#pragma unroll
        for (int j = 0; j < 4; ++j) xr[lane + 64 * j] = v[j] * rstd * w4[j];
    }
}

constexpr int KS_PITCH = 144, VT_PITCH = 264, VT_OFF = 128 * KS_PITCH;
constexpr int ATT_BUF = 36864;
constexpr float ATT_THR = 8.0f;
#define MFMA32(a, b, c) __builtin_amdgcn_mfma_f32_32x32x16_bf16((a), (b), (c), 0, 0, 0)
__device__ __forceinline__ void attn_phase(LAS unsigned char* lds, const bf16_t* QKVZ, bf16_t* AO, const float* sink) {
    const int tid = threadIdx.x, lane = tid & 63, wave = __builtin_amdgcn_readfirstlane(tid >> 6);
    const int ql = lane & 31, hh = lane >> 5, hq = wave & 3, qh = wave >> 2;
    int pb = 0;
    const bool bal = gridDim.x == 256;
    const int bi = blockIdx.x;
    int ctx_it = -1;
    { const int m = bi & 127, h = bi >> 7;
      if (m < 4) ctx_it = h * 4 + m; else if (m >= 124) ctx_it = 8 + h * 4 + (m - 124); else if (m >= 116) ctx_it = 16 + h * 8 + (m - 116); }
    const int nit = bal ? (ctx_it >= 0 ? 3 : 2) : (544 - bi + (int)gridDim.x - 1) / (int)gridDim.x;
#define ATT_ITEM(kk) (bal ? ((kk) == 0 ? bi : ((kk) == 1 ? 256 + ((bi + 8) & 255) : 512 + ctx_it)) : bi + (kk) * (int)gridDim.x)
#define ATT_QROW0(it) ((it) < 512 ? ((it) >> 7) * SEQ + (((it) >> 2) & 31) * 128 : NLAT + (((it) - 512) >> 3) * CTXL + ((((it) - 512) >> 2) & 1) * 128)
#define ATT_LOADQ(Q, it) do { const int qr0_ = ATT_QROW0(it), hd_ = ((it) & 3) * 4 + hq; _Pragma("unroll") for (int qt = 0; qt < 2; ++qt) _Pragma("unroll") for (int ks = 0; ks < 4; ++ks) \
        Q[qt][ks] = *(const bf16x8*)(QKVZ + (size_t)(qr0_ + 64 * qh + 32 * qt + ql) * NQKVZ + hd_ * 64 + 16 * ks + 8 * hh); } while (0)
#define ATT_LOADKV0(it) do { const bool ic_ = (it) >= 512; const int b_ = ic_ ? ((it) - 512) >> 3 : (it) >> 7, nb_ = ((it) >> 2) & 31, kh_ = (it) & 3; \
        const int kr0_ = ic_ ? NLAT + b_ * CTXL : b_ * SEQ + (nb_ == 0 ? 0 : nb_ - 1) * 128; \
        _Pragma("unroll") for (int i = 0; i < 2; ++i) { const int c = tid + 512 * i, key = c >> 3, dc = c & 7; kr[i] = *(const u32x4*)(QKVZ + (size_t)(kr0_ + key) * NQKVZ + 1024 + kh_ * 64 + dc * 8); } \
        va = *(const u32x4*)(QKVZ + (size_t)(kr0_ + 2 * kp) * NQKVZ + 1280 + kh_ * 64 + dcv * 8); \
        vb = *(const u32x4*)(QKVZ + (size_t)(kr0_ + 2 * kp + 1) * NQKVZ + 1280 + kh_ * 64 + dcv * 8); } while (0)
    const int kp = tid & 63, dcv = tid >> 6;
    u32x4 kr[2], va, vb;
    bf16x8 Qn[2][4];
    if (nit > 0) { ATT_LOADQ(Qn, ATT_ITEM(0)); ATT_LOADKV0(ATT_ITEM(0)); }
    for (int k = 0; k < nit; ++k) {
        const int item = ATT_ITEM(k);
        int b, kh, qrow0, nblk; bool isctx;
        if (item < 512) { b = item >> 7; nblk = (item >> 2) & 31; kh = item & 3; qrow0 = b * SEQ + nblk * 128; isctx = false; }
        else { const int r = item - 512; b = r >> 3; kh = r & 3; qrow0 = NLAT + b * CTXL + ((r >> 2) & 1) * 128; isctx = true; nblk = 0; }
        const int head = kh * 4 + hq;
        bf16x8 Qf[2][4];
#pragma unroll
        for (int qt = 0; qt < 2; ++qt)
#pragma unroll
            for (int ks = 0; ks < 4; ++ks) Qf[qt][ks] = Qn[qt][ks];
        f32x16 O[2][2];
#pragma unroll
        for (int dt = 0; dt < 2; ++dt)
#pragma unroll
            for (int qt = 0; qt < 2; ++qt)
#pragma unroll
                for (int i = 0; i < 16; ++i) O[dt][qt][i] = 0.f;
        const float sk = sink[head] * LOG2E;
        float m_[2] = {sk, sk}, l_[2]; l_[0] = l_[1] = (hh == 0) ? 1.0f : 0.0f;
        const int ntiles = isctx ? 2 : 5;
        int tcur = (!isctx && nblk == 0) ? 1 : 0;
        while (tcur < ntiles) {
            const int mode = (!isctx && tcur == 0) ? 1 : ((!isctx && tcur == 2) ? 2 : 0);
            LAS unsigned char* Ks = lds + pb * ATT_BUF; LAS unsigned char* Vt = Ks + VT_OFF; pb ^= 1;
            {
#pragma unroll
                for (int i = 0; i < 2; ++i) { const int c = tid + 512 * i, key = c >> 3, dc = c & 7; *(LAS u32x4*)(Ks + key * KS_PITCH + dc * 16) = kr[i]; }
                LAS unsigned char* vp = Vt + (dcv * 8) * VT_PITCH + kp * 4;
#pragma unroll
                for (int e = 0; e < 4; ++e) {
                    const unsigned wa = va[e], wb = vb[e];
                    *(LAS unsigned*)(vp + (2 * e) * VT_PITCH) = (wa & 0xffffu) | (wb << 16);
                    *(LAS unsigned*)(vp + (2 * e + 1) * VT_PITCH) = (wa >> 16) | (wb & 0xffff0000u);
                }
            }
            __syncthreads();
            int tnext = tcur + 1; if (!isctx && tnext == 2 && nblk == 31) tnext = 3;
            if (tnext < ntiles) {
                const int krow0 = isctx ? NLAT + b * CTXL + tnext * 128 : (tnext < 3 ? b * SEQ + (nblk - 1 + tnext) * 128 : NLAT + b * CTXL + (tnext - 3) * 128);
#pragma unroll
                for (int i = 0; i < 2; ++i) { const int c = tid + 512 * i, key = c >> 3, dc = c & 7; kr[i] = *(const u32x4*)(QKVZ + (size_t)(krow0 + key) * NQKVZ + 1024 + kh * 64 + dc * 8); }
                va = *(const u32x4*)(QKVZ + (size_t)(krow0 + 2 * kp) * NQKVZ + 1280 + kh * 64 + dcv * 8);
                vb = *(const u32x4*)(QKVZ + (size_t)(krow0 + 2 * kp + 1) * NQKVZ + 1280 + kh * 64 + dcv * 8);
            }
            tcur = tnext;
#pragma unroll 1
            for (int sub = 0; sub < 2; ++sub) {
                if ((mode == 1 && sub < qh) || (mode == 2 && sub > qh)) continue;
                f32x16 S[2][2];
#pragma unroll
                for (int kt = 0; kt < 2; ++kt)
#pragma unroll
                    for (int qt = 0; qt < 2; ++qt)
#pragma unroll
                        for (int i = 0; i < 16; ++i) S[kt][qt][i] = -m_[qt];
#pragma unroll
                for (int kt = 0; kt < 2; ++kt)
#pragma unroll
                    for (int ks = 0; ks < 4; ++ks) {
                        const bf16x8 Kf = *(const LAS bf16x8*)(Ks + (64 * sub + 32 * kt + ql) * KS_PITCH + (16 * ks + 8 * hh) * 2);
                        S[kt][0] = MFMA32(Kf, Qf[0][ks], S[kt][0]);
                        S[kt][1] = MFMA32(Kf, Qf[1][ks], S[kt][1]);
                    }
                if (mode) {
#pragma unroll
                    for (int kt = 0; kt < 2; ++kt)
#pragma unroll
                        for (int qt = 0; qt < 2; ++qt)
#pragma unroll
                            for (int i = 0; i < 16; ++i) {
                                const int j = 64 * sub + 32 * kt + 8 * (i >> 2) + 4 * hh + (i & 3), iq = 64 * qh + 32 * qt + ql;
                                const bool valid = (mode == 1) ? (j >= iq) : (j <= iq);
                                S[kt][qt][i] = valid ? S[kt][qt][i] : -1e30f;
                            }
                }
#pragma unroll
                for (int qt = 0; qt < 2; ++qt) {
                    float mx = S[0][qt][0];
#pragma unroll
                    for (int kt = 0; kt < 2; ++kt)
#pragma unroll
                        for (int i = 0; i < 16; ++i) mx = fmaxf(mx, S[kt][qt][i]);
                    { const auto rr = __builtin_amdgcn_permlane32_swap(__float_as_uint(mx), __float_as_uint(mx), false, false);
                      mx = fmaxf(__uint_as_float(rr[0]), __uint_as_float(rr[1])); }
                    float alpha = 1.0f;
                    if (!__builtin_expect(__all(mx <= ATT_THR), 1)) {
                        const float dlt = fmaxf(mx, 0.0f);
                        alpha = fast_exp2(-dlt); m_[qt] += dlt;
#pragma unroll
                        for (int i = 0; i < 16; ++i) { O[0][qt][i] *= alpha; O[1][qt][i] *= alpha; }
#pragma unroll
                        for (int kt = 0; kt < 2; ++kt)
#pragma unroll
                            for (int i = 0; i < 16; ++i) S[kt][qt][i] -= dlt;
                    }
                    float rs = 0.f;
#pragma unroll
                    for (int kt = 0; kt < 2; ++kt)
#pragma unroll
                        for (int i = 0; i < 16; ++i) { const float p = fast_exp2(S[kt][qt][i]); S[kt][qt][i] = p; rs += p; }
                    l_[qt] = l_[qt] * alpha + rs;
                }
#pragma unroll
                for (int kt = 0; kt < 2; ++kt)
#pragma unroll
                    for (int s2 = 0; s2 < 2; ++s2) {
                        bf16x8 Pf[2];
#pragma unroll
                        for (int qt = 0; qt < 2; ++qt) {
                            u32x4 w; w.x = pk2(S[kt][qt][8 * s2 + 0], S[kt][qt][8 * s2 + 1]); w.y = pk2(S[kt][qt][8 * s2 + 2], S[kt][qt][8 * s2 + 3]);
                            w.z = pk2(S[kt][qt][8 * s2 + 4], S[kt][qt][8 * s2 + 5]); w.w = pk2(S[kt][qt][8 * s2 + 6], S[kt][qt][8 * s2 + 7]);
                            Pf[qt] = __builtin_bit_cast(bf16x8, w);
                        }
#pragma unroll
                        for (int dt = 0; dt < 2; ++dt) {
                            const LAS unsigned char* ap = Vt + (32 * dt + ql) * VT_PITCH + (64 * sub + 32 * kt + 16 * s2 + 4 * hh) * 2;
                            const u32x2 lo = *(const LAS u32x2*)ap, hi = *(const LAS u32x2*)(ap + 16);
                            u32x4 w; w.x = lo.x; w.y = lo.y; w.z = hi.x; w.w = hi.y;
                            const bf16x8 Vf = __builtin_bit_cast(bf16x8, w);
                            O[dt][0] = MFMA32(Vf, Pf[0], O[dt][0]);
                            O[dt][1] = MFMA32(Vf, Pf[1], O[dt][1]);
                        }
                    }
            }
        }
        LAS unsigned char* wsc = lds + 2 * ATT_BUF + wave * 9216;
        const int er = lane >> 3, ec = lane & 7;
        u32x4 zt[8];
#pragma unroll
        for (int it = 0; it < 8; ++it) zt[it] = *(const u32x4*)(QKVZ + (size_t)(qrow0 + 64 * qh + er + 8 * it) * NQKVZ + 1536 + head * 64 + 8 * ec);
        if (k + 1 < nit) { ATT_LOADQ(Qn, ATT_ITEM(k + 1)); ATT_LOADKV0(ATT_ITEM(k + 1)); }
#pragma unroll
        for (int it = 0; it < 8; ++it) *(LAS u32x4*)(wsc + (er + 8 * it) * 144 + ec * 16) = zt[it];
        WAVE_LDS_FENCE();
#pragma unroll
        for (int qt = 0; qt < 2; ++qt) {
            const auto lr_ = __builtin_amdgcn_permlane32_swap(__float_as_uint(l_[qt]), __float_as_uint(l_[qt]), false, false);
            const float lt = __uint_as_float(lr_[0]) + __uint_as_float(lr_[1]), inv = 1.0f / lt;
#pragma unroll
            for (int dt = 0; dt < 2; ++dt)
#pragma unroll
                for (int a4 = 0; a4 < 4; ++a4) {
                    LAS u32x2* slot = (LAS u32x2*)(wsc + (32 * qt + ql) * 144 + (32 * dt + 8 * a4 + 4 * hh) * 2);
                    const u32x2 zw = *slot;
                    const float o0 = O[dt][qt][4 * a4 + 0] * inv * silu_f(bf_lo(zw.x)), o1 = O[dt][qt][4 * a4 + 1] * inv * silu_f(bf_hi(zw.x));
                    const float o2 = O[dt][qt][4 * a4 + 2] * inv * silu_f(bf_lo(zw.y)), o3 = O[dt][qt][4 * a4 + 3] * inv * silu_f(bf_hi(zw.y));
                    u32x2 w; w.x = pk2(o0, o1); w.y = pk2(o2, o3);
                    *slot = w;
                }
        }
        WAVE_LDS_FENCE();
#pragma unroll
        for (int it = 0; it < 8; ++it) *(u32x4*)(AO + (size_t)(qrow0 + 64 * qh + er + 8 * it) * D + head * 64 + 8 * ec) = *(const LAS u32x4*)(wsc + (er + 8 * it) * 144 + ec * 16);
        WAVE_LDS_FENCE();
    }
    __syncthreads();
}

constexpr int BU_PITCH = 132;
constexpr int XB_PITCH = 272;
template <bool OUT>
__device__ __forceinline__ void s5_chunk(LAS unsigned char* wl, const bf16x4 (&Uf)[4], const bf16x4 (&Bf)[8], const bf16x8 (&Cf)[4],
                                         float ar, float ai, float& xr, float& xi, int dir, f32x4 (&accY)[4], int lane) {
    LAS float* bu = (LAS float*)wl;
    LAS unsigned char* xb = wl + 16 * BU_PITCH * 4;
    const int fr = lane & 15, fq = lane >> 4;
#pragma unroll
    for (int mm = 0; mm < 4; ++mm) {
        const int m = dir ? 3 - mm : mm;
#pragma unroll
        for (int nt = 0; nt < 8; ++nt) {
            f32x4 c = {0.f, 0.f, 0.f, 0.f};
            c = __builtin_amdgcn_mfma_f32_16x16x16bf16_1k(m == 0 ? Uf[0] : m == 1 ? Uf[1] : m == 2 ? Uf[2] : Uf[3], Bf[nt], c, 0, 0, 0);
#pragma unroll
            for (int i = 0; i < 4; ++i) bu[(4 * fq + i) * BU_PITCH + 16 * nt + fr] = c[i];
        }
        WAVE_LDS_FENCE();
#pragma unroll
        for (int rr = 0; rr < 16; ++rr) {
            const int r = dir ? 15 - rr : rr;
            const f32x2 bb = *(const LAS f32x2*)(bu + r * BU_PITCH + 2 * lane);
            const float nr = fmaf(ar, xr, fmaf(-ai, xi, bb.x)), ni = fmaf(ar, xi, fmaf(ai, xr, bb.y));
            xr = nr; xi = ni;
            if (OUT) *(LAS unsigned*)(xb + r * XB_PITCH + lane * 4) = pk2(nr, ni);
        }
        if (OUT) {
            WAVE_LDS_FENCE();
            f32x4 y = (m == 0 ? accY[0] : m == 1 ? accY[1] : m == 2 ? accY[2] : accY[3]);
#pragma unroll
            for (int ks = 0; ks < 4; ++ks) {
                const bf16x8 Xf = *(const LAS bf16x8*)(xb + fr * XB_PITCH + (8 * fq + 32 * ks) * 2);
                y = __builtin_amdgcn_mfma_f32_16x16x32_bf16(Cf[ks], Xf, y, 0, 0, 0);
            }
            if (m == 0) accY[0] = y; else if (m == 1) accY[1] = y; else if (m == 2) accY[2] = y; else accY[3] = y;
        }
    }
}
__device__ __forceinline__ int chunk_rowbase(int b, int dir, int c) {
    if (dir == 0) return c < 4 ? NLAT + b * CTXL + 64 * c : b * SEQ + 64 * (c - 4);
    return c < 4 ? NLAT + b * CTXL + 64 * (3 - c) : b * SEQ + 64 * (63 - (c - 4));
}
__device__ __forceinline__ void load_uf(bf16x4 (&Uf)[4], const bf16_t* UZ, int rowbase, int g, int lane) {
#pragma unroll
    for (int m = 0; m < 4; ++m) Uf[m] = *(const bf16x4*)(UZ + (size_t)(rowbase + 16 * m + (lane & 15)) * NUZ + 16 * g + 4 * (lane >> 4));
}
__device__ __forceinline__ void cmul(float& xr, float& xi, float ar, float ai) { const float nr = xr * ar - xi * ai, ni = xr * ai + xi * ar; xr = nr; xi = ni; }
__device__ __forceinline__ bf16x4 cscale_bf(const bf16x4 re, const bf16x4 im, float wr, float wi, bool want_im) {
    bf16x4 o;
#pragma unroll
    for (int k = 0; k < 4; k += 2) {
        const float r0 = __uint_as_float((unsigned)(unsigned short)re[k] << 16), r1 = __uint_as_float((unsigned)(unsigned short)re[k + 1] << 16);
        const float i0 = __uint_as_float((unsigned)(unsigned short)im[k] << 16), i1 = __uint_as_float((unsigned)(unsigned short)im[k + 1] << 16);
        const unsigned w = want_im ? pk2(wr * i0 + wi * r0, wr * i1 + wi * r1) : pk2(wr * r0 - wi * i0, wr * r1 - wi * i1);
        o[k] = (short)(w & 0xffffu); o[k + 1] = (short)(w >> 16);
    }
    return o;
}
template <int DIR>
__device__ __forceinline__ void s5_local_dir(const bf16_t* UZ, unsigned char* ws, int gw, int NGW, int lane) {
    float* E = (float*)(ws + WS_E);
    const int pair = gw & 127, g = pair & 63, fr = lane & 15, fq = lane >> 4;
    const bf16_t* Bb = (const bf16_t*)(ws + WS_BB) + (size_t)pair * 128 * 16;
    bf16x4 Bre[4][4], Bim[4][4]; float a1r[4], a1i[4], a64r[4], a64i[4], wr_[4], wi_[4];
#pragma unroll
    for (int t = 0; t < 4; ++t) {
        const int p = 16 * t + fr;
        const bf16x4 b_re = *(const bf16x4*)(Bb + (2 * p) * 16 + 4 * fq), b_im = *(const bf16x4*)(Bb + (2 * p + 1) * 16 + 4 * fq);
        const f32x4 ap = ((const f32x4*)(ws + WS_APOW))[pair * 64 + p];
        const float ar = ap.x, ai = ap.y;
        float r2 = ar, i2 = ai; cmul(r2, i2, ar, ai);
        float r4 = r2, i4 = i2; cmul(r4, i4, r2, i2);
        float r8 = r4, i8 = i4; cmul(r8, i8, r4, i4);
        float r12 = r8, i12 = i8; cmul(r12, i12, r4, i4);
        float r16 = r8, i16 = i8; cmul(r16, i16, r8, i8);
        float r32 = r16, i32 = i16; cmul(r32, i32, r16, i16);
        float r48 = r32, i48 = i32; cmul(r48, i48, r16, i16);
        a1r[t] = ar; a1i[t] = ai; a64r[t] = ap.z; a64i[t] = ap.w;
        const int e = DIR ? fq : 3 - fq;
        wr_[t] = e == 0 ? 1.f : e == 1 ? r4 : e == 2 ? r8 : r12; wi_[t] = e == 0 ? 0.f : e == 1 ? i4 : e == 2 ? i8 : i12;
#pragma unroll
        for (int m = 0; m < 4; ++m) {
            const int em = DIR ? m : 3 - m;
            const float pr = em == 0 ? 1.f : em == 1 ? r16 : em == 2 ? r32 : r48, pi = em == 0 ? 0.f : em == 1 ? i16 : em == 2 ? i32 : i48;
            Bre[m][t] = cscale_bf(b_re, b_im, pr, pi, false); Bim[m][t] = cscale_bf(b_re, b_im, pr, pi, true);
        }
    }
    const int qd = gw >> 7, b = qd >> 2, q = qd & 3;
    if (qd >= 16) return;
    const int c0 = 17 * q, c1 = q < 3 ? c0 + 17 : 67;
    float Rr[4] = {0.f, 0.f, 0.f, 0.f}, Ri[4] = {0.f, 0.f, 0.f, 0.f};
    float* ebase = E + ((size_t)((b * 2 + DIR) * 64 + g) * NCHUNK) * 128;
    bf16x4 Un[4];
    load_uf(Un, UZ, chunk_rowbase(b, DIR, c0), g, lane);
    for (int c = c0; c < c1; ++c) {
        bf16x4 Uf[4];
#pragma unroll
        for (int m = 0; m < 4; ++m) Uf[m] = Un[m];
        if (c + 1 < c1) load_uf(Un, UZ, chunk_rowbase(b, DIR, c + 1), g, lane);
        float* e = ebase + (size_t)c * 128;
#pragma unroll
        for (int t = 0; t < 4; ++t) {
            f32x4 cr = {0.f, 0.f, 0.f, 0.f}, ci = {0.f, 0.f, 0.f, 0.f};
#pragma unroll
            for (int m = 0; m < 4; ++m) {
                cr = __builtin_amdgcn_mfma_f32_16x16x16bf16_1k(Uf[m], Bre[m][t], cr, 0, 0, 0);
                ci = __builtin_amdgcn_mfma_f32_16x16x16bf16_1k(Uf[m], Bim[m][t], ci, 0, 0, 0);
            }
            f32x2 s2 = {DIR ? cr[3] : cr[0], DIR ? ci[3] : ci[0]};
#pragma unroll
            for (int ii = 1; ii < 4; ++ii) { const int i = DIR ? 3 - ii : ii;
                s2 = cmac(s2, (f32x2){a1r[t], a1r[t]}, (f32x2){-a1i[t], a1i[t]}, (f32x2){cr[i], ci[i]}); }
            s2 = cmac(s2, (f32x2){wr_[t], wr_[t]}, (f32x2){-wi_[t], wi_[t]}, (f32x2){0.f, 0.f});
            float sr = s2.x, si = s2.y;
            sr += __shfl_xor(sr, 16); si += __shfl_xor(si, 16); sr += __shfl_xor(sr, 32); si += __shfl_xor(si, 32);
            if (fq == 0) { e[16 * t + fr] = Rr[t]; e[64 + 16 * t + fr] = Ri[t]; }
            const float nr = fmaf(a64r[t], Rr[t], fmaf(-a64i[t], Ri[t], sr)), ni = fmaf(a64r[t], Ri[t], fmaf(a64i[t], Rr[t], si)); Rr[t] = nr; Ri[t] = ni;
        }
    }
    float* fin = q < 3 ? (float*)(ws + WS_QE) + ((size_t)((b * 2 + DIR) * 64 + g) * 3 + q) * 128 : ebase + (size_t)67 * 128;
    if (fq == 0) {
#pragma unroll
        for (int t = 0; t < 4; ++t) { fin[16 * t + fr] = Rr[t]; fin[64 + 16 * t + fr] = Ri[t]; }
    }
}
__device__ __forceinline__ void s5_local_phase(LAS unsigned char* lds, const bf16_t* UZ, unsigned char* ws) {
    const int lane = threadIdx.x & 63, wave = __builtin_amdgcn_readfirstlane(threadIdx.x >> 6);
    const int gw = blockIdx.x * 8 + wave, NGW = gridDim.x * 8;
    if ((gw & 127) >> 6) s5_local_dir<1>(UZ, ws, gw, NGW, lane); else s5_local_dir<0>(UZ, ws, gw, NGW, lane);
}
__device__ __forceinline__ void s5_carry_phase(unsigned char* ws) {
    const int gt = blockIdx.x * 128 + (threadIdx.x & 127);
    if (threadIdx.x >= 128 || gt >= NB * 2 * 64 * 64) return;
    const int p = gt & 63, g = (gt >> 6) & 63, bd = gt >> 12, dir = bd & 1;
    const f32x4 ap = ((const f32x4*)(ws + WS_APOW))[(dir * 64 + g) * 64 + p];
    float* e = (float*)(ws + WS_E) + ((size_t)(bd * 64 + g) * NCHUNK) * 128 + p;
    float er[NCHUNK - 1], ei[NCHUNK - 1];
#pragma unroll
    for (int c = 0; c < NCHUNK - 1; ++c) { er[c] = e[c * 128]; ei[c] = e[c * 128 + 64]; }
    float xr = 0.f, xi = 0.f;
#pragma unroll
    for (int c = 0; c < NCHUNK - 1; ++c) {
        const float nr = ap.z * xr - ap.w * xi + er[c], ni = ap.z * xi + ap.w * xr + ei[c];
        er[c] = xr; ei[c] = xi; xr = nr; xi = ni;
    }
#pragma unroll
    for (int c = 0; c < NCHUNK - 1; ++c) { e[c * 128] = er[c]; e[c * 128 + 64] = ei[c]; }
    e[(NCHUNK - 1) * 128] = xr; e[(NCHUNK - 1) * 128 + 64] = xi;
}
__device__ __forceinline__ f32x2 s5_carry(const f32x2 pre, const f32x2 (&qe)[3], const f32x4 ap, int c) {
    const int q = c / 17, k = c - 17 * q;
    if (q == 0) return pre;
    float A1r = ap.z, A1i = ap.w;
    float A2r = A1r, A2i = A1i; cmul(A2r, A2i, A1r, A1i);
    float A4r = A2r, A4i = A2i; cmul(A4r, A4i, A2r, A2i);
    float A8r = A4r, A8i = A4i; cmul(A8r, A8i, A4r, A4i);
    float A16r = A8r, A16i = A8i; cmul(A16r, A16i, A8r, A8i);
    float A17r = A16r, A17i = A16i; cmul(A17r, A17i, A1r, A1i);
    float sr = qe[0].x, si = qe[0].y;
    if (q >= 2) { cmul(sr, si, A17r, A17i); sr += qe[1].x; si += qe[1].y; }
    if (q >= 3) { cmul(sr, si, A17r, A17i); sr += qe[2].x; si += qe[2].y; }
    if (k & 1) cmul(sr, si, A1r, A1i);
    if (k & 2) cmul(sr, si, A2r, A2i);
    if (k & 4) cmul(sr, si, A4r, A4i);
    if (k & 8) cmul(sr, si, A8r, A8i);
    if (k & 16) cmul(sr, si, A16r, A16i);
    return (f32x2){pre.x + sr, pre.y + si};
}
constexpr int BUT_BYTES = 64 * 80, XB_BYTES = 16 * XB_PITCH;
__device__ __forceinline__ float bf_at(const u32x4& lo, const u32x4& hi, int r) { const unsigned w = (r < 8 ? lo : hi)[(r & 7) >> 1]; return (r & 1) ? bf_hi(w) : bf_lo(w); }
__device__ __forceinline__ void s5_out_phase(LAS unsigned char* lds, const bf16_t* UZ, const unsigned char* ws, const float* dskip, bf16_t* YG) {
    const int lane = threadIdx.x & 63, wave = __builtin_amdgcn_readfirstlane(threadIdx.x >> 6);
    LAS unsigned char* wl = lds + wave * S5_WAVE_LDS;
    const int gw = blockIdx.x * 8 + wave, NGW = gridDim.x * 8;
    const float* E = (const float*)(ws + WS_E);
    const int g = gw & 63, fr = lane & 15, fq = lane >> 4;
    const f32x4 dsk = *(const f32x4*)(dskip + 16 * g + 4 * fq);
    bf16x4 Bf[2][8]; bf16x8 Cf[2][4]; f32x4 ap[2];
#pragma unroll
    for (int dir = 0; dir < 2; ++dir) {
        const int pair = dir * 64 + g;
        const bf16_t* Bb = (const bf16_t*)(ws + WS_BB) + (size_t)pair * 128 * 16;
        const bf16_t* Cm = (const bf16_t*)(ws + WS_CM) + (size_t)pair * 16 * 128;
#pragma unroll
        for (int nt = 0; nt < 8; ++nt) Bf[dir][nt] = *(const bf16x4*)(Bb + (16 * nt + fr) * 16 + 4 * fq);
#pragma unroll
        for (int ks = 0; ks < 4; ++ks) Cf[dir][ks] = *(const bf16x8*)(Cm + fr * 128 + 8 * fq + 32 * ks);
        ap[dir] = ((const f32x4*)(ws + WS_APOW))[pair * 64 + lane];
    }
    const int wofs = (fr >> 1) * 80 + (fr & 1) * 32 + 8 * fq;
    const int sstep = NGW >> 6;
    const float* QE = (const float*)(ws + WS_QE);
    bf16x4 Un[4]; f32x2 rp[2], rq[2][3];
#define S5_LOADRAW(bb, ttt) do { _Pragma("unroll") for (int dir = 0; dir < 2; ++dir) { const int c_ = dir ? 4 + 63 - (ttt) : 4 + (ttt); \
        const float* e_ = E + ((size_t)(((bb) * 2 + dir) * 64 + g) * NCHUNK + c_) * 128; rp[dir] = (f32x2){e_[lane], e_[64 + lane]}; \
        const float* q_ = QE + ((size_t)(((bb) * 2 + dir) * 64 + g) * 3) * 128; \
        _Pragma("unroll") for (int j = 0; j < 3; ++j) rq[dir][j] = (f32x2){q_[j * 128 + lane], q_[j * 128 + 64 + lane]}; } } while (0)
    { const int slot = gw >> 6, b = slot >> 6, tt = slot & 63;
      load_uf(Un, UZ, b * SEQ + 64 * tt, g, lane);
      S5_LOADRAW(b, tt); }
    for (int slot = gw >> 6; slot < 256; slot += sstep) {
        const int b = slot >> 6, tt = slot & 63, rowbase = b * SEQ + 64 * tt;
        bf16x4 Uf[4];
#pragma unroll
        for (int m = 0; m < 4; ++m) Uf[m] = Un[m];
        const f32x2 cF_ = s5_carry(rp[0], rq[0], ap[0], 4 + tt), cB_ = s5_carry(rp[1], rq[1], ap[1], 4 + 63 - tt);
        float xfr = cF_.x, xfi = cF_.y, xbr = cB_.x, xbi = cB_.y;
        if (slot + sstep < 256) { const int ns = slot + sstep, nb = ns >> 6, ntt = ns & 63;
            load_uf(Un, UZ, nb * SEQ + 64 * ntt, g, lane);
            S5_LOADRAW(nb, ntt); }
        f32x4 accY[4];
#pragma unroll
        for (int m = 0; m < 4; ++m) accY[m] = (f32x4){0.f, 0.f, 0.f, 0.f};
#pragma unroll
        for (int mm = 0; mm < 4; ++mm) {
            const int mf = mm, mb = 3 - mm;
#pragma unroll
            for (int nt = 0; nt < 8; ++nt) {
                const f32x4 z = {0.f, 0.f, 0.f, 0.f};
                const f32x4 cf = __builtin_amdgcn_mfma_f32_16x16x16bf16_1k(Uf[mf], Bf[0][nt], z, 0, 0, 0);
                const f32x4 cb = __builtin_amdgcn_mfma_f32_16x16x16bf16_1k(Uf[mb], Bf[1][nt], z, 0, 0, 0);
                u32x2 wf, wb; wf.x = pk2(cf[0], cf[1]); wf.y = pk2(cf[2], cf[3]); wb.x = pk2(cb[0], cb[1]); wb.y = pk2(cb[2], cb[3]);
                *(LAS u32x2*)(wl + nt * 640 + wofs) = wf;
                *(LAS u32x2*)(wl + BUT_BYTES + nt * 640 + wofs) = wb;
            }
            WAVE_LDS_FENCE();
            const LAS unsigned char* rp = wl + lane * 80;
            const u32x4 fre0 = *(const LAS u32x4*)(rp), fre1 = *(const LAS u32x4*)(rp + 16), fim0 = *(const LAS u32x4*)(rp + 32), fim1 = *(const LAS u32x4*)(rp + 48);
            const u32x4 bre0 = *(const LAS u32x4*)(rp + BUT_BYTES), bre1 = *(const LAS u32x4*)(rp + BUT_BYTES + 16), bim0 = *(const LAS u32x4*)(rp + BUT_BYTES + 32), bim1 = *(const LAS u32x4*)(rp + BUT_BYTES + 48);
            LAS unsigned char* xf = wl + 2 * BUT_BYTES; LAS unsigned char* xbk = xf + XB_BYTES;
#pragma unroll
            for (int rr = 0; rr < 16; ++rr) {
                const int r = rr, rb = 15 - rr;
                { const f32x2 bb = {bf_at(fre0, fre1, r), bf_at(fim0, fim1, r)};
                  const f32x2 n2 = cmac((f32x2){xfr, xfi}, (f32x2){ap[0].x, ap[0].x}, (f32x2){-ap[0].y, ap[0].y}, bb); xfr = n2.x; xfi = n2.y;
                  *(LAS unsigned*)(xf + r * XB_PITCH + lane * 4) = pk2(n2.x, n2.y); }
                { const f32x2 bb = {bf_at(bre0, bre1, rb), bf_at(bim0, bim1, rb)};
                  const f32x2 n2 = cmac((f32x2){xbr, xbi}, (f32x2){ap[1].x, ap[1].x}, (f32x2){-ap[1].y, ap[1].y}, bb); xbr = n2.x; xbi = n2.y;
                  *(LAS unsigned*)(xbk + rb * XB_PITCH + lane * 4) = pk2(n2.x, n2.y); }
            }
            WAVE_LDS_FENCE();
#pragma unroll
            for (int ks = 0; ks < 4; ++ks) {
                const bf16x8 Xf = *(const LAS bf16x8*)(xf + fr * XB_PITCH + (8 * fq + 32 * ks) * 2);
                const bf16x8 Xb = *(const LAS bf16x8*)(xbk + fr * XB_PITCH + (8 * fq + 32 * ks) * 2);
                accY[mf] = __builtin_amdgcn_mfma_f32_16x16x32_bf16(Cf[0][ks], Xf, accY[mf], 0, 0, 0);
                accY[mb] = __builtin_amdgcn_mfma_f32_16x16x32_bf16(Cf[1][ks], Xb, accY[mb], 0, 0, 0);
            }
        }
#pragma unroll
        for (int m = 0; m < 4; ++m) {
            const unsigned u0 = (unsigned)(unsigned short)Uf[m][0] | ((unsigned)(unsigned short)Uf[m][1] << 16), u1 = (unsigned)(unsigned short)Uf[m][2] | ((unsigned)(unsigned short)Uf[m][3] << 16);
            const float y0 = gelu_f(accY[m][0] + dsk[0] * bf_lo(u0)), y1 = gelu_f(accY[m][1] + dsk[1] * bf_hi(u0));
            const float y2 = gelu_f(accY[m][2] + dsk[2] * bf_lo(u1)), y3 = gelu_f(accY[m][3] + dsk[3] * bf_hi(u1));
            u32x2 w; w.x = pk2(y0, y1); w.y = pk2(y2, y3);
            *(u32x2*)(YG + (size_t)(rowbase + 16 * m + fr) * D + 16 * g + 4 * fq) = w;
        }
    }
}

__global__ void __launch_bounds__(512, 2) fwd_megakernel(Args a) {
    extern __shared__ __attribute__((aligned(16))) unsigned char lds_raw[];
    LAS unsigned char* lds = (LAS unsigned char*)lds_raw;
    cg::grid_group grid = cg::this_grid();
    unsigned char* ws = a.ws;
    volatile LAS unsigned* bst = (volatile LAS unsigned*)(lds + LDS_TOP);
    if (threadIdx.x < 2) bst[threadIdx.x] = 0u;
    __syncthreads();
    const XcdBarrier xbar = xcd_barrier_post((unsigned*)(ws + WS_BAR), bst);
    if (a.pad == 0x7ead) grid.sync();
    const int lo = a.ph_lo, hi = a.ph_hi;
    const int G = gridDim.x, bid = blockIdx.x;
    const float* mod0 = (const float*)(ws + WS_MOD);
    const float* mod1 = mod0 + 5 * 3072;
    bf16_t* H = (bf16_t*)(ws + WS_H);
    bf16_t* QKVZ = (bf16_t*)(ws + WS_QKVZ);
    bf16_t* AO = (bf16_t*)(ws + WS_AO);
    float* CTX1 = (float*)(ws + WS_CTX1);
#define IN(k) (lo <= (k) && (k) < hi)
#define SEAM(k) do { if (IN(k) && IN((k) + 1)) { xcd_barrier(xbar); if (SYNC_REP > 1) xcd_barrier(xbar); } } while (0)
#define REPB(k) ((((REP_MASK) >> (k)) & 1) != 0)
    if (IN(0)) p0_prologue(a, lds);
    if (IN(0) && REPB(0)) p0_prologue(a, lds);
    SEAM(0);
    if (IN(1)) norm_mod_phase(a.in[0], a.in[2], a.in[4], mod0, H);
    if (IN(1) && REPB(1)) norm_mod_phase(a.in[0], a.in[2], a.in[4], mod0, H);
    SEAM(1);
    if (IN(2)) { pg8::Gemm g{H, (const bf16_t*)(ws + WS_WQKVZ), MTOT, NQKVZ, D}; pg8::StaticOrder S; S.init(MTOT, NQKVZ, G, bid);
        EpiQKVZ E{QKVZ, (const float*)(ws + WS_ROPE)}; pg8::gemm_phase<EpiQKVZ, pg8::StaticOrder>(lds, g, S, E);
        p2_late_transposes(a, lds, (MTOT / 256) * (NQKVZ / 256) - 2 * G); }
    if (IN(2) && REPB(2)) { pg8::Gemm g{H, (const bf16_t*)(ws + WS_WQKVZ), MTOT, NQKVZ, D}; pg8::StaticOrder S; S.init(MTOT, NQKVZ, G, bid);
        EpiQKVZ E{QKVZ, (const float*)(ws + WS_ROPE)}; pg8::gemm_phase<EpiQKVZ, pg8::StaticOrder>(lds, g, S, E); }
    SEAM(2);
    if (IN(3)) attn_phase(lds, QKVZ, AO, a.in[8]);
    if (IN(3) && REPB(3)) attn_phase(lds, QKVZ, AO, a.in[8]);
    SEAM(3);
    if (IN(4)) { pg8::Gemm g{AO, (const bf16_t*)(ws + WS_WAO), NLAT, D, D}; PanelOrder S; S.init(NLAT, G, bid);
        EpiResidNorm<false> E{a.in[0], (bf16_t*)(ws + WS_X1), nullptr, mod0, a.in[4] + D, mod1, H, (float*)(ws + WS_STAT), (unsigned*)(ws + WS_CNT)};
        pg8::gemm_phase<EpiResidNorm<false>, PanelOrder>(lds, g, S, E);
        if (bid < 256) { const int rb = bid >> 4, cb = bid & 15;
            Epi64ResidNorm E2{a.in[2] + (size_t)rb * 64 * D, mod0 + 4 * 3072, a.in[4] + D, mod1 + 4 * 3072, H + (size_t)(NLAT + rb * 64) * D, cb * 64,
                              (float*)(ws + WS_STATC) + rb * 1024, (unsigned*)(ws + WS_CNTC) + rb * 64, cb};
            gemm64_tile<Epi64ResidNorm>(lds, AO + (size_t)(NLAT + rb * 64) * D, (const bf16_t*)(ws + WS_WAO) + (size_t)cb * 64 * D, E2); } }
    SEAM(5);
    if (IN(6)) { pg8::Gemm g{H, (const bf16_t*)(ws + WS_WSIN), NLAT, NUZ, D}; pg8::StaticOrder S; S.init(NLAT, NUZ, G, bid);
        EpiBf16 E{QKVZ, NUZ}; pg8::gemm_phase<EpiBf16, pg8::StaticOrder>(lds, g, S, E);
        if (bid < 256) { const int rb = bid >> 4, cb = bid & 15;
            Epi64Bf16 E2{QKVZ + (size_t)(NLAT + rb * 64) * NUZ + cb * 64, NUZ};
            gemm64_tile<Epi64Bf16>(lds, H + (size_t)(NLAT + rb * 64) * D, (const bf16_t*)(ws + WS_WSIN) + (size_t)cb * 64 * D, E2); } }
    SEAM(6);
    if (IN(7)) s5_local_phase(lds, QKVZ, ws);
    if (IN(7) && REPB(7)) s5_local_phase(lds, QKVZ, ws);
    SEAM(7);
    if (IN(9)) s5_out_phase(lds, QKVZ, ws, a.in[18], AO);
    if (IN(9) && REPB(9)) s5_out_phase(lds, QKVZ, ws, a.in[18], AO);
    SEAM(9);
    if (IN(10)) { pg8::Gemm g{AO, (const bf16_t*)(ws + WS_WGLU), NLAT, NUZ, D}; pg8::StaticOrder S; S.init(NLAT, NUZ, G, bid);
        EpiGlu E{H, QKVZ}; pg8::gemm_phase<EpiGlu, pg8::StaticOrder>(lds, g, S, E); }
    if (IN(10) && REPB(10)) { pg8::Gemm g{AO, (const bf16_t*)(ws + WS_WGLU), NLAT, NUZ, D}; pg8::StaticOrder S; S.init(NLAT, NUZ, G, bid);
        EpiGlu E{H, QKVZ}; pg8::gemm_phase<EpiGlu, pg8::StaticOrder>(lds, g, S, E); }
    SEAM(10);
    if (IN(11)) { pg8::Gemm g{H, (const bf16_t*)(ws + WS_WSOUT), NLAT, D, D}; PanelOrder S; S.init(NLAT, G, bid);
        EpiResidNorm<true> E{nullptr, (bf16_t*)(ws + WS_X1), a.out, mod1, a.in[21], nullptr, nullptr, (float*)(ws + WS_STAT) + 68 * 1024, (unsigned*)(ws + WS_CNT) + 68 * 64};
        pg8::gemm_phase<EpiResidNorm<true>, PanelOrder>(lds, g, S, E); }
#undef IN
#undef SEAM
}

extern "C" void kernel_launch(void* const* d_in, const int* in_sizes, int n_in, void* d_out, int out_size, void* d_ws, size_t ws_size, hipStream_t stream) {
    static int grid = 0;
    if (grid == 0) {
        int dev = 0, cus = 0, per_cu = 0;
        (void)hipGetDevice(&dev);
        (void)hipDeviceGetAttribute(&cus, hipDeviceAttributeMultiprocessorCount, dev);
        (void)hipFuncSetAttribute((const void*)fwd_megakernel, hipFuncAttributeMaxDynamicSharedMemorySize, LDS_BYTES);
        (void)hipOccupancyMaxActiveBlocksPerMultiprocessor(&per_cu, (const void*)fwd_megakernel, 512, LDS_BYTES);
        if (per_cu < 1) per_cu = 1;
        grid = cus * per_cu;
        if (n_in != 22 || ws_size < WS_END) { fprintf(stderr, "kernel_launch: unexpected n_in %d / ws_size %zu\n", n_in, ws_size); }
    }
    Args a{};
    for (int i = 0; i < 22; ++i) a.in[i] = (const float*)d_in[i];
    a.out = (float*)d_out; a.ws = (unsigned char*)d_ws; a.ph_lo = 0; a.ph_hi = 13;
    (void)hipMemsetAsync((char*)d_ws + WS_BAR, 0, BAR_ZERO_BYTES, stream);
    void* args[] = {&a};
    hipError_t e = hipLaunchCooperativeKernel((void*)fwd_megakernel, dim3(grid), dim3(512), args, LDS_BYTES, stream);
    if (e != hipSuccess) fprintf(stderr, "cooperative launch failed: %s (grid %d)\n", hipGetErrorString(e), grid);
}
```

```cpp
#include <hip/hip_runtime.h>
#include <hip/hip_cooperative_groups.h>
#include <cstdio>
#include <cstdint>
namespace cg = cooperative_groups;

#define LAS __attribute__((address_space(3)))
typedef unsigned short bf16_t;
typedef short bf16x8 __attribute__((ext_vector_type(8)));
typedef short bf16x4 __attribute__((ext_vector_type(4)));
typedef float f32x4 __attribute__((ext_vector_type(4)));
typedef float f32x2 __attribute__((ext_vector_type(2)));
typedef float f32x16 __attribute__((ext_vector_type(16)));
typedef unsigned u32x4 __attribute__((ext_vector_type(4)));
typedef unsigned u32x2 __attribute__((ext_vector_type(2)));
typedef __bf16 nbf2 __attribute__((ext_vector_type(2)));

constexpr int D = 1024, NB = 4, SEQ = 4096, CTXL = 256;
constexpr int NLAT = NB * SEQ;
constexpr int NCTX = NB * CTXL;
constexpr int MTOT = NLAT + NCTX;
constexpr int NQKVZ = 2560;
constexpr int NUZ = 2048;
constexpr int NCHUNK = 68;
constexpr float LOG2E = 1.4426950408889634f;

constexpr size_t MiB = 1u << 20;
constexpr size_t WS_MOD = 0;
constexpr size_t WS_BAR = 128 * 1024;
constexpr size_t WS_ROPE = 256 * 1024;
constexpr size_t WS_APOW = 512 * 1024;
constexpr size_t WS_BB = 1 * MiB;
constexpr size_t WS_CM = 1 * MiB + 512 * 1024;
constexpr size_t WS_WQKVZ = 2 * MiB;
constexpr size_t WS_WAO = 7 * MiB;
constexpr size_t WS_WSIN = 9 * MiB;
constexpr size_t WS_WGLU = 13 * MiB;
constexpr size_t WS_WSOUT = 17 * MiB;
constexpr size_t WS_CTX1 = 19 * MiB;
constexpr size_t WS_E = 23 * MiB;
constexpr size_t WS_H = 40 * MiB;
constexpr size_t WS_AO = 74 * MiB;
constexpr size_t WS_QKVZ = 108 * MiB;
constexpr size_t WS_STAT = 193 * MiB;
constexpr size_t WS_QE = 194 * MiB;
constexpr size_t WS_X1 = 195 * MiB;
constexpr size_t WS_END = 227 * MiB;
constexpr size_t WS_CNT = WS_BAR + 16384;
constexpr size_t WS_STATC = WS_STAT + 768 * 1024;
constexpr size_t WS_CNTC = WS_CNT + 2 * 68 * 256;
constexpr size_t BAR_ZERO_BYTES = 16384 + 2 * 68 * 256 + 16 * 256;

constexpr int S5_WAVE_LDS = 18944;
constexpr int LDS_TOP = 8 * S5_WAVE_LDS;
constexpr int LDS_BYTES = LDS_TOP + 6144;
#ifndef REP_MASK
#define REP_MASK 0
#endif
#ifndef SYNC_REP
#define SYNC_REP 1
#endif

__device__ __forceinline__ unsigned pk2(float lo, float hi) { f32x2 v = {lo, hi}; nbf2 r = __builtin_convertvector(v, nbf2); return __builtin_bit_cast(unsigned, r); }
__device__ __forceinline__ float bf_lo(unsigned w) { return __uint_as_float(w << 16); }
__device__ __forceinline__ float bf_hi(unsigned w) { return __uint_as_float(w & 0xffff0000u); }
__device__ __forceinline__ float fast_rcp(float x) { return __builtin_amdgcn_rcpf(x); }
__device__ __forceinline__ float fast_exp2(float x) { return __builtin_amdgcn_exp2f(x); }
__device__ __forceinline__ float silu_f(float z) { return z * fast_rcp(1.0f + fast_exp2(-z * LOG2E)); }
__device__ __forceinline__ float sigmoid_f(float z) { return fast_rcp(1.0f + fast_exp2(-z * LOG2E)); }
__device__ __forceinline__ float wave_sum(float v) {
#pragma unroll
    for (int o = 1; o < 64; o <<= 1) v += __shfl_xor(v, o);
    return v;
}
__device__ __forceinline__ float gelu_f(float v) {
    const float av = fabsf(v), d = av * 0.2316418882f + 1.0f;
    const float t = fast_rcp(d);
    float q = t * 0.5307027145f + (-0.7265760135f); q = q * t + 0.7107068705f; q = q * t + (-0.142248368f); q = q * t + 0.127414796f; q = q * t;
    const float e = fast_exp2((v * v) * (-0.72134752044f));
    const float m = v * (q * e), r = v - m;
    return v < 0.f ? m : r;
}
#define WAVE_LDS_FENCE() asm volatile("s_waitcnt lgkmcnt(0)" ::: "memory")
__device__ __forceinline__ f32x2 cmac(f32x2 x, f32x2 a_rr, f32x2 a_i, f32x2 c) { const f32x2 t = a_rr * x + c; const f32x2 xs = {x.y, x.x}; return a_i * xs + t; }

namespace pg8 {
constexpr int BM = 256, BK = 64, HALF = 128, HTB = HALF * BK * 2, NXCD = 8, WGM = 8;
__host__ __device__ __forceinline__ int lds_byte(int r, int c) { const int st = (r >> 4) * 2 + (c >> 5), rr = r & 15, cc = c & 31, ob = rr * 64 + cc * 2; return st * 1024 + (ob ^ (((ob >> 9) & 1) << 5)); }
__host__ __device__ __forceinline__ void stage_rc(int b, int& R, int& C) { const int st = b / 1024, sb = b % 1024, swz = sb ^ (((sb >> 9) & 1) << 5); R = (st >> 1) * 16 + swz / 64; C = (st & 1) * 32 + (swz % 64) / 2; }
__host__ __device__ __forceinline__ int perm32(int rho) { const int n = rho >> 4, i = rho & 15; return 8 * (i >> 2) + 4 * n + (i & 3); }
struct Unit { int pm, pn; };
struct Gemm { const bf16_t* A; const bf16_t* Bt; int M, N, K; };
struct StaticOrder {
    int nM, nN, nwg, G, c;
    __device__ void init(int M, int N, int G_, int c_) { nM = M / BM; nN = N / BM; nwg = nM * nN; G = G_; c = c_; }
    __device__ bool next(int i, Unit& u) const {
        const long L = (long)i * G + c; if (L >= nwg) return false;
        int wgid = (int)L; { const int q = nwg / NXCD, r = nwg % NXCD, xcd = wgid % NXCD, off = wgid / NXCD; wgid = (xcd < r ? xcd * (q + 1) : r * (q + 1) + (xcd - r) * q) + off; }
        const int nig = WGM * nN, gid = wgid / nig, fm = gid * WGM, gsz = (nM - fm) < WGM ? (nM - fm) : WGM;
        u.pm = fm + ((wgid % nig) % gsz); u.pn = (wgid % nig) / gsz; return true;
    }
};
template <class Epi, class Sched>
__device__ __forceinline__ void gemm_phase(LAS unsigned char* lds, const Gemm g, const Sched& S, const Epi& E) {
    const int tid = threadIdx.x, wid = __builtin_amdgcn_readfirstlane(tid >> 6), lane = tid & 63, wr = wid >> 2, wc = wid & 3, fr = lane & 15, fq = lane >> 4;
    const int K = g.K, nt = K / BK;
    unsigned voffA[2], voffB[2];
#pragma unroll
    for (int i = 0; i < 2; ++i) { int R, C; stage_rc(tid * 16 + i * 8192, R, C); const int Rb = Epi::PERM ? ((R & ~31) + perm32(R & 31)) : R;
        voffA[i] = (unsigned)(R * K + C) * 2u; voffB[i] = (unsigned)(Rb * K + C) * 2u; }
    const size_t kstep = (size_t)(BK * 2);
    const size_t hstep = (size_t)HALF * K * 2;
    const size_t tstep = 2 * hstep;
    const unsigned ldsw = (unsigned)wid * 1024u;
    const int aoff = lds_byte(wr * 64 + fr, fq * 8), boff = lds_byte(wc * 32 + fr, fq * 8);
#define PG8_SA(b, h) (((b) * 2 + (h)) * HTB)
#define PG8_SB(b, h) ((4 + (b) * 2 + (h)) * HTB)
#define PG8_STAGE(bufoff, gbase, voff) do { _Pragma("unroll") for (int _i = 0; _i < 2; ++_i) \
        __builtin_amdgcn_global_load_lds((const unsigned*)((const char*)(gbase) + (voff)[_i]), (LAS unsigned*)(lds + (bufoff) + ldsw + _i * 8192), 16, 0, 0); } while (0)
#define PG8_LDA(dst, b, h) do { _Pragma("unroll") for (int m = 0; m < 4; ++m) _Pragma("unroll") for (int k = 0; k < 2; ++k) dst[m][k] = *(const LAS bf16x8*)(lds + PG8_SA(b, h) + aoff + m * 2048 + k * 1024); } while (0)
#define PG8_LDB(dst, b, h) do { _Pragma("unroll") for (int n = 0; n < 2; ++n) _Pragma("unroll") for (int k = 0; k < 2; ++k) dst[n][k] = *(const LAS bf16x8*)(lds + PG8_SB(b, h) + boff + n * 2048 + k * 1024); } while (0)
#define PG8_MMA(ai, bj, At, Bt) do { __builtin_amdgcn_s_setprio(1); _Pragma("unroll") for (int m = 0; m < 4; ++m) _Pragma("unroll") for (int n = 0; n < 2; ++n) _Pragma("unroll") for (int k = 0; k < 2; ++k) \
        acc[ai][bj][m][n] = __builtin_amdgcn_mfma_f32_16x16x32_bf16(Bt[n][k], At[m][k], acc[ai][bj][m][n], 0, 0, 0); __builtin_amdgcn_s_setprio(0); } while (0)
#define PG8_WAIT_V(n) asm volatile("s_waitcnt vmcnt(" #n ")" ::: "memory")
#define PG8_WAIT_L(n) asm volatile("s_waitcnt lgkmcnt(" #n ")" ::: "memory")
#define PG8_BAR __builtin_amdgcn_s_barrier()
#define PG8_SCHED __builtin_amdgcn_sched_barrier(0)
    Unit cur, nxt; int ui = 0;
    if (!S.next(0, cur)) return;
    f32x4 acc[2][2][4][2];
#pragma unroll
    for (int a = 0; a < 2; ++a)
#pragma unroll
        for (int b = 0; b < 2; ++b)
#pragma unroll
            for (int m = 0; m < 4; ++m)
#pragma unroll
                for (int n = 0; n < 2; ++n) acc[a][b][m][n] = (f32x4){0.f, 0.f, 0.f, 0.f};
    bf16x8 At[4][2], B0[2][2], B1[2][2];
    const char* cA = (const char*)g.A + (size_t)cur.pm * tstep; const char* cB = (const char*)g.Bt + (size_t)cur.pn * tstep;
    PG8_STAGE(PG8_SB(0, 0), cB, voffB); PG8_STAGE(PG8_SB(0, 1), cB + hstep, voffB); PG8_STAGE(PG8_SA(0, 0), cA, voffA); PG8_STAGE(PG8_SA(0, 1), cA + hstep, voffA);
    if (wr == 1) PG8_BAR;
    PG8_WAIT_V(2); PG8_BAR;
    PG8_STAGE(PG8_SB(1, 0), cB + kstep, voffB); PG8_STAGE(PG8_SA(1, 0), cA + kstep, voffA); PG8_STAGE(PG8_SB(1, 1), cB + hstep + kstep, voffB);
    PG8_WAIT_V(6); PG8_BAR;
    for (;;) {
        const bool has_next = S.next(ui + 1, nxt);
        const char* nA = has_next ? (const char*)g.A + (size_t)nxt.pm * tstep : cA; const char* nB = has_next ? (const char*)g.Bt + (size_t)nxt.pn * tstep : cB;
        for (int t = 0; t < nt; t += 2) {
            const bool last = (t == nt - 2);
            const char* a1 = cA + (size_t)(t + 1) * kstep;
            const char* a2 = last ? nA : cA + (size_t)(t + 2) * kstep; const char* b2 = last ? nB : cB + (size_t)(t + 2) * kstep;
            const char* a3 = a2 + kstep; const char* b3 = b2 + kstep;
            PG8_LDB(B0, 0, 0); PG8_LDB(B1, 0, 1); PG8_SCHED; PG8_LDA(At, 0, 0); PG8_STAGE(PG8_SA(1, 1), a1 + hstep, voffA);
            PG8_WAIT_V(8); PG8_WAIT_L(0); PG8_BAR; PG8_MMA(0, 0, At, B0); PG8_MMA(0, 1, At, B1); PG8_BAR; PG8_SCHED;
            PG8_LDA(At, 0, 1); PG8_STAGE(PG8_SB(0, 0), b2, voffB); PG8_STAGE(PG8_SB(0, 1), b2 + hstep, voffB); PG8_STAGE(PG8_SA(0, 0), a2, voffA);
            PG8_WAIT_V(8); PG8_WAIT_L(0); PG8_BAR; PG8_MMA(1, 0, At, B0); PG8_MMA(1, 1, At, B1); PG8_BAR; PG8_SCHED;
            PG8_LDB(B0, 1, 0); PG8_LDB(B1, 1, 1); PG8_SCHED; PG8_LDA(At, 1, 0); PG8_STAGE(PG8_SA(0, 1), a2 + hstep, voffA);
            PG8_WAIT_V(8); PG8_WAIT_L(0); PG8_BAR; PG8_MMA(0, 0, At, B0); PG8_MMA(0, 1, At, B1); PG8_BAR; PG8_SCHED;
            PG8_LDA(At, 1, 1); PG8_STAGE(PG8_SB(1, 0), b3, voffB); PG8_STAGE(PG8_SB(1, 1), b3 + hstep, voffB); PG8_STAGE(PG8_SA(1, 0), a3, voffA);
            PG8_WAIT_V(8); PG8_WAIT_L(0); PG8_BAR; PG8_MMA(1, 0, At, B0); PG8_MMA(1, 1, At, B1); PG8_BAR; PG8_SCHED;
        }
        if (wr == 0) PG8_BAR;
        E(acc, cur, wr, wc, fr, fq, lds);
        if (!has_next) break;
#pragma unroll
        for (int a = 0; a < 2; ++a)
#pragma unroll
            for (int b = 0; b < 2; ++b)
#pragma unroll
                for (int m = 0; m < 4; ++m)
#pragma unroll
                    for (int n = 0; n < 2; ++n) acc[a][b][m][n] = (f32x4){0.f, 0.f, 0.f, 0.f};
        cur = nxt; cA = nA; cB = nB; ++ui;
        if (wr == 1) PG8_BAR;
    }
    PG8_WAIT_V(0);
    PG8_BAR;
#undef PG8_SA
#undef PG8_SB
#undef PG8_STAGE
#undef PG8_LDA
#undef PG8_LDB
#undef PG8_MMA
#undef PG8_WAIT_V
#undef PG8_WAIT_L
#undef PG8_BAR
#undef PG8_SCHED
}
}

struct EpiQKVZ {
    static constexpr bool PERM = true;
    bf16_t* O; const float* rope;
    __device__ __forceinline__ void operator()(f32x4 (&acc)[2][2][4][2], const pg8::Unit& u, int wr, int wc, int fr, int fq, LAS unsigned char* lds) const {
        const float qs = 0.125f * LOG2E;
        if (u.pn >= 5) {
#pragma unroll
            for (int ai = 0; ai < 2; ++ai)
#pragma unroll
                for (int m = 0; m < 4; ++m) {
                    bf16_t* rowp = O + (size_t)(u.pm * 256 + ai * 128 + wr * 64 + m * 16 + fr) * NQKVZ + u.pn * 256 + wc * 32 + 8 * fq;
#pragma unroll
                    for (int bj = 0; bj < 2; ++bj) {
                        const f32x4 v0 = acc[ai][bj][m][0], v1 = acc[ai][bj][m][1];
                        u32x4 w; w.x = pk2(v0[0], v0[1]); w.y = pk2(v0[2], v0[3]); w.z = pk2(v1[0], v1[1]); w.w = pk2(v1[2], v1[3]);
                        *(u32x4*)(rowp + bj * 128) = w;
                    }
                }
            return;
        }
        f32x4 csv[2][4], snv[2][4];
#pragma unroll
        for (int ai = 0; ai < 2; ++ai)
#pragma unroll
            for (int m = 0; m < 4; ++m) {
                const int t = (u.pm * 256 + ai * 128 + wr * 64 + m * 16 + fr) & (SEQ - 1);
                const int val = (wc & 1) ? (t & 63) : (t >> 6);
                csv[ai][m] = *(const f32x4*)(rope + val * 32 + 4 * fq); snv[ai][m] = *(const f32x4*)(rope + val * 32 + 16 + 4 * fq);
            }
#pragma unroll
        for (int ai = 0; ai < 2; ++ai)
#pragma unroll
            for (int m = 0; m < 4; ++m) {
                const int r = u.pm * 256 + ai * 128 + wr * 64 + m * 16 + fr;
                const bool lat = r < NLAT;
                const f32x4 cs = csv[ai][m], sn = snv[ai][m];
                bf16_t* rowp = O + (size_t)r * NQKVZ;
#pragma unroll
                for (int bj = 0; bj < 2; ++bj) {
                    const int cb = u.pn * 256 + bj * 128 + wc * 32;
                    f32x4 t1 = acc[ai][bj][m][0], t2 = acc[ai][bj][m][1];
                    if (cb < 1280 && lat) { const f32x4 o1 = t1 * cs - t2 * sn, o2 = t2 * cs + t1 * sn; t1 = o1; t2 = o2; }
                    if (cb < 1024) { t1 = t1 * qs; t2 = t2 * qs; }
                    u32x4 w; w.x = pk2(t1[0], t1[1]); w.y = pk2(t1[2], t1[3]); w.z = pk2(t2[0], t2[1]); w.w = pk2(t2[2], t2[3]);
                    *(u32x4*)(rowp + cb + 8 * fq) = w;
                }
            }
    }
};
struct EpiResid {
    static constexpr bool PERM = true;
    const float* base_lat; float* out_lat; const float* base_ctx; float* out_ctx; const float* mod;
    __device__ __forceinline__ void operator()(f32x4 (&acc)[2][2][4][2], const pg8::Unit& u, int wr, int wc, int fr, int fq, LAS unsigned char* lds) const {
#pragma unroll
        for (int ai = 0; ai < 2; ++ai) {
            const int r0 = u.pm * 256 + ai * 128;
            const bool lat = r0 < NLAT;
            const int v = lat ? (r0 >> 12) : 4;
            const float* gp = mod + v * 3072 + 2048;
            const float* bp = lat ? base_lat : base_ctx - (size_t)NLAT * D;
            float* op = lat ? out_lat : out_ctx - (size_t)NLAT * D;
#pragma unroll
            for (int bj = 0; bj < 2; ++bj) {
                const int c0 = u.pn * 256 + bj * 128 + wc * 32 + 8 * fq;
                const f32x4 g0 = *(const f32x4*)(gp + c0), g1 = *(const f32x4*)(gp + c0 + 4);
#pragma unroll
                for (int m = 0; m < 4; ++m) {
                    const size_t off = (size_t)(r0 + wr * 64 + m * 16 + fr) * D + c0;
                    const f32x4 x0 = *(const f32x4*)(bp + off), x1 = *(const f32x4*)(bp + off + 4);
                    *(f32x4*)(op + off) = x0 + g0 * acc[ai][bj][m][0];
                    *(f32x4*)(op + off + 4) = x1 + g1 * acc[ai][bj][m][1];
                }
            }
        }
    }
};
struct EpiBf16 {
    static constexpr bool PERM = true;
    bf16_t* O; int ldc;
    __device__ __forceinline__ void operator()(f32x4 (&acc)[2][2][4][2], const pg8::Unit& u, int wr, int wc, int fr, int fq, LAS unsigned char* lds) const {
#pragma unroll
        for (int ai = 0; ai < 2; ++ai)
#pragma unroll
            for (int m = 0; m < 4; ++m) {
                bf16_t* rowp = O + (size_t)(u.pm * 256 + ai * 128 + wr * 64 + m * 16 + fr) * ldc + u.pn * 256 + wc * 32 + 8 * fq;
#pragma unroll
                for (int bj = 0; bj < 2; ++bj) {
                    const f32x4 v0 = acc[ai][bj][m][0], v1 = acc[ai][bj][m][1];
                    u32x4 w; w.x = pk2(v0[0], v0[1]); w.y = pk2(v0[2], v0[3]); w.z = pk2(v1[0], v1[1]); w.w = pk2(v1[2], v1[3]);
                    *(u32x4*)(rowp + bj * 128) = w;
                }
            }
    }
};
struct EpiGlu {
    static constexpr bool PERM = true;
    bf16_t* O; const bf16_t* UZ;
    __device__ __forceinline__ void operator()(f32x4 (&acc)[2][2][4][2], const pg8::Unit& u, int wr, int wc, int fr, int fq, LAS unsigned char* lds) const {
#pragma unroll
        for (int ai = 0; ai < 2; ++ai)
#pragma unroll
            for (int m = 0; m < 4; ++m) {
                const int r = u.pm * 256 + ai * 128 + wr * 64 + m * 16 + fr;
                const int oc = u.pn * 128 + wc * 32 + 8 * fq;
                const u32x4 zw = *(const u32x4*)(UZ + (size_t)r * NUZ + 1024 + oc);
                const f32x4 a0 = acc[ai][0][m][0], a1 = acc[ai][0][m][1], g0 = acc[ai][1][m][0], g1 = acc[ai][1][m][1];
                float o[8];
                o[0] = a0[0] * sigmoid_f(g0[0]) * silu_f(bf_lo(zw.x)); o[1] = a0[1] * sigmoid_f(g0[1]) * silu_f(bf_hi(zw.x));
                o[2] = a0[2] * sigmoid_f(g0[2]) * silu_f(bf_lo(zw.y)); o[3] = a0[3] * sigmoid_f(g0[3]) * silu_f(bf_hi(zw.y));
                o[4] = a1[0] * sigmoid_f(g1[0]) * silu_f(bf_lo(zw.z)); o[5] = a1[1] * sigmoid_f(g1[1]) * silu_f(bf_hi(zw.z));
                o[6] = a1[2] * sigmoid_f(g1[2]) * silu_f(bf_lo(zw.w)); o[7] = a1[3] * sigmoid_f(g1[3]) * silu_f(bf_hi(zw.w));
                u32x4 w; w.x = pk2(o[0], o[1]); w.y = pk2(o[2], o[3]); w.z = pk2(o[4], o[5]); w.w = pk2(o[6], o[7]);
                *(u32x4*)(O + (size_t)r * D + oc) = w;
            }
    }
};


#define XB_TMO      128
#define XB_XCNT(j)  (256  + 64 * (j))
#define XB_XSUB(j)  (1280 + 64 * (j))
#define XB_XGEN(j)  (2304 + 64 * (j))
#define XB_TOP      3328
#define XB_TOPGEN   3392
#define XCD_BAR_WORDS 3456
#define XB_SPIN_CAP (1u << 18)
__device__ __forceinline__ unsigned xb_ld(unsigned* p)              { return __hip_atomic_load(p, __ATOMIC_RELAXED, __HIP_MEMORY_SCOPE_AGENT); }
__device__ __forceinline__ unsigned xb_add(unsigned* p, unsigned v) { return __hip_atomic_fetch_add(p, v, __ATOMIC_RELAXED, __HIP_MEMORY_SCOPE_AGENT); }
__device__ __forceinline__ unsigned xb_xcc_id() { return (unsigned)__builtin_amdgcn_s_getreg((3 << 11) | 20) & 0xFu; }
#define XB_SPIN(cond, bar) do { unsigned _sp = 0; while (cond) { __builtin_amdgcn_s_sleep(1); \
    if ((++_sp & 255u) == 0u) { if (xb_ld(&(bar)[XB_TMO])) break; if (_sp > XB_SPIN_CAP) { atomicAdd(&(bar)[XB_TMO], 1u); break; } } } } while (0)
struct XcdBarrier { unsigned* bar; unsigned x; volatile LAS unsigned* st; };
__device__ __forceinline__ XcdBarrier xcd_barrier_post(unsigned* bar, volatile LAS unsigned* st) {
    XcdBarrier b; b.bar = bar; b.x = xb_xcc_id(); b.st = st;
    if (threadIdx.x == 0) (void)xb_add(&bar[XB_XCNT(b.x)], 1u);
    return b;
}
__device__ __forceinline__ void xcd_barrier_complete(unsigned* bar, unsigned x, unsigned& nloc, unsigned& nx) {
    const unsigned G = gridDim.x * gridDim.y * gridDim.z;
    unsigned sum, cnt, mine, sp = 0u;
    for (;;) {
        sum = 0u; cnt = 0u; mine = 0u;
#pragma unroll
        for (unsigned j = 0; j < 16; ++j) { const unsigned c = xb_ld(&bar[XB_XCNT(j)]); sum += c; cnt += (c > 0u) ? 1u : 0u; mine = (j == x) ? c : mine; }
        if (sum == G) break;
        __builtin_amdgcn_s_sleep(1);
        if ((++sp & 255u) == 0u) { if (xb_ld(&bar[XB_TMO])) break; if (sp > XB_SPIN_CAP) { atomicAdd(&bar[XB_TMO], 1u); break; } }
    }
    nloc = mine > 0u ? mine : 1u; nx = cnt > 0u ? cnt : 1u;
}
__device__ __forceinline__ void xcd_barrier(const XcdBarrier& b) {
    asm volatile("s_waitcnt vmcnt(0)" ::: "memory");
    __syncthreads();
    if (threadIdx.x == 0) {
        unsigned* bar = b.bar;
        __builtin_amdgcn_s_waitcnt(0);
        unsigned nloc = b.st[0], nx = b.st[1];
        if (nloc == 0u) { xcd_barrier_complete(bar, b.x, nloc, nx); b.st[0] = nloc; b.st[1] = nx; }
        const unsigned old = xb_add(&bar[XB_XSUB(b.x)], 1u);
        const unsigned gen = old / nloc;
        if (old + 1u == (gen + 1u) * nloc) {
            __builtin_amdgcn_fence(__ATOMIC_RELEASE, "agent");
            asm volatile("s_waitcnt vmcnt(0)" ::: "memory");
            const unsigned og = xb_add(&bar[XB_TOP], 1u);
            const unsigned tg = og / nx;
            if (og + 1u == (tg + 1u) * nx) xb_add(&bar[XB_TOPGEN], 1u);
            else XB_SPIN(xb_ld(&bar[XB_TOPGEN]) == tg, bar);
            __builtin_amdgcn_fence(__ATOMIC_ACQUIRE, "agent");
            xb_add(&bar[XB_XGEN(b.x)], 1u);
            asm volatile("s_waitcnt vmcnt(0)" ::: "memory");
        } else {
            XB_SPIN(xb_ld(&bar[XB_XGEN(b.x)]) == gen, bar);
            __builtin_amdgcn_fence(__ATOMIC_ACQUIRE, "agent");
            asm volatile("s_waitcnt vmcnt(0)" ::: "memory");
        }
    }
    __syncthreads();
}


struct PanelOrder {
    int ntiles, G, c;
    __device__ void init(int M, int G_, int c_) { ntiles = (M / 256) * 4; G = G_; c = c_; }
    __device__ bool next(int i, pg8::Unit& u) const {
        const int L = i * G + c; if (L >= ntiles) return false;
        if (L < 256) { const int xcd = L & 7, j = L >> 3; u.pm = xcd * 8 + (j >> 2); u.pn = j & 3; }
        else { const int Lc = L - 256; u.pm = 64 + (Lc >> 2); u.pn = Lc & 3; }
        return true;
    }
};
template <bool FINAL>
struct EpiResidNorm {
    static constexpr bool PERM = true;
    const float* xin; bf16_t* X1; float* out;
    const float* mod;
    const float* nw;
    const float* mod_next;
    bf16_t* H;
    float* stat; unsigned* cnt;
    __device__ __forceinline__ void operator()(f32x4 (&acc)[2][2][4][2], const pg8::Unit& u, int wr, int wc, int fr, int fq, LAS unsigned char* lds) const {
        LAS float* P = (LAS float*)(lds + LDS_TOP + 64);
        LAS float* S = P + 1024;
        const int tid = threadIdx.x;
        asm volatile("s_waitcnt vmcnt(0)" ::: "memory"); __syncthreads();
        LAS unsigned char* park = lds + tid * 16;
        float q[2][4];
#pragma unroll
        for (int ai = 0; ai < 2; ++ai) {
            const int r0 = u.pm * 256 + ai * 128;
            const float* gp = mod + (r0 >> 12) * 3072 + 2048;
#pragma unroll
            for (int m = 0; m < 4; ++m) q[ai][m] = 0.f;
#pragma unroll
            for (int bj = 0; bj < 2; ++bj) {
                const int c0 = u.pn * 256 + bj * 128 + wc * 32 + 8 * fq;
                const f32x4 g0 = *(const f32x4*)(gp + c0), g1 = *(const f32x4*)(gp + c0 + 4);
#pragma unroll
                for (int m = 0; m < 4; ++m) {
                    const size_t off = (size_t)(r0 + wr * 64 + m * 16 + fr) * D + c0;
                    f32x4 b0, b1;
                    if (FINAL) { const u32x4 w = *(const u32x4*)(X1 + off); b0 = (f32x4){bf_lo(w.x), bf_hi(w.x), bf_lo(w.y), bf_hi(w.y)}; b1 = (f32x4){bf_lo(w.z), bf_hi(w.z), bf_lo(w.w), bf_hi(w.w)}; }
                    else { b0 = *(const f32x4*)(xin + off); b1 = *(const f32x4*)(xin + off + 4); }
                    const f32x4 x0 = b0 + g0 * acc[ai][bj][m][0], x1 = b1 + g1 * acc[ai][bj][m][1];
                    u32x4 w; w.x = pk2(x0[0], x0[1]); w.y = pk2(x0[2], x0[3]); w.z = pk2(x1[0], x1[1]); w.w = pk2(x1[2], x1[3]);
                    *(LAS u32x4*)(park + ((ai * 2 + bj) * 4 + m) * 8192) = w;
                    if (!FINAL) *(u32x4*)(X1 + off) = w;
                    q[ai][m] += ((x0[0] * x0[0] + x0[1] * x0[1]) + (x0[2] * x0[2] + x0[3] * x0[3])) + ((x1[0] * x1[0] + x1[1] * x1[1]) + (x1[2] * x1[2] + x1[3] * x1[3]));
                }
            }
        }
#pragma unroll
        for (int ai = 0; ai < 2; ++ai)
#pragma unroll
            for (int m = 0; m < 4; ++m) {
                float t = q[ai][m]; t += __shfl_xor(t, 16); t += __shfl_xor(t, 32);
                if (fq == 0) P[(ai * 128 + wr * 64 + m * 16 + fr) * 4 + wc] = t;
            }
        __syncthreads();
        float* st = stat + (size_t)u.pm * 1024;
        if (tid < 256) { const f32x4 p = *(const LAS f32x4*)(P + tid * 4);
            __hip_atomic_store(st + u.pn * 256 + tid, (p[0] + p[1]) + (p[2] + p[3]), __ATOMIC_RELAXED, __HIP_MEMORY_SCOPE_AGENT); }
        asm volatile("s_waitcnt vmcnt(0)" ::: "memory");
        __syncthreads();
        if (tid == 0) {
            __hip_atomic_fetch_add(cnt + 64 * u.pm, 1u, __ATOMIC_RELAXED, __HIP_MEMORY_SCOPE_AGENT);
            unsigned sp = 0;
            while (__hip_atomic_load(cnt + 64 * u.pm, __ATOMIC_RELAXED, __HIP_MEMORY_SCOPE_AGENT) < 4u) { __builtin_amdgcn_s_sleep(1); if (++sp > (1u << 20)) break; }
        }
        __syncthreads();
        if (tid < 256) {
            float t = 0.f;
#pragma unroll
            for (int k = 0; k < 4; ++k) t += __hip_atomic_load(st + k * 256 + tid, __ATOMIC_RELAXED, __HIP_MEMORY_SCOPE_AGENT);
            S[tid] = 1.0f / sqrtf(t * (1.0f / D) + 1e-6f);
        }
        __syncthreads();
#pragma unroll
        for (int ai = 0; ai < 2; ++ai) {
            const int r0 = u.pm * 256 + ai * 128;
            const float* mp = FINAL ? nullptr : mod_next + (r0 >> 12) * 3072;
#pragma unroll
            for (int bj = 0; bj < 2; ++bj) {
                const int c0 = u.pn * 256 + bj * 128 + wc * 32 + 8 * fq;
                f32x4 w0 = *(const f32x4*)(nw + c0), w1 = *(const f32x4*)(nw + c0 + 4), s0, s1;
                if (!FINAL) { w0 = w0 * (*(const f32x4*)(mp + 1024 + c0) + 1.0f); w1 = w1 * (*(const f32x4*)(mp + 1024 + c0 + 4) + 1.0f); s0 = *(const f32x4*)(mp + c0); s1 = *(const f32x4*)(mp + c0 + 4); }
#pragma unroll
                for (int m = 0; m < 4; ++m) {
                    const int rl = ai * 128 + wr * 64 + m * 16 + fr;
                    const float rstd = S[rl];
                    const size_t off = (size_t)(u.pm * 256 + rl) * D + c0;
                    const u32x4 xw = *(const LAS u32x4*)(park + ((ai * 2 + bj) * 4 + m) * 8192);
                    const f32x4 x0 = {bf_lo(xw.x), bf_hi(xw.x), bf_lo(xw.y), bf_hi(xw.y)}, x1 = {bf_lo(xw.z), bf_hi(xw.z), bf_lo(xw.w), bf_hi(xw.w)};
                    if (FINAL) { *(f32x4*)(out + off) = x0 * rstd * w0; *(f32x4*)(out + off + 4) = x1 * rstd * w1; }
                    else { const f32x4 y0 = x0 * rstd * w0 + s0, y1 = x1 * rstd * w1 + s1;
                        u32x4 w; w.x = pk2(y0[0], y0[1]); w.y = pk2(y0[2], y0[3]); w.z = pk2(y1[0], y1[1]); w.w = pk2(y1[2], y1[3]);
                        *(u32x4*)(H + off) = w; }
                }
            }
        }
        __syncthreads();
    }
};

template <class Epi>
__device__ __forceinline__ void gemm64_tile(LAS unsigned char* lds, const bf16_t* A, const bf16_t* Bt, const Epi& E) {
    constexpr int K = 1024, BK = 128, PITCH = BK * 2 + 16, NKT = K / BK;
    const int tid = threadIdx.x, lane = tid & 63, wave = __builtin_amdgcn_readfirstlane(tid >> 6), fr = lane & 15, fq = lane >> 4, wr = wave >> 1, wc = wave & 1;
    LAS unsigned char* As = lds; LAS unsigned char* Bs = lds + 64 * PITCH;
    const int srow = tid >> 4, sch = tid & 15;
    const bf16_t* ga = A + (size_t)srow * K + sch * 8; const bf16_t* gb = Bt + (size_t)srow * K + sch * 8;
    u32x4 ra[2], rb[2];
#pragma unroll
    for (int i = 0; i < 2; ++i) { ra[i] = *(const u32x4*)(ga + (size_t)(32 * i) * K); rb[i] = *(const u32x4*)(gb + (size_t)(32 * i) * K); }
    f32x4 acc[2] = {(f32x4){0.f, 0.f, 0.f, 0.f}, (f32x4){0.f, 0.f, 0.f, 0.f}};
    for (int kt = 0; kt < NKT; ++kt) {
        __syncthreads();
#pragma unroll
        for (int i = 0; i < 2; ++i) { *(LAS u32x4*)(As + (srow + 32 * i) * PITCH + sch * 16) = ra[i]; *(LAS u32x4*)(Bs + (srow + 32 * i) * PITCH + sch * 16) = rb[i]; }
        __syncthreads();
        if (kt + 1 < NKT) {
#pragma unroll
            for (int i = 0; i < 2; ++i) { ra[i] = *(const u32x4*)(ga + (size_t)(32 * i) * K + (kt + 1) * BK); rb[i] = *(const u32x4*)(gb + (size_t)(32 * i) * K + (kt + 1) * BK); }
        }
#pragma unroll
        for (int ks = 0; ks < 4; ++ks) {
            const bf16x8 Af = *(const LAS bf16x8*)(As + (16 * wr + fr) * PITCH + (32 * ks + 8 * fq) * 2);
#pragma unroll
            for (int n = 0; n < 2; ++n) {
                const bf16x8 Bf = *(const LAS bf16x8*)(Bs + (32 * wc + 16 * n + fr) * PITCH + (32 * ks + 8 * fq) * 2);
                acc[n] = __builtin_amdgcn_mfma_f32_16x16x32_bf16(Bf, Af, acc[n], 0, 0, 0);
            }
        }
    }
    __syncthreads();
    E(acc, wr, wc, fr, fq, lds);
}
struct Epi64Bf16 {
    bf16_t* O; int ldc;
    __device__ __forceinline__ void operator()(f32x4 (&acc)[2], int wr, int wc, int fr, int fq, LAS unsigned char* lds) const {
#pragma unroll
        for (int n = 0; n < 2; ++n) { u32x2 w; w.x = pk2(acc[n][0], acc[n][1]); w.y = pk2(acc[n][2], acc[n][3]);
            *(u32x2*)(O + (size_t)(16 * wr + fr) * ldc + 32 * wc + 16 * n + 4 * fq) = w; }
    }
};
struct Epi64ResidNorm {
    const float* base; const float* modc; const float* nw; const float* modc_next; bf16_t* H;
    int col0; float* stat; unsigned* cnt;
    int cb;
    __device__ __forceinline__ void operator()(f32x4 (&acc)[2], int wr, int wc, int fr, int fq, LAS unsigned char* lds) const {
        LAS float* P = (LAS float*)(lds + LDS_TOP + 64);
        LAS float* S = P + 128;
        const int tid = threadIdx.x, row = 16 * wr + fr;
        f32x4 x[2]; float q = 0.f;
#pragma unroll
        for (int n = 0; n < 2; ++n) { const int c = col0 + 32 * wc + 16 * n + 4 * fq;
            x[n] = *(const f32x4*)(base + (size_t)row * D + c) + *(const f32x4*)(modc + 2048 + c) * acc[n];
            q += (x[n][0] * x[n][0] + x[n][1] * x[n][1]) + (x[n][2] * x[n][2] + x[n][3] * x[n][3]); }
        q += __shfl_xor(q, 16); q += __shfl_xor(q, 32);
        if (fq == 0) P[row * 2 + wc] = q;
        __syncthreads();
        if (tid < 64) __hip_atomic_store(stat + cb * 64 + tid, P[tid * 2] + P[tid * 2 + 1], __ATOMIC_RELAXED, __HIP_MEMORY_SCOPE_AGENT);
        asm volatile("s_waitcnt vmcnt(0)" ::: "memory");
        __syncthreads();
        if (tid == 0) {
            __hip_atomic_fetch_add(cnt, 1u, __ATOMIC_RELAXED, __HIP_MEMORY_SCOPE_AGENT);
            unsigned sp = 0;
            while (__hip_atomic_load(cnt, __ATOMIC_RELAXED, __HIP_MEMORY_SCOPE_AGENT) < 16u) { __builtin_amdgcn_s_sleep(1); if (++sp > (1u << 20)) break; }
        }
        __syncthreads();
        if (tid < 64) { float t = 0.f;
#pragma unroll
            for (int k = 0; k < 16; ++k) t += __hip_atomic_load(stat + k * 64 + tid, __ATOMIC_RELAXED, __HIP_MEMORY_SCOPE_AGENT);
            S[tid] = 1.0f / sqrtf(t * (1.0f / D) + 1e-6f); }
        __syncthreads();
        const float rstd = S[row];
#pragma unroll
        for (int n = 0; n < 2; ++n) { const int c = col0 + 32 * wc + 16 * n + 4 * fq;
            const f32x4 y = x[n] * rstd * *(const f32x4*)(nw + c) * (*(const f32x4*)(modc_next + 1024 + c) + 1.0f) + *(const f32x4*)(modc_next + c);
            u32x2 w; w.x = pk2(y[0], y[1]); w.y = pk2(y[2], y[3]);
            *(u32x2*)(H + (size_t)row * D + c) = w; }
        __syncthreads();
    }
};

struct Args {
    const float* in[22];
    float* out;
    unsigned char* ws;
    int ph_lo, ph_hi, pad, pad2;
};

__device__ __forceinline__ void transpose_item(const float* W, int K, int N, bf16_t* WT, int k0, int n0, int dst_row0, LAS float* scr, int lane, bool perm = false) {
    float wv[32];
#pragma unroll
    for (int i = 0; i < 32; ++i) wv[i] = W[(size_t)(k0 + 2 * i + (lane >> 5)) * N + n0 + (lane & 31)];
#pragma unroll
    for (int i = 0; i < 32; ++i) scr[(2 * i + (lane >> 5)) * 33 + (lane & 31)] = wv[i];
    WAVE_LDS_FENCE();
    const int c = lane & 7;
#pragma unroll
    for (int j = 0; j < 4; ++j) { const int n = (lane >> 3) + 8 * j; const LAS float* s = scr + (8 * c) * 33 + n;
        u32x4 o; o.x = pk2(s[0 * 33], s[1 * 33]); o.y = pk2(s[2 * 33], s[3 * 33]); o.z = pk2(s[4 * 33], s[5 * 33]); o.w = pk2(s[6 * 33], s[7 * 33]);
        const int nd = perm ? 8 * ((n & 15) >> 2) + 4 * (n >> 4) + (n & 3) : n;
        *(u32x4*)(WT + (size_t)(dst_row0 + nd) * K + k0 + 8 * c) = o; }
    WAVE_LDS_FENCE();
}

__device__ __forceinline__ void p0_prologue(const Args& a, LAS unsigned char* lds) {
    const int tid = threadIdx.x, lane = tid & 63, wave = tid >> 6, bid = blockIdx.x, G = gridDim.x;
    unsigned char* ws = a.ws;
    if (bid < 192) {
        LAS float* sv = (LAS float*)lds;
        LAS float* red = (LAS float*)(lds + 20480);
        const int layer = bid / 96, n0 = (bid % 96) * 32;
        const int c4 = lane & 7, kk = lane >> 3;
        const float* wp = a.in[5] + (size_t)layer * D * 3072 + (size_t)(wave * 128 + kk) * 3072 + n0 + 4 * c4;
        f32x4 w[16];
#pragma unroll
        for (int i = 0; i < 16; ++i) w[i] = *(const f32x4*)(wp + (size_t)(8 * i) * 3072);
        float cx[10];
#pragma unroll
        for (int j = 0; j < 10; ++j) { const int idx = tid + 512 * j, v = idx >> 10, k = idx & 1023; cx[j] = v < 4 ? a.in[1][v * D + k] : a.in[3][k]; }
#pragma unroll
        for (int j = 0; j < 10; ++j) sv[tid + 512 * j] = cx[j] / (1.0f + expf(-cx[j]));
        __syncthreads();
        f32x4 acc[5];
#pragma unroll
        for (int v = 0; v < 5; ++v) acc[v] = (f32x4){0.f, 0.f, 0.f, 0.f};
#pragma unroll
        for (int i = 0; i < 16; ++i) {
#pragma unroll
            for (int v = 0; v < 5; ++v) acc[v] += w[i] * sv[v * D + wave * 128 + 8 * i + kk];
        }
#pragma unroll
        for (int v = 0; v < 5; ++v)
#pragma unroll
            for (int j = 0; j < 4; ++j) { float t = acc[v][j]; t += __shfl_xor(t, 8); t += __shfl_xor(t, 16); t += __shfl_xor(t, 32); acc[v][j] = t; }
        if (kk == 0) {
#pragma unroll
            for (int v = 0; v < 5; ++v) *(LAS f32x4*)(red + (wave * 5 + v) * 32 + 4 * c4) = acc[v];
        }
        __syncthreads();
        if (tid < 160) { const int v = tid >> 5, c = tid & 31; float t = 0.f;
#pragma unroll
            for (int q = 0; q < 8; ++q) t += red[(q * 5 + v) * 32 + c];
            ((float*)(ws + WS_MOD))[(layer * 5 + v) * 3072 + n0 + c] = t + a.in[6][layer * 3072 + n0 + c]; }
        __syncthreads();
    }
    if (bid >= 192 && bid < 208) {
        const int id = (bid - 192) * 512 + tid;
        const int dg = id >> 6, p = id & 63;
        const float lre = a.in[11][id], lim = a.in[12][id], dt = expf(a.in[13][dg]);
        const float mag = expf(lre * dt), ar = mag * cosf(lim * dt), ai = mag * sinf(lim * dt);
        float pr = ar, pi = ai;
#pragma unroll
        for (int s = 0; s < 6; ++s) { const float nr = pr * pr - pi * pi, ni = 2.f * pr * pi; pr = nr; pi = ni; }
        ((f32x4*)(ws + WS_APOW))[id] = (f32x4){ar, ai, pr, pi};
        const float den = lre * lre + lim * lim, nr_ = ar - 1.0f, ni_ = ai;
        const float cr = (nr_ * lre + ni_ * lim) / den, ci = (ni_ * lre - nr_ * lim) / den;
        bf16_t* Bb = (bf16_t*)(ws + WS_BB) + (size_t)dg * 128 * 16;
        bf16_t* Cm = (bf16_t*)(ws + WS_CM) + (size_t)dg * 16 * 128;
        const float* bre = a.in[14] + (size_t)id * 16; const float* bim = a.in[15] + (size_t)id * 16;
#pragma unroll
        for (int h = 0; h < 16; h += 2) {
            const float r0 = cr * bre[h] - ci * bim[h], i0 = cr * bim[h] + ci * bre[h], r1 = cr * bre[h + 1] - ci * bim[h + 1], i1 = cr * bim[h + 1] + ci * bre[h + 1];
            *(unsigned*)(Bb + (2 * p) * 16 + h) = pk2(r0, r1); *(unsigned*)(Bb + (2 * p + 1) * 16 + h) = pk2(i0, i1);
        }
        const float* cre = a.in[16] + (size_t)dg * 16 * 64; const float* cim = a.in[17] + (size_t)dg * 16 * 64;
#pragma unroll
        for (int h = 0; h < 16; ++h) *(unsigned*)(Cm + h * 128 + 2 * p) = pk2(cre[h * 64 + p], -cim[h * 64 + p]);
    }
    if (bid >= 208 && bid < 210) {
        const int id = (bid - 208) * 512 + tid;
        const int val = id >> 4, f = id & 15;
        const float inv = powf(10000.0f, -(float)f / 16.0f), ang = (float)val * inv;
        float* rp = (float*)(ws + WS_ROPE);
        rp[val * 32 + f] = cosf(ang); rp[val * 32 + 16 + f] = sinf(ang);
    }
    LAS float* scr = (LAS float*)(lds + wave * 16384);
    const int gw = bid * 8 + wave, NGW = G * 8;
    constexpr int I0 = 16 * 80, I1 = 16 * 32;
    for (int it = gw; it < I0 + I1; it += NGW) {
        int r = it;
        if (r < I0) { const int nb = r % 80, kb = r / 80; transpose_item(a.in[7], D, NQKVZ, (bf16_t*)(ws + WS_WQKVZ), kb * 64, nb * 32, nb * 32, scr, lane, nb * 32 < 1280); continue; } r -= I0;
        { const int nb = r % 32, kb = r / 32; transpose_item(a.in[9], D, D, (bf16_t*)(ws + WS_WAO), kb * 64, nb * 32, nb * 32, scr, lane); }
    }
}
__device__ __forceinline__ void p2_late_transposes(const Args& a, LAS unsigned char* lds, int w0) {
    const int tid = threadIdx.x, lane = tid & 63, wave = tid >> 6, bid = blockIdx.x, G = gridDim.x;
    unsigned char* ws = a.ws;
    LAS float* scr = (LAS float*)(lds + wave * 16384);
    const bool all = (w0 <= 0 || w0 >= G);
    if (!all && bid < w0) return;
    const int gw = ((all ? bid : bid - w0) * 8 + wave), NGW = (all ? G : G - w0) * 8;
    constexpr int I2 = 16 * 64, I3 = 16 * 64, I4 = 16 * 32;
    for (int it = gw; it < I2 + I3 + I4; it += NGW) {
        int r = it;
        if (r < I2) { const int nb = r % 64, kb = r / 64; transpose_item(a.in[10], D, NUZ, (bf16_t*)(ws + WS_WSIN), kb * 64, nb * 32, nb * 32, scr, lane); continue; } r -= I2;
        if (r < I3) { const int nb = r % 64, kb = r / 64, n0 = nb * 32; const int dst = 256 * ((n0 & 1023) >> 7) + 128 * (n0 >> 10) + (n0 & 127);
                      transpose_item(a.in[19], D, NUZ, (bf16_t*)(ws + WS_WGLU), kb * 64, n0, dst, scr, lane); continue; } r -= I3;
        { const int nb = r % 32, kb = r / 32; transpose_item(a.in[20], D, D, (bf16_t*)(ws + WS_WSOUT), kb * 64, nb * 32, nb * 32, scr, lane); }
    }
}

__device__ __forceinline__ const float* norm_src(const float* xlat, const float* xctx, int r) { return r < NLAT ? xlat + (size_t)r * D : xctx + (size_t)(r - NLAT) * D; }
__device__ __forceinline__ void norm_mod_phase(const float* xlat, const float* xctx, const float* nw, const float* mod, bf16_t* H) {
    const int lane = threadIdx.x & 63, gw = blockIdx.x * 8 + (threadIdx.x >> 6), NGW = gridDim.x * 8;
    f32x4 w4[4];
#pragma unroll
    for (int j = 0; j < 4; ++j) w4[j] = ((const f32x4*)nw)[lane + 64 * j];
    const int per = NLAT / NGW;
    const int nrows = per + ((gw < NCTX && NGW >= NCTX) ? 1 : 0);
    if (NLAT % NGW != 0 || NGW < NCTX) {
        for (int r = gw; r < MTOT; r += NGW) {
            const float* xr = norm_src(xlat, xctx, r); const float* mp = mod + (r < NLAT ? (r >> 12) : 4) * 3072;
            f32x4 v[4]; float s = 0.f;
#pragma unroll
            for (int j = 0; j < 4; ++j) { v[j] = ((const f32x4*)xr)[lane + 64 * j]; s += (v[j].x * v[j].x + v[j].y * v[j].y) + (v[j].z * v[j].z + v[j].w * v[j].w); }
            const float rstd = 1.0f / sqrtf(wave_sum(s) * (1.0f / D) + 1e-6f);
            unsigned long long* o8 = (unsigned long long*)(H + (size_t)r * D) + lane;
#pragma unroll
            for (int j = 0; j < 4; ++j) { const f32x4 sh = ((const f32x4*)mp)[lane + 64 * j], sc = ((const f32x4*)(mp + 1024))[lane + 64 * j];
                const f32x4 y = v[j] * rstd * w4[j] * (sc + 1.0f) + sh; o8[64 * j] = (unsigned long long)pk2(y.x, y.y) | ((unsigned long long)pk2(y.z, y.w) << 32); }
        }
        return;
    }
    const int r0 = gw * per;
    f32x4 g4[4], sh4[4];
    { const float* mp = mod + (r0 >> 12) * 3072;
#pragma unroll
      for (int j = 0; j < 4; ++j) { g4[j] = w4[j] * (((const f32x4*)(mp + 1024))[lane + 64 * j] + 1.0f); sh4[j] = ((const f32x4*)mp)[lane + 64 * j]; } }
    f32x4 nx[4];
#pragma unroll
    for (int j = 0; j < 4; ++j) nx[j] = ((const f32x4*)(xlat + (size_t)r0 * D))[lane + 64 * j];
    for (int k = 0; k < nrows; ++k) {
        const bool isc = k == per;
        const int r = isc ? NLAT + gw : r0 + k;
        f32x4 v[4];
#pragma unroll
        for (int j = 0; j < 4; ++j) v[j] = nx[j];
        if (k + 1 < nrows) { const float* xr = (k + 1 == per) ? xctx + (size_t)gw * D : xlat + (size_t)(r0 + k + 1) * D;
#pragma unroll
            for (int j = 0; j < 4; ++j) nx[j] = ((const f32x4*)xr)[lane + 64 * j]; }
        if (isc) { const float* mp = mod + 4 * 3072;
#pragma unroll
            for (int j = 0; j < 4; ++j) { g4[j] = w4[j] * (((const f32x4*)(mp + 1024))[lane + 64 * j] + 1.0f); sh4[j] = ((const f32x4*)mp)[lane + 64 * j]; } }
        float s = 0.f;
#pragma unroll
        for (int j = 0; j < 4; ++j) s += (v[j].x * v[j].x + v[j].y * v[j].y) + (v[j].z * v[j].z + v[j].w * v[j].w);
        const float rstd = 1.0f / sqrtf(wave_sum(s) * (1.0f / D) + 1e-6f);
        unsigned long long* o8 = (unsigned long long*)(H + (size_t)r * D) + lane;
#pragma unroll
        for (int j = 0; j < 4; ++j) {
            const f32x4 y = v[j] * rstd * g4[j] + sh4[j];
            o8[64 * j] = (unsigned long long)pk2(y.x, y.y) | ((unsigned long long)pk2(y.z, y.w) << 32);
        }
    }
}
__device__ __forceinline__ void final_norm_phase(float* out, const float* nw) {
    const int lane = threadIdx.x & 63, gw = blockIdx.x * 8 + (threadIdx.x >> 6), NGW = gridDim.x * 8;
    f32x4 w4[4];
#pragma unroll
    for (int j = 0; j < 4; ++j) w4[j] = ((const f32x4*)nw)[lane + 64 * j];
    f32x4 nx[4];
#pragma unroll
    for (int j = 0; j < 4; ++j) nx[j] = ((const f32x4*)(out + (size_t)gw * D))[lane + 64 * j];
    for (int r = gw; r < NLAT; r += NGW) {
        f32x4* xr = (f32x4*)(out + (size_t)r * D);
        f32x4 v[4]; float s = 0.f;
#pragma unroll
        for (int j = 0; j < 4; ++j) v[j] = nx[j];
        if (r + NGW < NLAT) {
#pragma unroll
            for (int j = 0; j < 4; ++j) nx[j] = ((const f32x4*)(out + (size_t)(r + NGW) * D))[lane + 64 * j]; }
#pragma unroll
        for (int j = 0; j < 4; ++j) s += (v[j].x * v[j].x + v[j].y * v[j].y) + (v[j].z * v[j].z + v[j].w * v[j].w);
        const float rstd = 1.0f / sqrtf(wave_sum(s) * (1.0f / D) + 1e-6f);
#pragma unroll
        for (int j = 0; j < 4; ++j) xr[lane + 64 * j] = v[j] * rstd * w4[j];
    }
}

constexpr int KS_PITCH = 144, VT_PITCH = 264, VT_OFF = 128 * KS_PITCH;
constexpr int ATT_BUF = 36864;
constexpr float ATT_THR = 8.0f;
#define MFMA32(a, b, c) __builtin_amdgcn_mfma_f32_32x32x16_bf16((a), (b), (c), 0, 0, 0)
__device__ __forceinline__ void attn_phase(LAS unsigned char* lds, const bf16_t* QKVZ, bf16_t* AO, const float* sink) {
    const int tid = threadIdx.x, lane = tid & 63, wave = __builtin_amdgcn_readfirstlane(tid >> 6);
    const int ql = lane & 31, hh = lane >> 5, hq = wave & 3, qh = wave >> 2;
    int pb = 0;
    const bool bal = gridDim.x == 256;
    const int bi = blockIdx.x;
    int ctx_it = -1;
    { const int m = bi & 127, h = bi >> 7;
      if (m < 4) ctx_it = h * 4 + m; else if (m >= 124) ctx_it = 8 + h * 4 + (m - 124); else if (m >= 116) ctx_it = 16 + h * 8 + (m - 116); }
    const int nit = bal ? (ctx_it >= 0 ? 3 : 2) : (544 - bi + (int)gridDim.x - 1) / (int)gridDim.x;
#define ATT_ITEM(kk) (bal ? ((kk) == 0 ? bi : ((kk) == 1 ? 256 + ((bi + 8) & 255) : 512 + ctx_it)) : bi + (kk) * (int)gridDim.x)
#define ATT_QROW0(it) ((it) < 512 ? ((it) >> 7) * SEQ + (((it) >> 2) & 31) * 128 : NLAT + (((it) - 512) >> 3) * CTXL + ((((it) - 512) >> 2) & 1) * 128)
#define ATT_LOADQ(Q, it) do { const int qr0_ = ATT_QROW0(it), hd_ = ((it) & 3) * 4 + hq; _Pragma("unroll") for (int qt = 0; qt < 2; ++qt) _Pragma("unroll") for (int ks = 0; ks < 4; ++ks) \
        Q[qt][ks] = *(const bf16x8*)(QKVZ + (size_t)(qr0_ + 64 * qh + 32 * qt + ql) * NQKVZ + hd_ * 64 + 16 * ks + 8 * hh); } while (0)
#define ATT_LOADKV0(it) do { const bool ic_ = (it) >= 512; const int b_ = ic_ ? ((it) - 512) >> 3 : (it) >> 7, nb_ = ((it) >> 2) & 31, kh_ = (it) & 3; \
        const int kr0_ = ic_ ? NLAT + b_ * CTXL : b_ * SEQ + (nb_ == 0 ? 0 : nb_ - 1) * 128; \
        _Pragma("unroll") for (int i = 0; i < 2; ++i) { const int c = tid + 512 * i, key = c >> 3, dc = c & 7; kr[i] = *(const u32x4*)(QKVZ + (size_t)(kr0_ + key) * NQKVZ + 1024 + kh_ * 64 + dc * 8); } \
        va = *(const u32x4*)(QKVZ + (size_t)(kr0_ + 2 * kp) * NQKVZ + 1280 + kh_ * 64 + dcv * 8); \
        vb = *(const u32x4*)(QKVZ + (size_t)(kr0_ + 2 * kp + 1) * NQKVZ + 1280 + kh_ * 64 + dcv * 8); } while (0)
    const int kp = tid & 63, dcv = tid >> 6;
    u32x4 kr[2], va, vb;
    bf16x8 Qn[2][4];
    if (nit > 0) { ATT_LOADQ(Qn, ATT_ITEM(0)); ATT_LOADKV0(ATT_ITEM(0)); }
    for (int k = 0; k < nit; ++k) {
        const int item = ATT_ITEM(k);
        int b, kh, qrow0, nblk; bool isctx;
        if (item < 512) { b = item >> 7; nblk = (item >> 2) & 31; kh = item & 3; qrow0 = b * SEQ + nblk * 128; isctx = false; }
        else { const int r = item - 512; b = r >> 3; kh = r & 3; qrow0 = NLAT + b * CTXL + ((r >> 2) & 1) * 128; isctx = true; nblk = 0; }
        const int head = kh * 4 + hq;
        bf16x8 Qf[2][4];
#pragma unroll
        for (int qt = 0; qt < 2; ++qt)
#pragma unroll
            for (int ks = 0; ks < 4; ++ks) Qf[qt][ks] = Qn[qt][ks];
        f32x16 O[2][2];
#pragma unroll
        for (int dt = 0; dt < 2; ++dt)
#pragma unroll
            for (int qt = 0; qt < 2; ++qt)
#pragma unroll
                for (int i = 0; i < 16; ++i) O[dt][qt][i] = 0.f;
        const float sk = sink[head] * LOG2E;
        float m_[2] = {sk, sk}, l_[2]; l_[0] = l_[1] = (hh == 0) ? 1.0f : 0.0f;
        const int ntiles = isctx ? 2 : 5;
        int tcur = (!isctx && nblk == 0) ? 1 : 0;
        while (tcur < ntiles) {
            const int mode = (!isctx && tcur == 0) ? 1 : ((!isctx && tcur == 2) ? 2 : 0);
            LAS unsigned char* Ks = lds + pb * ATT_BUF; LAS unsigned char* Vt = Ks + VT_OFF; pb ^= 1;
            {
#pragma unroll
                for (int i = 0; i < 2; ++i) { const int c = tid + 512 * i, key = c >> 3, dc = c & 7; *(LAS u32x4*)(Ks + key * KS_PITCH + dc * 16) = kr[i]; }
                LAS unsigned char* vp = Vt + (dcv * 8) * VT_PITCH + kp * 4;
#pragma unroll
                for (int e = 0; e < 4; ++e) {
                    const unsigned wa = va[e], wb = vb[e];
                    *(LAS unsigned*)(vp + (2 * e) * VT_PITCH) = (wa & 0xffffu) | (wb << 16);
                    *(LAS unsigned*)(vp + (2 * e + 1) * VT_PITCH) = (wa >> 16) | (wb & 0xffff0000u);
                }
            }
            __syncthreads();
            int tnext = tcur + 1; if (!isctx && tnext == 2 && nblk == 31) tnext = 3;
            if (tnext < ntiles) {
                const int krow0 = isctx ? NLAT + b * CTXL + tnext * 128 : (tnext < 3 ? b * SEQ + (nblk - 1 + tnext) * 128 : NLAT + b * CTXL + (tnext - 3) * 128);
#pragma unroll
                for (int i = 0; i < 2; ++i) { const int c = tid + 512 * i, key = c >> 3, dc = c & 7; kr[i] = *(const u32x4*)(QKVZ + (size_t)(krow0 + key) * NQKVZ + 1024 + kh * 64 + dc * 8); }
                va = *(const u32x4*)(QKVZ + (size_t)(krow0 + 2 * kp) * NQKVZ + 1280 + kh * 64 + dcv * 8);
                vb = *(const u32x4*)(QKVZ + (size_t)(krow0 + 2 * kp + 1) * NQKVZ + 1280 + kh * 64 + dcv * 8);
            }
            tcur = tnext;
#pragma unroll 1
            for (int sub = 0; sub < 2; ++sub) {
                if ((mode == 1 && sub < qh) || (mode == 2 && sub > qh)) continue;
                f32x16 S[2][2];
#pragma unroll
                for (int kt = 0; kt < 2; ++kt)
#pragma unroll
                    for (int qt = 0; qt < 2; ++qt)
#pragma unroll
                        for (int i = 0; i < 16; ++i) S[kt][qt][i] = -m_[qt];
#pragma unroll
                for (int kt = 0; kt < 2; ++kt)
#pragma unroll
                    for (int ks = 0; ks < 4; ++ks) {
                        const bf16x8 Kf = *(const LAS bf16x8*)(Ks + (64 * sub + 32 * kt + ql) * KS_PITCH + (16 * ks + 8 * hh) * 2);
                        S[kt][0] = MFMA32(Kf, Qf[0][ks], S[kt][0]);
                        S[kt][1] = MFMA32(Kf, Qf[1][ks], S[kt][1]);
                    }
                if (mode) {
#pragma unroll
                    for (int kt = 0; kt < 2; ++kt)
#pragma unroll
                        for (int qt = 0; qt < 2; ++qt)
#pragma unroll
                            for (int i = 0; i < 16; ++i) {
                                const int j = 64 * sub + 32 * kt + 8 * (i >> 2) + 4 * hh + (i & 3), iq = 64 * qh + 32 * qt + ql;
                                const bool valid = (mode == 1) ? (j >= iq) : (j <= iq);
                                S[kt][qt][i] = valid ? S[kt][qt][i] : -1e30f;
                            }
                }
#pragma unroll
                for (int qt = 0; qt < 2; ++qt) {
                    float mx = S[0][qt][0];
#pragma unroll
                    for (int kt = 0; kt < 2; ++kt)
#pragma unroll
                        for (int i = 0; i < 16; ++i) mx = fmaxf(mx, S[kt][qt][i]);
                    { const auto rr = __builtin_amdgcn_permlane32_swap(__float_as_uint(mx), __float_as_uint(mx), false, false);
                      mx = fmaxf(__uint_as_float(rr[0]), __uint_as_float(rr[1])); }
                    float alpha = 1.0f;
                    if (!__builtin_expect(__all(mx <= ATT_THR), 1)) {
                        const float dlt = fmaxf(mx, 0.0f);
                        alpha = fast_exp2(-dlt); m_[qt] += dlt;
#pragma unroll
                        for (int i = 0; i < 16; ++i) { O[0][qt][i] *= alpha; O[1][qt][i] *= alpha; }
#pragma unroll
                        for (int kt = 0; kt < 2; ++kt)
#pragma unroll
                            for (int i = 0; i < 16; ++i) S[kt][qt][i] -= dlt;
                    }
                    float rs = 0.f;
#pragma unroll
                    for (int kt = 0; kt < 2; ++kt)
#pragma unroll
                        for (int i = 0; i < 16; ++i) { const float p = fast_exp2(S[kt][qt][i]); S[kt][qt][i] = p; rs += p; }
                    l_[qt] = l_[qt] * alpha + rs;
                }
#pragma unroll
                for (int kt = 0; kt < 2; ++kt)
#pragma unroll
                    for (int s2 = 0; s2 < 2; ++s2) {
                        bf16x8 Pf[2];
#pragma unroll
                        for (int qt = 0; qt < 2; ++qt) {
                            u32x4 w; w.x = pk2(S[kt][qt][8 * s2 + 0], S[kt][qt][8 * s2 + 1]); w.y = pk2(S[kt][qt][8 * s2 + 2], S[kt][qt][8 * s2 + 3]);
                            w.z = pk2(S[kt][qt][8 * s2 + 4], S[kt][qt][8 * s2 + 5]); w.w = pk2(S[kt][qt][8 * s2 + 6], S[kt][qt][8 * s2 + 7]);
                            Pf[qt] = __builtin_bit_cast(bf16x8, w);
                        }
#pragma unroll
                        for (int dt = 0; dt < 2; ++dt) {
                            const LAS unsigned char* ap = Vt + (32 * dt + ql) * VT_PITCH + (64 * sub + 32 * kt + 16 * s2 + 4 * hh) * 2;
                            const u32x2 lo = *(const LAS u32x2*)ap, hi = *(const LAS u32x2*)(ap + 16);
                            u32x4 w; w.x = lo.x; w.y = lo.y; w.z = hi.x; w.w = hi.y;
                            const bf16x8 Vf = __builtin_bit_cast(bf16x8, w);
                            O[dt][0] = MFMA32(Vf, Pf[0], O[dt][0]);
                            O[dt][1] = MFMA32(Vf, Pf[1], O[dt][1]);
                        }
                    }
            }
        }
        LAS unsigned char* wsc = lds + 2 * ATT_BUF + wave * 9216;
        const int er = lane >> 3, ec = lane & 7;
        u32x4 zt[8];
#pragma unroll
        for (int it = 0; it < 8; ++it) zt[it] = *(const u32x4*)(QKVZ + (size_t)(qrow0 + 64 * qh + er + 8 * it) * NQKVZ + 1536 + head * 64 + 8 * ec);
        if (k + 1 < nit) { ATT_LOADQ(Qn, ATT_ITEM(k + 1)); ATT_LOADKV0(ATT_ITEM(k + 1)); }
#pragma unroll
        for (int it = 0; it < 8; ++it) *(LAS u32x4*)(wsc + (er + 8 * it) * 144 + ec * 16) = zt[it];
        WAVE_LDS_FENCE();
#pragma unroll
        for (int qt = 0; qt < 2; ++qt) {
            const auto lr_ = __builtin_amdgcn_permlane32_swap(__float_as_uint(l_[qt]), __float_as_uint(l_[qt]), false, false);
            const float lt = __uint_as_float(lr_[0]) + __uint_as_float(lr_[1]), inv = 1.0f / lt;
#pragma unroll
            for (int dt = 0; dt < 2; ++dt)
#pragma unroll
                for (int a4 = 0; a4 < 4; ++a4) {
                    LAS u32x2* slot = (LAS u32x2*)(wsc + (32 * qt + ql) * 144 + (32 * dt + 8 * a4 + 4 * hh) * 2);
                    const u32x2 zw = *slot;
                    const float o0 = O[dt][qt][4 * a4 + 0] * inv * silu_f(bf_lo(zw.x)), o1 = O[dt][qt][4 * a4 + 1] * inv * silu_f(bf_hi(zw.x));
                    const float o2 = O[dt][qt][4 * a4 + 2] * inv * silu_f(bf_lo(zw.y)), o3 = O[dt][qt][4 * a4 + 3] * inv * silu_f(bf_hi(zw.y));
                    u32x2 w; w.x = pk2(o0, o1); w.y = pk2(o2, o3);
                    *slot = w;
                }
        }
        WAVE_LDS_FENCE();
#pragma unroll
        for (int it = 0; it < 8; ++it) *(u32x4*)(AO + (size_t)(qrow0 + 64 * qh + er + 8 * it) * D + head * 64 + 8 * ec) = *(const LAS u32x4*)(wsc + (er + 8 * it) * 144 + ec * 16);
        WAVE_LDS_FENCE();
    }
    __syncthreads();
}

constexpr int BU_PITCH = 132;
constexpr int XB_PITCH = 272;
template <bool OUT>
__device__ __forceinline__ void s5_chunk(LAS unsigned char* wl, const bf16x4 (&Uf)[4], const bf16x4 (&Bf)[8], const bf16x8 (&Cf)[4],
                                         float ar, float ai, float& xr, float& xi, int dir, f32x4 (&accY)[4], int lane) {
    LAS float* bu = (LAS float*)wl;
    LAS unsigned char* xb = wl + 16 * BU_PITCH * 4;
    const int fr = lane & 15, fq = lane >> 4;
#pragma unroll
    for (int mm = 0; mm < 4; ++mm) {
        const int m = dir ? 3 - mm : mm;
#pragma unroll
        for (int nt = 0; nt < 8; ++nt) {
            f32x4 c = {0.f, 0.f, 0.f, 0.f};
            c = __builtin_amdgcn_mfma_f32_16x16x16bf16_1k(m == 0 ? Uf[0] : m == 1 ? Uf[1] : m == 2 ? Uf[2] : Uf[3], Bf[nt], c, 0, 0, 0);
#pragma unroll
            for (int i = 0; i < 4; ++i) bu[(4 * fq + i) * BU_PITCH + 16 * nt + fr] = c[i];
        }
        WAVE_LDS_FENCE();
#pragma unroll
        for (int rr = 0; rr < 16; ++rr) {
            const int r = dir ? 15 - rr : rr;
            const f32x2 bb = *(const LAS f32x2*)(bu + r * BU_PITCH + 2 * lane);
            const float nr = fmaf(ar, xr, fmaf(-ai, xi, bb.x)), ni = fmaf(ar, xi, fmaf(ai, xr, bb.y));
            xr = nr; xi = ni;
            if (OUT) *(LAS unsigned*)(xb + r * XB_PITCH + lane * 4) = pk2(nr, ni);
        }
        if (OUT) {
            WAVE_LDS_FENCE();
            f32x4 y = (m == 0 ? accY[0] : m == 1 ? accY[1] : m == 2 ? accY[2] : accY[3]);
#pragma unroll
            for (int ks = 0; ks < 4; ++ks) {
                const bf16x8 Xf = *(const LAS bf16x8*)(xb + fr * XB_PITCH + (8 * fq + 32 * ks) * 2);
                y = __builtin_amdgcn_mfma_f32_16x16x32_bf16(Cf[ks], Xf, y, 0, 0, 0);
            }
            if (m == 0) accY[0] = y; else if (m == 1) accY[1] = y; else if (m == 2) accY[2] = y; else accY[3] = y;
        }
    }
}
__device__ __forceinline__ int chunk_rowbase(int b, int dir, int c) {
    if (dir == 0) return c < 4 ? NLAT + b * CTXL + 64 * c : b * SEQ + 64 * (c - 4);
    return c < 4 ? NLAT + b * CTXL + 64 * (3 - c) : b * SEQ + 64 * (63 - (c - 4));
}
__device__ __forceinline__ void load_uf(bf16x4 (&Uf)[4], const bf16_t* UZ, int rowbase, int g, int lane) {
#pragma unroll
    for (int m = 0; m < 4; ++m) Uf[m] = *(const bf16x4*)(UZ + (size_t)(rowbase + 16 * m + (lane & 15)) * NUZ + 16 * g + 4 * (lane >> 4));
}
__device__ __forceinline__ void cmul(float& xr, float& xi, float ar, float ai) { const float nr = xr * ar - xi * ai, ni = xr * ai + xi * ar; xr = nr; xi = ni; }
__device__ __forceinline__ bf16x4 cscale_bf(const bf16x4 re, const bf16x4 im, float wr, float wi, bool want_im) {
    bf16x4 o;
#pragma unroll
    for (int k = 0; k < 4; k += 2) {
        const float r0 = __uint_as_float((unsigned)(unsigned short)re[k] << 16), r1 = __uint_as_float((unsigned)(unsigned short)re[k + 1] << 16);
        const float i0 = __uint_as_float((unsigned)(unsigned short)im[k] << 16), i1 = __uint_as_float((unsigned)(unsigned short)im[k + 1] << 16);
        const unsigned w = want_im ? pk2(wr * i0 + wi * r0, wr * i1 + wi * r1) : pk2(wr * r0 - wi * i0, wr * r1 - wi * i1);
        o[k] = (short)(w & 0xffffu); o[k + 1] = (short)(w >> 16);
    }
    return o;
}
template <int DIR>
__device__ __forceinline__ void s5_local_dir(const bf16_t* UZ, unsigned char* ws, int gw, int NGW, int lane) {
    float* E = (float*)(ws + WS_E);
    const int pair = gw & 127, g = pair & 63, fr = lane & 15, fq = lane >> 4;
    const bf16_t* Bb = (const bf16_t*)(ws + WS_BB) + (size_t)pair * 128 * 16;
    bf16x4 Bre[4][4], Bim[4][4]; float a1r[4], a1i[4], a64r[4], a64i[4], wr_[4], wi_[4];
#pragma unroll
    for (int t = 0; t < 4; ++t) {
        const int p = 16 * t + fr;
        const bf16x4 b_re = *(const bf16x4*)(Bb + (2 * p) * 16 + 4 * fq), b_im = *(const bf16x4*)(Bb + (2 * p + 1) * 16 + 4 * fq);
        const f32x4 ap = ((const f32x4*)(ws + WS_APOW))[pair * 64 + p];
        const float ar = ap.x, ai = ap.y;
        float r2 = ar, i2 = ai; cmul(r2, i2, ar, ai);
        float r4 = r2, i4 = i2; cmul(r4, i4, r2, i2);
        float r8 = r4, i8 = i4; cmul(r8, i8, r4, i4);
        float r12 = r8, i12 = i8; cmul(r12, i12, r4, i4);
        float r16 = r8, i16 = i8; cmul(r16, i16, r8, i8);
        float r32 = r16, i32 = i16; cmul(r32, i32, r16, i16);
        float r48 = r32, i48 = i32; cmul(r48, i48, r16, i16);
        a1r[t] = ar; a1i[t] = ai; a64r[t] = ap.z; a64i[t] = ap.w;
        const int e = DIR ? fq : 3 - fq;
        wr_[t] = e == 0 ? 1.f : e == 1 ? r4 : e == 2 ? r8 : r12; wi_[t] = e == 0 ? 0.f : e == 1 ? i4 : e == 2 ? i8 : i12;
#pragma unroll
        for (int m = 0; m < 4; ++m) {
            const int em = DIR ? m : 3 - m;
            const float pr = em == 0 ? 1.f : em == 1 ? r16 : em == 2 ? r32 : r48, pi = em == 0 ? 0.f : em == 1 ? i16 : em == 2 ? i32 : i48;
            Bre[m][t] = cscale_bf(b_re, b_im, pr, pi, false); Bim[m][t] = cscale_bf(b_re, b_im, pr, pi, true);
        }
    }
    const int qd = gw >> 7, b = qd >> 2, q = qd & 3;
    if (qd >= 16) return;
    const int c0 = 17 * q, c1 = q < 3 ? c0 + 17 : 67;
    float Rr[4] = {0.f, 0.f, 0.f, 0.f}, Ri[4] = {0.f, 0.f, 0.f, 0.f};
    float* ebase = E + ((size_t)((b * 2 + DIR) * 64 + g) * NCHUNK) * 128;
    bf16x4 Un[4];
    load_uf(Un, UZ, chunk_rowbase(b, DIR, c0), g, lane);
    for (int c = c0; c < c1; ++c) {
        bf16x4 Uf[4];
#pragma unroll
        for (int m = 0; m < 4; ++m) Uf[m] = Un[m];
        if (c + 1 < c1) load_uf(Un, UZ, chunk_rowbase(b, DIR, c + 1), g, lane);
        float* e = ebase + (size_t)c * 128;
#pragma unroll
        for (int t = 0; t < 4; ++t) {
            f32x4 cr = {0.f, 0.f, 0.f, 0.f}, ci = {0.f, 0.f, 0.f, 0.f};
#pragma unroll
            for (int m = 0; m < 4; ++m) {
                cr = __builtin_amdgcn_mfma_f32_16x16x16bf16_1k(Uf[m], Bre[m][t], cr, 0, 0, 0);
                ci = __builtin_amdgcn_mfma_f32_16x16x16bf16_1k(Uf[m], Bim[m][t], ci, 0, 0, 0);
            }
            f32x2 s2 = {DIR ? cr[3] : cr[0], DIR ? ci[3] : ci[0]};
#pragma unroll
            for (int ii = 1; ii < 4; ++ii) { const int i = DIR ? 3 - ii : ii;
                s2 = cmac(s2, (f32x2){a1r[t], a1r[t]}, (f32x2){-a1i[t], a1i[t]}, (f32x2){cr[i], ci[i]}); }
            s2 = cmac(s2, (f32x2){wr_[t], wr_[t]}, (f32x2){-wi_[t], wi_[t]}, (f32x2){0.f, 0.f});
            float sr = s2.x, si = s2.y;
            sr += __shfl_xor(sr, 16); si += __shfl_xor(si, 16); sr += __shfl_xor(sr, 32); si += __shfl_xor(si, 32);
            if (fq == 0) { e[16 * t + fr] = Rr[t]; e[64 + 16 * t + fr] = Ri[t]; }
            const float nr = fmaf(a64r[t], Rr[t], fmaf(-a64i[t], Ri[t], sr)), ni = fmaf(a64r[t], Ri[t], fmaf(a64i[t], Rr[t], si)); Rr[t] = nr; Ri[t] = ni;
        }
    }
    float* fin = q < 3 ? (float*)(ws + WS_QE) + ((size_t)((b * 2 + DIR) * 64 + g) * 3 + q) * 128 : ebase + (size_t)67 * 128;
    if (fq == 0) {
#pragma unroll
        for (int t = 0; t < 4; ++t) { fin[16 * t + fr] = Rr[t]; fin[64 + 16 * t + fr] = Ri[t]; }
    }
}
__device__ __forceinline__ void s5_local_phase(LAS unsigned char* lds, const bf16_t* UZ, unsigned char* ws) {
    const int lane = threadIdx.x & 63, wave = __builtin_amdgcn_readfirstlane(threadIdx.x >> 6);
    const int gw = blockIdx.x * 8 + wave, NGW = gridDim.x * 8;
    if ((gw & 127) >> 6) s5_local_dir<1>(UZ, ws, gw, NGW, lane); else s5_local_dir<0>(UZ, ws, gw, NGW, lane);
}
__device__ __forceinline__ void s5_carry_phase(unsigned char* ws) {
    const int gt = blockIdx.x * 128 + (threadIdx.x & 127);
    if (threadIdx.x >= 128 || gt >= NB * 2 * 64 * 64) return;
    const int p = gt & 63, g = (gt >> 6) & 63, bd = gt >> 12, dir = bd & 1;
    const f32x4 ap = ((const f32x4*)(ws + WS_APOW))[(dir * 64 + g) * 64 + p];
    float* e = (float*)(ws + WS_E) + ((size_t)(bd * 64 + g) * NCHUNK) * 128 + p;
    float er[NCHUNK - 1], ei[NCHUNK - 1];
#pragma unroll
    for (int c = 0; c < NCHUNK - 1; ++c) { er[c] = e[c * 128]; ei[c] = e[c * 128 + 64]; }
    float xr = 0.f, xi = 0.f;
#pragma unroll
    for (int c = 0; c < NCHUNK - 1; ++c) {
        const float nr = ap.z * xr - ap.w * xi + er[c], ni = ap.z * xi + ap.w * xr + ei[c];
        er[c] = xr; ei[c] = xi; xr = nr; xi = ni;
    }
#pragma unroll
    for (int c = 0; c < NCHUNK - 1; ++c) { e[c * 128] = er[c]; e[c * 128 + 64] = ei[c]; }
    e[(NCHUNK - 1) * 128] = xr; e[(NCHUNK - 1) * 128 + 64] = xi;
}
__device__ __forceinline__ f32x2 s5_carry(const f32x2 pre, const f32x2 (&qe)[3], const f32x4 ap, int c) {
    const int q = c / 17, k = c - 17 * q;
    if (q == 0) return pre;
    float A1r = ap.z, A1i = ap.w;
    float A2r = A1r, A2i = A1i; cmul(A2r, A2i, A1r, A1i);
    float A4r = A2r, A4i = A2i; cmul(A4r, A4i, A2r, A2i);
    float A8r = A4r, A8i = A4i; cmul(A8r, A8i, A4r, A4i);
    float A16r = A8r, A16i = A8i; cmul(A16r, A16i, A8r, A8i);
    float A17r = A16r, A17i = A16i; cmul(A17r, A17i, A1r, A1i);
    float sr = qe[0].x, si = qe[0].y;
    if (q >= 2) { cmul(sr, si, A17r, A17i); sr += qe[1].x; si += qe[1].y; }
    if (q >= 3) { cmul(sr, si, A17r, A17i); sr += qe[2].x; si += qe[2].y; }
    if (k & 1) cmul(sr, si, A1r, A1i);
    if (k & 2) cmul(sr, si, A2r, A2i);
    if (k & 4) cmul(sr, si, A4r, A4i);
    if (k & 8) cmul(sr, si, A8r, A8i);
    if (k & 16) cmul(sr, si, A16r, A16i);
    return (f32x2){pre.x + sr, pre.y + si};
}
constexpr int BUT_BYTES = 64 * 80, XB_BYTES = 16 * XB_PITCH;
__device__ __forceinline__ float bf_at(const u32x4& lo, const u32x4& hi, int r) { const unsigned w = (r < 8 ? lo : hi)[(r & 7) >> 1]; return (r & 1) ? bf_hi(w) : bf_lo(w); }
__device__ __forceinline__ void s5_out_phase(LAS unsigned char* lds, const bf16_t* UZ, const unsigned char* ws, const float* dskip, bf16_t* YG) {
    const int lane = threadIdx.x & 63, wave = __builtin_amdgcn_readfirstlane(threadIdx.x >> 6);
    LAS unsigned char* wl = lds + wave * S5_WAVE_LDS;
    const int gw = blockIdx.x * 8 + wave, NGW = gridDim.x * 8;
    const float* E = (const float*)(ws + WS_E);
    const int g = gw & 63, fr = lane & 15, fq = lane >> 4;
    const f32x4 dsk = *(const f32x4*)(dskip + 16 * g + 4 * fq);
    bf16x4 Bf[2][8]; bf16x8 Cf[2][4]; f32x4 ap[2];
#pragma unroll
    for (int dir = 0; dir < 2; ++dir) {
        const int pair = dir * 64 + g;
        const bf16_t* Bb = (const bf16_t*)(ws + WS_BB) + (size_t)pair * 128 * 16;
        const bf16_t* Cm = (const bf16_t*)(ws + WS_CM) + (size_t)pair * 16 * 128;
#pragma unroll
        for (int nt = 0; nt < 8; ++nt) Bf[dir][nt] = *(const bf16x4*)(Bb + (16 * nt + fr) * 16 + 4 * fq);
#pragma unroll
        for (int ks = 0; ks < 4; ++ks) Cf[dir][ks] = *(const bf16x8*)(Cm + fr * 128 + 8 * fq + 32 * ks);
        ap[dir] = ((const f32x4*)(ws + WS_APOW))[pair * 64 + lane];
    }
    const int wofs = (fr >> 1) * 80 + (fr & 1) * 32 + 8 * fq;
    const int sstep = NGW >> 6;
    const float* QE = (const float*)(ws + WS_QE);
    bf16x4 Un[4]; f32x2 rp[2], rq[2][3];
#define S5_LOADRAW(bb, ttt) do { _Pragma("unroll") for (int dir = 0; dir < 2; ++dir) { const int c_ = dir ? 4 + 63 - (ttt) : 4 + (ttt); \
        const float* e_ = E + ((size_t)(((bb) * 2 + dir) * 64 + g) * NCHUNK + c_) * 128; rp[dir] = (f32x2){e_[lane], e_[64 + lane]}; \
        const float* q_ = QE + ((size_t)(((bb) * 2 + dir) * 64 + g) * 3) * 128; \
        _Pragma("unroll") for (int j = 0; j < 3; ++j) rq[dir][j] = (f32x2){q_[j * 128 + lane], q_[j * 128 + 64 + lane]}; } } while (0)
    { const int slot = gw >> 6, b = slot >> 6, tt = slot & 63;
      load_uf(Un, UZ, b * SEQ + 64 * tt, g, lane);
      S5_LOADRAW(b, tt); }
    for (int slot = gw >> 6; slot < 256; slot += sstep) {
        const int b = slot >> 6, tt = slot & 63, rowbase = b * SEQ + 64 * tt;
        bf16x4 Uf[4];
#pragma unroll
        for (int m = 0; m < 4; ++m) Uf[m] = Un[m];
        const f32x2 cF_ = s5_carry(rp[0], rq[0], ap[0], 4 + tt), cB_ = s5_carry(rp[1], rq[1], ap[1], 4 + 63 - tt);
        float xfr = cF_.x, xfi = cF_.y, xbr = cB_.x, xbi = cB_.y;
        if (slot + sstep < 256) { const int ns = slot + sstep, nb = ns >> 6, ntt = ns & 63;
            load_uf(Un, UZ, nb * SEQ + 64 * ntt, g, lane);
            S5_LOADRAW(nb, ntt); }
        f32x4 accY[4];
#pragma unroll
        for (int m = 0; m < 4; ++m) accY[m] = (f32x4){0.f, 0.f, 0.f, 0.f};
#pragma unroll
        for (int mm = 0; mm < 4; ++mm) {
            const int mf = mm, mb = 3 - mm;
#pragma unroll
            for (int nt = 0; nt < 8; ++nt) {
                const f32x4 z = {0.f, 0.f, 0.f, 0.f};
                const f32x4 cf = __builtin_amdgcn_mfma_f32_16x16x16bf16_1k(Uf[mf], Bf[0][nt], z, 0, 0, 0);
                const f32x4 cb = __builtin_amdgcn_mfma_f32_16x16x16bf16_1k(Uf[mb], Bf[1][nt], z, 0, 0, 0);
                u32x2 wf, wb; wf.x = pk2(cf[0], cf[1]); wf.y = pk2(cf[2], cf[3]); wb.x = pk2(cb[0], cb[1]); wb.y = pk2(cb[2], cb[3]);
                *(LAS u32x2*)(wl + nt * 640 + wofs) = wf;
                *(LAS u32x2*)(wl + BUT_BYTES + nt * 640 + wofs) = wb;
            }
            WAVE_LDS_FENCE();
            const LAS unsigned char* rp = wl + lane * 80;
            const u32x4 fre0 = *(const LAS u32x4*)(rp), fre1 = *(const LAS u32x4*)(rp + 16), fim0 = *(const LAS u32x4*)(rp + 32), fim1 = *(const LAS u32x4*)(rp + 48);
            const u32x4 bre0 = *(const LAS u32x4*)(rp + BUT_BYTES), bre1 = *(const LAS u32x4*)(rp + BUT_BYTES + 16), bim0 = *(const LAS u32x4*)(rp + BUT_BYTES + 32), bim1 = *(const LAS u32x4*)(rp + BUT_BYTES + 48);
            LAS unsigned char* xf = wl + 2 * BUT_BYTES; LAS unsigned char* xbk = xf + XB_BYTES;
#pragma unroll
            for (int rr = 0; rr < 16; ++rr) {
                const int r = rr, rb = 15 - rr;
                { const f32x2 bb = {bf_at(fre0, fre1, r), bf_at(fim0, fim1, r)};
                  const f32x2 n2 = cmac((f32x2){xfr, xfi}, (f32x2){ap[0].x, ap[0].x}, (f32x2){-ap[0].y, ap[0].y}, bb); xfr = n2.x; xfi = n2.y;
                  *(LAS unsigned*)(xf + r * XB_PITCH + lane * 4) = pk2(n2.x, n2.y); }
                { const f32x2 bb = {bf_at(bre0, bre1, rb), bf_at(bim0, bim1, rb)};
                  const f32x2 n2 = cmac((f32x2){xbr, xbi}, (f32x2){ap[1].x, ap[1].x}, (f32x2){-ap[1].y, ap[1].y}, bb); xbr = n2.x; xbi = n2.y;
                  *(LAS unsigned*)(xbk + rb * XB_PITCH + lane * 4) = pk2(n2.x, n2.y); }
            }
            WAVE_LDS_FENCE();
#pragma unroll
            for (int ks = 0; ks < 4; ++ks) {
                const bf16x8 Xf = *(const LAS bf16x8*)(xf + fr * XB_PITCH + (8 * fq + 32 * ks) * 2);
                const bf16x8 Xb = *(const LAS bf16x8*)(xbk + fr * XB_PITCH + (8 * fq + 32 * ks) * 2);
                accY[mf] = __builtin_amdgcn_mfma_f32_16x16x32_bf16(Cf[0][ks], Xf, accY[mf], 0, 0, 0);
                accY[mb] = __builtin_amdgcn_mfma_f32_16x16x32_bf16(Cf[1][ks], Xb, accY[mb], 0, 0, 0);
            }
        }
#pragma unroll
        for (int m = 0; m < 4; ++m) {
            const unsigned u0 = (unsigned)(unsigned short)Uf[m][0] | ((unsigned)(unsigned short)Uf[m][1] << 16), u1 = (unsigned)(unsigned short)Uf[m][2] | ((unsigned)(unsigned short)Uf[m][3] << 16);
            const float y0 = gelu_f(accY[m][0] + dsk[0] * bf_lo(u0)), y1 = gelu_f(accY[m][1] + dsk[1] * bf_hi(u0));
            const float y2 = gelu_f(accY[m][2] + dsk[2] * bf_lo(u1)), y3 = gelu_f(accY[m][3] + dsk[3] * bf_hi(u1));
            u32x2 w; w.x = pk2(y0, y1); w.y = pk2(y2, y3);
            *(u32x2*)(YG + (size_t)(rowbase + 16 * m + fr) * D + 16 * g + 4 * fq) = w;
        }
    }
}

__global__ void __launch_bounds__(512, 2) fwd_megakernel(Args a) {
    extern __shared__ __attribute__((aligned(16))) unsigned char lds_raw[];
    LAS unsigned char* lds = (LAS unsigned char*)lds_raw;
    cg::grid_group grid = cg::this_grid();
    unsigned char* ws = a.ws;
    volatile LAS unsigned* bst = (volatile LAS unsigned*)(lds + LDS_TOP);
    if (threadIdx.x < 2) bst[threadIdx.x] = 0u;
    __syncthreads();
    const XcdBarrier xbar = xcd_barrier_post((unsigned*)(ws + WS_BAR), bst);
    if (a.pad == 0x7ead) grid.sync();
    const int lo = a.ph_lo, hi = a.ph_hi;
    const int G = gridDim.x, bid = blockIdx.x;
    const float* mod0 = (const float*)(ws + WS_MOD);
    const float* mod1 = mod0 + 5 * 3072;
    bf16_t* H = (bf16_t*)(ws + WS_H);
    bf16_t* QKVZ = (bf16_t*)(ws + WS_QKVZ);
    bf16_t* AO = (bf16_t*)(ws + WS_AO);
    float* CTX1 = (float*)(ws + WS_CTX1);
#define IN(k) (lo <= (k) && (k) < hi)
#define SEAM(k) do { if (IN(k) && IN((k) + 1)) { xcd_barrier(xbar); if (SYNC_REP > 1) xcd_barrier(xbar); } } while (0)
#define REPB(k) ((((REP_MASK) >> (k)) & 1) != 0)
    if (IN(0)) p0_prologue(a, lds);
    if (IN(0) && REPB(0)) p0_prologue(a, lds);
    SEAM(0);
    if (IN(1)) norm_mod_phase(a.in[0], a.in[2], a.in[4], mod0, H);
    if (IN(1) && REPB(1)) norm_mod_phase(a.in[0], a.in[2], a.in[4], mod0, H);
    SEAM(1);
    if (IN(2)) { pg8::Gemm g{H, (const bf16_t*)(ws + WS_WQKVZ), MTOT, NQKVZ, D}; pg8::StaticOrder S; S.init(MTOT, NQKVZ, G, bid);
        EpiQKVZ E{QKVZ, (const float*)(ws + WS_ROPE)}; pg8::gemm_phase<EpiQKVZ, pg8::StaticOrder>(lds, g, S, E);
        p2_late_transposes(a, lds, (MTOT / 256) * (NQKVZ / 256) - 2 * G); }
    if (IN(2) && REPB(2)) { pg8::Gemm g{H, (const bf16_t*)(ws + WS_WQKVZ), MTOT, NQKVZ, D}; pg8::StaticOrder S; S.init(MTOT, NQKVZ, G, bid);
        EpiQKVZ E{QKVZ, (const float*)(ws + WS_ROPE)}; pg8::gemm_phase<EpiQKVZ, pg8::StaticOrder>(lds, g, S, E); }
    SEAM(2);
    if (IN(3)) attn_phase(lds, QKVZ, AO, a.in[8]);
    if (IN(3) && REPB(3)) attn_phase(lds, QKVZ, AO, a.in[8]);
    SEAM(3);
    if (IN(4)) { pg8::Gemm g{AO, (const bf16_t*)(ws + WS_WAO), NLAT, D, D}; PanelOrder S; S.init(NLAT, G, bid);
        EpiResidNorm<false> E{a.in[0], (bf16_t*)(ws + WS_X1), nullptr, mod0, a.in[4] + D, mod1, H, (float*)(ws + WS_STAT), (unsigned*)(ws + WS_CNT)};
        pg8::gemm_phase<EpiResidNorm<false>, PanelOrder>(lds, g, S, E);
        if (bid < 256) { const int rb = bid >> 4, cb = bid & 15;
            Epi64ResidNorm E2{a.in[2] + (size_t)rb * 64 * D, mod0 + 4 * 3072, a.in[4] + D, mod1 + 4 * 3072, H + (size_t)(NLAT + rb * 64) * D, cb * 64,
                              (float*)(ws + WS_STATC) + rb * 1024, (unsigned*)(ws + WS_CNTC) + rb * 64, cb};
            gemm64_tile<Epi64ResidNorm>(lds, AO + (size_t)(NLAT + rb * 64) * D, (const bf16_t*)(ws + WS_WAO) + (size_t)cb * 64 * D, E2); } }
    SEAM(5);
    if (IN(6)) { pg8::Gemm g{H, (const bf16_t*)(ws + WS_WSIN), NLAT, NUZ, D}; pg8::StaticOrder S; S.init(NLAT, NUZ, G, bid);
        EpiBf16 E{QKVZ, NUZ}; pg8::gemm_phase<EpiBf16, pg8::StaticOrder>(lds, g, S, E);
        if (bid < 256) { const int rb = bid >> 4, cb = bid & 15;
            Epi64Bf16 E2{QKVZ + (size_t)(NLAT + rb * 64) * NUZ + cb * 64, NUZ};
            gemm64_tile<Epi64Bf16>(lds, H + (size_t)(NLAT + rb * 64) * D, (const bf16_t*)(ws + WS_WSIN) + (size_t)cb * 64 * D, E2); } }
    SEAM(6);
    if (IN(7)) s5_local_phase(lds, QKVZ, ws);
    if (IN(7) && REPB(7)) s5_local_phase(lds, QKVZ, ws);
    SEAM(7);
    if (IN(9)) s5_out_phase(lds, QKVZ, ws, a.in[18], AO);
    if (IN(9) && REPB(9)) s5_out_phase(lds, QKVZ, ws, a.in[18], AO);
    SEAM(9);
    if (IN(10)) { pg8::Gemm g{AO, (const bf16_t*)(ws + WS_WGLU), NLAT, NUZ, D}; pg8::StaticOrder S; S.init(NLAT, NUZ, G, bid);
        EpiGlu E{H, QKVZ}; pg8::gemm_phase<EpiGlu, pg8::StaticOrder>(lds, g, S, E); }
    if (IN(10) && REPB(10)) { pg8::Gemm g{AO, (const bf16_t*)(ws + WS_WGLU), NLAT, NUZ, D}; pg8::StaticOrder S; S.init(NLAT, NUZ, G, bid);
        EpiGlu E{H, QKVZ}; pg8::gemm_phase<EpiGlu, pg8::StaticOrder>(lds, g, S, E); }
    SEAM(10);
    if (IN(11)) { pg8::Gemm g{H, (const bf16_t*)(ws + WS_WSOUT), NLAT, D, D}; PanelOrder S; S.init(NLAT, G, bid);
        EpiResidNorm<true> E{nullptr, (bf16_t*)(ws + WS_X1), a.out, mod1, a.in[21], nullptr, nullptr, (float*)(ws + WS_STAT) + 68 * 1024, (unsigned*)(ws + WS_CNT) + 68 * 64};
        pg8::gemm_phase<EpiResidNorm<true>, PanelOrder>(lds, g, S, E); }
#undef IN
#undef SEAM
}

extern "C" void kernel_launch(void* const* d_in, const int* in_sizes, int n_in, void* d_out, int out_size, void* d_ws, size_t ws_size, hipStream_t stream) {
    static int grid = 0;
    if (grid == 0) {
        int dev = 0, cus = 0, per_cu = 0;
        (void)hipGetDevice(&dev);
        (void)hipDeviceGetAttribute(&cus, hipDeviceAttributeMultiprocessorCount, dev);
        (void)hipFuncSetAttribute((const void*)fwd_megakernel, hipFuncAttributeMaxDynamicSharedMemorySize, LDS_BYTES);
        (void)hipOccupancyMaxActiveBlocksPerMultiprocessor(&per_cu, (const void*)fwd_megakernel, 512, LDS_BYTES);
        if (per_cu < 1) per_cu = 1;
        grid = cus * per_cu;
        if (n_in != 22 || ws_size < WS_END) { fprintf(stderr, "kernel_launch: unexpected n_in %d / ws_size %zu\n", n_in, ws_size); }
    }
    Args a{};
    for (int i = 0; i < 22; ++i) a.in[i] = (const float*)d_in[i];
    a.out = (float*)d_out; a.ws = (unsigned char*)d_ws; a.ph_lo = 0; a.ph_hi = 13;
    (void)hipMemsetAsync((char*)d_ws + WS_BAR, 0, BAR_ZERO_BYTES, stream);
    void* args[] = {&a};
    hipError_t e = hipLaunchCooperativeKernel((void*)fwd_megakernel, dim3(grid), dim3(512), args, LDS_BYTES, stream);
    if (e != hipSuccess) fprintf(stderr, "cooperative launch failed: %s (grid %d)\n", hipGetErrorString(e), grid);
}
```
